# Optimizing an MI355X kernel written in HIP

```python
import jax, jax.numpy as jnp
from jax import lax
import numpy as np


D_MODEL = 2048
BATCH = 4
SEQ = 8192
DEPTH = 2
DEC_BATCH = 8
DEC_SEQ = 4096
PAST_LEN = 128

GRID_W = 64
HEAD_DIM = 128
NA_HEADS = 8
NA_ROWS = 8
NA_COLS = 16
GA_HEADS = 8
GA_KV_HEADS = 2
ROPE_THETA = 10000.0
SW_HEADS = 8
SW_KV_HEADS = 2
WINDOW = 128
Q_BLOCK = 128
N_BRANCH = 3
D_FF = 5632
EPS = 1e-6

NA_W = NA_HEADS * HEAD_DIM
GA_QW = GA_HEADS * HEAD_DIM
GA_KW = GA_KV_HEADS * HEAD_DIM
SW_QW = SW_HEADS * HEAD_DIM
SW_KW = SW_KV_HEADS * HEAD_DIM
BRANCH_W = NA_W
D_IN = 3 * NA_W + GA_QW + 2 * GA_KW + SW_QW + 2 * SW_KW

kernel_name = 'hybrid_na_gqa_swa_macaron_encoder'


def rms_norm(x, g):
    xf = x.astype(jnp.float32)
    y = xf * lax.rsqrt(jnp.mean(xf * xf, axis=-1, keepdims=True) + EPS)
    return (y * g.astype(jnp.float32)).astype(x.dtype)


def swiglu(x, wg, wu, wd):
    return (jax.nn.silu(x @ wg) * (x @ wu)) @ wd


def alibi_slopes(n):
    return 2.0 ** (-8.0 * jnp.arange(1, n + 1, dtype=jnp.float32) / n)


def axial_rope(x, row, col):
    half = HEAD_DIM // 2
    quarter = half // 2
    freqs = ROPE_THETA ** (-jnp.arange(quarter, dtype=jnp.float32) / quarter)

    def rot(part, pos):
        ang = pos.astype(jnp.float32)[:, None] * freqs[None, :]
        c = jnp.cos(ang)[None, :, None, :]
        s = jnp.sin(ang)[None, :, None, :]
        p1, p2 = part[..., :quarter], part[..., quarter:]
        return jnp.concatenate([p1 * c - p2 * s, p2 * c + p1 * s], axis=-1)

    xf = x.astype(jnp.float32)
    out = jnp.concatenate([rot(xf[..., :half], row), rot(xf[..., half:], col)], axis=-1)
    return out.astype(x.dtype)


def neighborhood_attention(q, k, v, rel_bias):
    B, S, H, hd = q.shape
    rows = S // GRID_W
    kh = min(NA_ROWS, rows)
    kw = NA_COLS
    scale = hd ** -0.5
    q = q.reshape(B, rows, GRID_W, H, hd)
    k = k.reshape(B, rows, GRID_W, H, hd)
    v = v.reshape(B, rows, GRID_W, H, hd)
    cq = jnp.arange(GRID_W)
    col_idx = jnp.clip(cq - kw // 2, 0, GRID_W - kw)[:, None] + jnp.arange(kw)[None, :]
    col_bias_idx = col_idx - cq[:, None] + NA_COLS - 1
    table_c = rel_bias.astype(jnp.float32)[:, :, col_bias_idx]

    def one_row(r):
        rs = jnp.clip(r - kh // 2, 0, rows - kh)
        row_bias_idx = rs + jnp.arange(kh) - r + NA_ROWS - 1
        bias = table_c[:, row_bias_idx].transpose(0, 2, 1, 3)
        ks = lax.dynamic_slice_in_dim(k, rs, kh, axis=1)[:, :, col_idx]
        vs = lax.dynamic_slice_in_dim(v, rs, kh, axis=1)[:, :, col_idx]
        qr = lax.dynamic_index_in_dim(q, r, axis=1, keepdims=False)
        s = jnp.einsum('bqhd,bkqjhd->bhqkj', qr, ks).astype(jnp.float32) * scale + bias[None]
        p = jax.nn.softmax(s.reshape(B, H, GRID_W, kh * kw), axis=-1)
        p = p.reshape(B, H, GRID_W, kh, kw).astype(v.dtype)
        return jnp.einsum('bhqkj,bkqjhd->bqhd', p, vs)

    out = lax.map(one_row, jnp.arange(rows))
    return out.transpose(1, 0, 2, 3, 4).reshape(B, S, H * hd)


def global_attention(q, k, v):
    B, S, Hq, hd = q.shape
    Hkv = k.shape[2]
    G = Hq // Hkv
    nblk = S // Q_BLOCK
    scale = hd ** -0.5
    qb = q.reshape(B, nblk, Q_BLOCK, Hkv, G, hd).transpose(1, 0, 2, 3, 4, 5)

    def blk(qi):
        s = jnp.einsum('bqkgd,bskd->bkgqs', qi, k).astype(jnp.float32) * scale
        p = jax.nn.softmax(s, axis=-1).astype(v.dtype)
        return jnp.einsum('bkgqs,bskd->bqkgd', p, v)

    out = lax.map(blk, qb)
    return out.transpose(1, 0, 2, 3, 4, 5).reshape(B, S, Hq * hd)


def sliding_window_attention(q, k, v, sink):
    B, S, Hq, hd = q.shape
    Hkv = k.shape[2]
    G = Hq // Hkv
    nblk = S // Q_BLOCK
    span = Q_BLOCK + 2 * WINDOW
    scale = hd ** -0.5
    pad = ((0, 0), (WINDOW, WINDOW), (0, 0), (0, 0))
    kp = jnp.pad(k, pad)
    vp = jnp.pad(v, pad)
    qb = q.reshape(B, nblk, Q_BLOCK, Hkv, G, hd).transpose(1, 0, 2, 3, 4, 5)
    slopes = alibi_slopes(Hq).reshape(Hkv, G)
    sink_f = sink.astype(jnp.float32).reshape(Hkv, G)

    def blk(args):
        i, qi = args
        start = i * Q_BLOCK
        ks = lax.dynamic_slice_in_dim(kp, start, span, axis=1)
        vs = lax.dynamic_slice_in_dim(vp, start, span, axis=1)
        qpos = start + jnp.arange(Q_BLOCK)
        kpos = start - WINDOW + jnp.arange(span)
        dist = jnp.abs(qpos[:, None] - kpos[None, :])
        valid = (dist <= WINDOW) & (kpos >= 0)[None, :] & (kpos < S)[None, :]
        s = jnp.einsum('bqkgd,bskd->bkgqs', qi, ks).astype(jnp.float32) * scale
        s = s - slopes[:, :, None, None] * dist.astype(jnp.float32)[None, None]
        s = jnp.where(valid[None, None, None], s, -jnp.inf)
        sink_col = jnp.broadcast_to(sink_f[None, :, :, None, None], s.shape[:-1] + (1,))
        p = jax.nn.softmax(jnp.concatenate([s, sink_col], axis=-1), axis=-1)[..., :-1]
        return jnp.einsum('bkgqs,bskd->bqkgd', p.astype(v.dtype), vs)

    out = lax.map(blk, (jnp.arange(nblk), qb))
    return out.transpose(1, 0, 2, 3, 4, 5).reshape(B, S, Hq * hd)


def token_mixer(h, w_in, w_gate, na_q_norm, na_k_norm, na_rel_bias, ga_q_norm, ga_k_norm,
                sw_q_norm, sw_k_norm, sw_sink, w_branch, w_out):
    B, S, _ = h.shape
    widths = (NA_W, NA_W, NA_W, GA_QW, GA_KW, GA_KW, SW_QW, SW_KW, SW_KW)
    cuts = []
    acc = 0
    for wdt in widths[:-1]:
        acc += wdt
        cuts.append(acc)
    qa, ka, va, qb, kb, vb, qc, kc, vc = jnp.split(h @ w_in, cuts, axis=-1)

    def heads(t, n):
        return t.reshape(B, S, n, HEAD_DIM)

    t = jnp.arange(S)
    row = t // GRID_W
    col = t % GRID_W
    o_a = neighborhood_attention(rms_norm(heads(qa, NA_HEADS), na_q_norm),
                                 rms_norm(heads(ka, NA_HEADS), na_k_norm),
                                 heads(va, NA_HEADS), na_rel_bias)
    o_b = global_attention(axial_rope(rms_norm(heads(qb, GA_HEADS), ga_q_norm), row, col),
                           axial_rope(rms_norm(heads(kb, GA_KV_HEADS), ga_k_norm), row, col),
                           heads(vb, GA_KV_HEADS))
    o_c = sliding_window_attention(rms_norm(heads(qc, SW_HEADS), sw_q_norm),
                                   rms_norm(heads(kc, SW_KV_HEADS), sw_k_norm),
                                   heads(vc, SW_KV_HEADS), sw_sink)
    merged = None
    for i, o in enumerate((o_a, o_b, o_c)):
        term = jax.nn.sigmoid(h @ w_gate[i]) * (o @ w_branch[i])
        merged = term if merged is None else merged + term
    return merged @ w_out


def trunk(x, ffn1_norm, ffn1_wg, ffn1_wu, ffn1_wd, mix_norm, w_in, w_gate, na_q_norm, na_k_norm,
          na_rel_bias, ga_q_norm, ga_k_norm, sw_q_norm, sw_k_norm, sw_sink, w_branch, w_out,
          ffn2_norm, ffn2_wg, ffn2_wu, ffn2_wd):
    for l in range(DEPTH):
        x = x + 0.5 * swiglu(rms_norm(x, ffn1_norm[l]), ffn1_wg[l], ffn1_wu[l], ffn1_wd[l])
        x = x + token_mixer(rms_norm(x, mix_norm[l]), w_in[l], w_gate[l], na_q_norm[l], na_k_norm[l],
                            na_rel_bias[l], ga_q_norm[l], ga_k_norm[l], sw_q_norm[l], sw_k_norm[l],
                            sw_sink[l], w_branch[l], w_out[l])
        x = x + 0.5 * swiglu(rms_norm(x, ffn2_norm[l]), ffn2_wg[l], ffn2_wu[l], ffn2_wd[l])
    return x


def setup_inputs(seed: int = 0) -> dict:
    key = jax.random.key(seed)
    ks = iter(jax.random.split(key, 32))

    def nrm(shape, scale):
        return jax.random.normal(next(ks), shape, jnp.float32) * scale

    def gain(shape):
        return 1.0 + 0.02 * jax.random.normal(next(ks), shape, jnp.float32)

    d = D_MODEL
    return dict(
        x_prompt=nrm((BATCH, SEQ, d), 1.0),
        x_sample=nrm((DEC_BATCH, DEC_SEQ, d), 1.0),
        ffn1_norm=gain((DEPTH, d)),
        ffn1_wg=nrm((DEPTH, d, D_FF), d ** -0.5),
        ffn1_wu=nrm((DEPTH, d, D_FF), d ** -0.5),
        ffn1_wd=nrm((DEPTH, D_FF, d), D_FF ** -0.5),
        mix_norm=gain((DEPTH, d)),
        w_in=nrm((DEPTH, d, D_IN), d ** -0.5),
        w_gate=nrm((DEPTH, N_BRANCH, d, d), d ** -0.5),
        na_q_norm=gain((DEPTH, HEAD_DIM)),
        na_k_norm=gain((DEPTH, HEAD_DIM)),
        na_rel_bias=nrm((DEPTH, NA_HEADS, 2 * NA_ROWS - 1, 2 * NA_COLS - 1), 0.5),
        ga_q_norm=gain((DEPTH, HEAD_DIM)),
        ga_k_norm=gain((DEPTH, HEAD_DIM)),
        sw_q_norm=gain((DEPTH, HEAD_DIM)),
        sw_k_norm=gain((DEPTH, HEAD_DIM)),
        sw_sink=nrm((DEPTH, SW_HEADS), 1.0),
        w_branch=nrm((DEPTH, N_BRANCH, BRANCH_W, d), BRANCH_W ** -0.5),
        w_out=nrm((DEPTH, d, d), d ** -0.5),
        ffn2_norm=gain((DEPTH, d)),
        ffn2_wg=nrm((DEPTH, d, D_FF), d ** -0.5),
        ffn2_wu=nrm((DEPTH, d, D_FF), d ** -0.5),
        ffn2_wd=nrm((DEPTH, D_FF, d), D_FF ** -0.5),
    )


def reference(x_prompt, x_sample, ffn1_norm, ffn1_wg, ffn1_wu, ffn1_wd, mix_norm, w_in, w_gate,
              na_q_norm, na_k_norm, na_rel_bias, ga_q_norm, ga_k_norm, sw_q_norm, sw_k_norm,
              sw_sink, w_branch, w_out, ffn2_norm, ffn2_wg, ffn2_wu, ffn2_wd):
    y_prompt = trunk(x_prompt, ffn1_norm, ffn1_wg, ffn1_wu, ffn1_wd, mix_norm, w_in, w_gate,
                     na_q_norm, na_k_norm, na_rel_bias, ga_q_norm, ga_k_norm, sw_q_norm, sw_k_norm,
                     sw_sink, w_branch, w_out, ffn2_norm, ffn2_wg, ffn2_wu, ffn2_wd)
    y_sample = trunk(x_sample, ffn1_norm, ffn1_wg, ffn1_wu, ffn1_wd, mix_norm, w_in, w_gate,
                     na_q_norm, na_k_norm, na_rel_bias, ga_q_norm, ga_k_norm, sw_q_norm, sw_k_norm,
                     sw_sink, w_branch, w_out, ffn2_norm, ffn2_wg, ffn2_wu, ffn2_wd)
    return (y_prompt, y_sample)
```

```cpp
#include <hip/hip_runtime.h>
#include <cstdio>
#include <cstdint>

#ifndef MK_ONE_LAUNCH
#define MK_ONE_LAUNCH 1
#endif

namespace pg8 {
#define PG8_LAS __attribute__((address_space(3)))
typedef unsigned short bf16_t;
typedef short bf16x8 __attribute__((ext_vector_type(8)));
typedef float f32x4 __attribute__((ext_vector_type(4)));
typedef unsigned u32x4 __attribute__((ext_vector_type(4)));
constexpr int BM = 256, BK = 64, HALF = 128, HTB = HALF * BK * 2  , STAGE_BYTES = 8 * HTB, NXCD = 8, WGM = 8;

__host__ __device__ __forceinline__ int lds_byte(int r, int c) { const int st = (r >> 4) * 2 + (c >> 5), rr = r & 15, cc = c & 31, ob = rr * 64 + cc * 2; return st * 1024 + (ob ^ (((ob >> 9) & 1) << 5)); }
__host__ __device__ __forceinline__ void stage_rc(int b, int& R, int& C) { const int st = b / 1024, sb = b % 1024, swz = sb ^ (((sb >> 9) & 1) << 5); R = (st >> 1) * 16 + swz / 64; C = (st & 1) * 32 + (swz % 64) / 2; }
__host__ __device__ __forceinline__ int perm32(int rho) { const int n = rho >> 4, i = rho & 15; return 8 * (i >> 2) + 4 * n + (i & 3); }

struct Unit { int pm, pn; };
struct Gemm { const bf16_t* A; const bf16_t* Bt; int M, N, K, lda, ldb, grp, grp_a; };

struct StaticOrder {
    int nM, nN, nwg, G, c;
    __host__ __device__ void init(int M, int N, int G_, int c_) { nM = M / BM; nN = N / BM; nwg = nM * nN; G = G_; c = c_; }
    __host__ __device__ bool next(int i, Unit& u) const {
        const long L = (long)i * G + c; if (L >= nwg) return false;
        int wgid = (int)L; { const int q = nwg / NXCD, r = nwg % NXCD, xcd = wgid % NXCD, off = wgid / NXCD; wgid = (xcd < r ? xcd * (q + 1) : r * (q + 1) + (xcd - r) * q) + off; }
        const int nig = WGM * nN, gid = wgid / nig, fm = gid * WGM, gsz = (nM - fm) < WGM ? (nM - fm) : WGM;
        u.pm = fm + ((wgid % nig) % gsz); u.pn = (wgid % nig) / gsz; return true;
    }
    __device__ __forceinline__ void a_ready(const Unit&) const {}
    __device__ __forceinline__ void done(const Unit&) const {}
};

__device__ __forceinline__ unsigned cvt_pk_bf16(float lo, float hi) { unsigned r; asm volatile("v_cvt_pk_bf16_f32 %0, %1, %2" : "=v"(r) : "v"(lo), "v"(hi)); return r; }
__device__ __forceinline__ float bf_lo(unsigned w) { return __uint_as_float(w << 16); }
__device__ __forceinline__ float bf_hi(unsigned w) { return __uint_as_float(w & 0xffff0000u); }
__device__ __forceinline__ float sigmoid_f(float x) { return __builtin_amdgcn_rcpf(1.0f + __builtin_amdgcn_exp2f(-1.4426950408889634f * x)); }

struct EpiBf16 {
    static constexpr bool PERM = true, AFTER_DRAIN = false;
    bf16_t* O; int ldc;
    __device__ __forceinline__ void operator()(const f32x4 (&acc)[2][2][4][2], const Unit& u, int wr, int wc, int fr, int fq) const {
        const int row0 = u.pm * BM + wr * 64 + fr, col0 = u.pn * BM + wc * 32 + 8 * fq;
#pragma unroll
        for (int ai = 0; ai < 2; ++ai)
#pragma unroll
            for (int m = 0; m < 4; ++m) { bf16_t* rowp = O + (size_t)(row0 + ai * HALF + m * 16) * ldc + col0;
#pragma unroll
                for (int bj = 0; bj < 2; ++bj) { const f32x4 v0 = acc[ai][bj][m][0], v1 = acc[ai][bj][m][1];
                    u32x4 w; w.x = cvt_pk_bf16(v0[0], v0[1]); w.y = cvt_pk_bf16(v0[2], v0[3]); w.z = cvt_pk_bf16(v1[0], v1[1]); w.w = cvt_pk_bf16(v1[2], v1[3]);
                    *(u32x4*)(rowp + bj * HALF) = w; } }
    }
};
struct EpiSwiglu {
    static constexpr bool PERM = true, AFTER_DRAIN = false;
    bf16_t* O; int ldc;
    __device__ __forceinline__ void operator()(const f32x4 (&acc)[2][2][4][2], const Unit& u, int wr, int wc, int fr, int fq) const {
        const int row0 = u.pm * BM + wr * 64 + fr, col0 = u.pn * HALF + wc * 32 + 8 * fq;
#pragma unroll
        for (int ai = 0; ai < 2; ++ai)
#pragma unroll
            for (int m = 0; m < 4; ++m) { bf16_t* rowp = O + (size_t)(row0 + ai * HALF + m * 16) * ldc + col0;
                float h[8];
#pragma unroll
                for (int n = 0; n < 2; ++n)
#pragma unroll
                    for (int j = 0; j < 4; ++j) { const float g = acc[ai][0][m][n][j], up = acc[ai][1][m][n][j]; h[n * 4 + j] = g * sigmoid_f(g) * up; }
                u32x4 w; w.x = cvt_pk_bf16(h[0], h[1]); w.y = cvt_pk_bf16(h[2], h[3]); w.z = cvt_pk_bf16(h[4], h[5]); w.w = cvt_pk_bf16(h[6], h[7]);
                *(u32x4*)rowp = w; }
    }
};
struct EpiResid {
    static constexpr bool PERM = false, AFTER_DRAIN = false;
    const float* base; float* out; int ldc; float alpha;
    __device__ __forceinline__ void operator()(const f32x4 (&acc)[2][2][4][2], const Unit& u, int wr, int wc, int fr, int fq) const {
        const int row0 = u.pm * BM + wr * 64 + fr, col0 = u.pn * BM + wc * 32 + 4 * fq;
#pragma unroll
        for (int ai = 0; ai < 2; ++ai)
#pragma unroll
            for (int m = 0; m < 4; ++m) { const size_t off = (size_t)(row0 + ai * HALF + m * 16) * ldc + col0;
#pragma unroll
                for (int bj = 0; bj < 2; ++bj)
#pragma unroll
                    for (int n = 0; n < 2; ++n) { const f32x4 b = *(const f32x4*)(base + off + bj * HALF + n * 16); *(f32x4*)(out + off + bj * HALF + n * 16) = b + acc[ai][bj][m][n] * alpha; } }
    }
};
struct EpiGate {
    static constexpr bool PERM = true, AFTER_DRAIN = false;
    bf16_t* P; int ldc;
    __device__ __forceinline__ void operator()(const f32x4 (&acc)[2][2][4][2], const Unit& u, int wr, int wc, int fr, int fq) const {
        const int row0 = u.pm * BM + wr * 64 + fr, col0 = u.pn * BM + wc * 32 + 8 * fq;
#pragma unroll
        for (int ai = 0; ai < 2; ++ai)
#pragma unroll
            for (int m = 0; m < 4; ++m) { bf16_t* rowp = P + (size_t)(row0 + ai * HALF + m * 16) * ldc + col0;
#pragma unroll
                for (int bj = 0; bj < 2; ++bj) { const f32x4 v0 = acc[ai][bj][m][0], v1 = acc[ai][bj][m][1]; const u32x4 b = *(const u32x4*)(rowp + bj * HALF);
                    u32x4 w;
                    w.x = cvt_pk_bf16(sigmoid_f(v0[0]) * bf_lo(b.x), sigmoid_f(v0[1]) * bf_hi(b.x)); w.y = cvt_pk_bf16(sigmoid_f(v0[2]) * bf_lo(b.y), sigmoid_f(v0[3]) * bf_hi(b.y));
                    w.z = cvt_pk_bf16(sigmoid_f(v1[0]) * bf_lo(b.z), sigmoid_f(v1[1]) * bf_hi(b.z)); w.w = cvt_pk_bf16(sigmoid_f(v1[2]) * bf_lo(b.w), sigmoid_f(v1[3]) * bf_hi(b.w));
                    *(u32x4*)(rowp + bj * HALF) = w; } }
    }
};

template <class Epi, class Sched, bool ALIGN_EPI = false, bool SP2 = false>
__device__ __forceinline__ void gemm_phase(PG8_LAS unsigned char* lds, const Gemm g, const Sched& S, const Epi& E, const int tid) {
    const int wid = __builtin_amdgcn_readfirstlane(tid >> 6), lane = tid & 63, wr = wid >> 2, wc = wid & 3, fr = lane & 15, fq = lane >> 4;
    const int K = g.K, nt = K / BK;
    unsigned voffA[2], voffB[2];
#pragma unroll
    for (int i = 0; i < 2; ++i) { int R, C; stage_rc(tid * 16 + i * 8192, R, C); const int Rb = Epi::PERM ? ((R & ~31) + perm32(R & 31)) : R;
        voffA[i] = (unsigned)(R * g.lda + C) * 2u; voffB[i] = (unsigned)(Rb * g.ldb + C) * 2u; }
    const size_t kstep = (size_t)(BK * 2);
    const size_t hstepA = (size_t)HALF * g.lda * 2, hstepB = (size_t)HALF * g.ldb * 2;
    const size_t tstepA = 2 * hstepA, tstepB = 2 * hstepB;
    const unsigned ldsw = (unsigned)wid * 1024u;
    const int aoff = lds_byte(wr * 64 + fr, fq * 8), boff = lds_byte(wc * 32 + fr, fq * 8);
#define PG8_ABASE(u) ((const char*)g.A + (size_t)(u).pm * tstepA + (g.grp ? (size_t)(((u).pn / g.grp) * g.grp_a) * 2 : (size_t)0))
#define PG8_BBASE(u) ((const char*)g.Bt + (size_t)(u).pn * tstepB)
#define PG8_SA(b, h) (((b) * 2 + (h)) * HTB)
#define PG8_SB(b, h) ((4 + (b) * 2 + (h)) * HTB)
#define PG8_STAGE(bufoff, gbase, voff) do { _Pragma("unroll") for (int _i = 0; _i < 2; ++_i) \
        __builtin_amdgcn_global_load_lds((const unsigned*)((const char*)(gbase) + (voff)[_i]), (PG8_LAS unsigned*)(lds + (bufoff) + ldsw + _i * 8192), 16, 0, 0); } while (0)
#define PG8_LDA(dst, b, h) do { _Pragma("unroll") for (int m = 0; m < 4; ++m) _Pragma("unroll") for (int k = 0; k < 2; ++k) dst[m][k] = *(const PG8_LAS bf16x8*)(lds + PG8_SA(b, h) + aoff + m * 2048 + k * 1024); } while (0)
#define PG8_LDB(dst, b, h) do { _Pragma("unroll") for (int n = 0; n < 2; ++n) _Pragma("unroll") for (int k = 0; k < 2; ++k) dst[n][k] = *(const PG8_LAS bf16x8*)(lds + PG8_SB(b, h) + boff + n * 2048 + k * 1024); } while (0)
#define PG8_MMA(ai, bj, At, Bt) do { __builtin_amdgcn_s_setprio(1); _Pragma("unroll") for (int m = 0; m < 4; ++m) _Pragma("unroll") for (int n = 0; n < 2; ++n) _Pragma("unroll") for (int k = 0; k < 2; ++k) \
        acc[ai][bj][m][n] = __builtin_amdgcn_mfma_f32_16x16x32_bf16(Bt[n][k], At[m][k], acc[ai][bj][m][n], 0, 0, 0); __builtin_amdgcn_s_setprio(0); } while (0)
#define PG8_WAIT_V(n) asm volatile("s_waitcnt vmcnt(" #n ")" ::: "memory")
#define PG8_WAIT_L(n) asm volatile("s_waitcnt lgkmcnt(" #n ")" ::: "memory")
#define PG8_BAR __builtin_amdgcn_s_barrier()
#define PG8_SCHED __builtin_amdgcn_sched_barrier(0)
    Unit cur, nxt; int ui = 0;
    if (!S.next(0, cur)) return;
    f32x4 acc[2][2][4][2];
#pragma unroll
    for (int a = 0; a < 2; ++a)
#pragma unroll
        for (int b = 0; b < 2; ++b)
#pragma unroll
            for (int m = 0; m < 4; ++m)
#pragma unroll
                for (int n = 0; n < 2; ++n) acc[a][b][m][n] = (f32x4){0.f, 0.f, 0.f, 0.f};
    bf16x8 At[4][2], B0[2][2], B1[2][2];
    const char* cA = PG8_ABASE(cur); const char* cB = PG8_BBASE(cur);
    S.a_ready(cur);
    if constexpr (SP2) {
        PG8_STAGE(PG8_SB(0, 0), cB, voffB); PG8_STAGE(PG8_SB(0, 1), cB + hstepB, voffB); PG8_STAGE(PG8_SA(0, 0), cA, voffA); PG8_STAGE(PG8_SA(0, 1), cA + hstepA, voffA);
        if (wr == 1) PG8_BAR;
        PG8_WAIT_V(2); PG8_BAR;
        PG8_STAGE(PG8_SB(1, 0), cB + kstep, voffB); PG8_STAGE(PG8_SA(1, 0), cA + kstep, voffA); PG8_STAGE(PG8_SB(1, 1), cB + hstepB + kstep, voffB);
        PG8_WAIT_V(6); PG8_BAR;
    } else {
        PG8_STAGE(PG8_SB(0, 0), cB, voffB); PG8_STAGE(PG8_SA(0, 0), cA, voffA); PG8_STAGE(PG8_SB(0, 1), cB + hstepB, voffB); PG8_STAGE(PG8_SA(0, 1), cA + hstepA, voffA);
        if (wr == 1) PG8_BAR;
        PG8_WAIT_V(4); PG8_BAR;
        PG8_STAGE(PG8_SB(1, 0), cB + kstep, voffB); PG8_STAGE(PG8_SA(1, 0), cA + kstep, voffA); PG8_STAGE(PG8_SB(1, 1), cB + hstepB + kstep, voffB);
        PG8_WAIT_V(6); PG8_BAR;
    }
    for (;;) {
        const bool has_next = S.next(ui + 1, nxt);
        const char* nA = has_next ? PG8_ABASE(nxt) : cA; const char* nB = has_next ? PG8_BBASE(nxt) : cB;
        for (int t = 0; t < nt; t += 2) {
            const bool last = (t == nt - 2);
            const char* a1 = cA + (size_t)(t + 1) * kstep;
            const char* a2 = last ? nA : cA + (size_t)(t + 2) * kstep; const char* b2 = last ? nB : cB + (size_t)(t + 2) * kstep;
            const char* a3 = a2 + kstep; const char* b3 = b2 + kstep;
            if (last && has_next) S.a_ready(nxt);
            if constexpr (SP2) {
            PG8_LDB(B0, 0, 0); PG8_LDB(B1, 0, 1); PG8_SCHED; PG8_LDA(At, 0, 0); PG8_STAGE(PG8_SA(1, 1), a1 + hstepA, voffA);
            PG8_WAIT_V(8); PG8_WAIT_L(0); PG8_BAR; PG8_MMA(0, 0, At, B0); PG8_MMA(0, 1, At, B1); PG8_BAR; PG8_SCHED;
            PG8_LDA(At, 0, 1); PG8_STAGE(PG8_SB(0, 0), b2, voffB); PG8_STAGE(PG8_SB(0, 1), b2 + hstepB, voffB); PG8_STAGE(PG8_SA(0, 0), a2, voffA);
            PG8_WAIT_V(8); PG8_WAIT_L(0); PG8_BAR; PG8_MMA(1, 0, At, B0); PG8_MMA(1, 1, At, B1); PG8_BAR; PG8_SCHED;
            PG8_LDB(B0, 1, 0); PG8_LDB(B1, 1, 1); PG8_SCHED; PG8_LDA(At, 1, 0); PG8_STAGE(PG8_SA(0, 1), a2 + hstepA, voffA);
            PG8_WAIT_V(8); PG8_WAIT_L(0); PG8_BAR; PG8_MMA(0, 0, At, B0); PG8_MMA(0, 1, At, B1); PG8_BAR; PG8_SCHED;
            PG8_LDA(At, 1, 1); PG8_STAGE(PG8_SB(1, 0), b3, voffB); PG8_STAGE(PG8_SB(1, 1), b3 + hstepB, voffB); PG8_STAGE(PG8_SA(1, 0), a3, voffA);
            PG8_WAIT_V(8); PG8_WAIT_L(0); PG8_BAR; PG8_MMA(1, 0, At, B0); PG8_MMA(1, 1, At, B1); PG8_BAR; PG8_SCHED;
            } else {
            PG8_LDB(B0, 0, 0); PG8_SCHED; PG8_LDA(At, 0, 0); PG8_STAGE(PG8_SA(1, 1), a1 + hstepA, voffA);
            PG8_WAIT_L(8); PG8_BAR; PG8_WAIT_L(0); PG8_MMA(0, 0, At, B0); PG8_BAR; PG8_SCHED;
            PG8_LDB(B1, 0, 1); PG8_STAGE(PG8_SB(0, 0), b2, voffB);
            PG8_BAR; PG8_WAIT_L(0); PG8_MMA(0, 1, At, B1); PG8_BAR;
            PG8_LDA(At, 0, 1); PG8_STAGE(PG8_SA(0, 0), a2, voffA);
            PG8_BAR; PG8_WAIT_L(0); PG8_MMA(1, 0, At, B0); PG8_BAR; PG8_SCHED;
            PG8_STAGE(PG8_SB(0, 1), b2 + hstepB, voffB);
            PG8_WAIT_V(6); PG8_BAR; PG8_MMA(1, 1, At, B1); PG8_BAR;
            PG8_LDB(B0, 1, 0); PG8_SCHED; PG8_LDA(At, 1, 0); PG8_STAGE(PG8_SA(0, 1), a2 + hstepA, voffA);
            PG8_WAIT_L(8); PG8_BAR; PG8_WAIT_L(0); PG8_MMA(0, 0, At, B0); PG8_BAR; PG8_SCHED;
            PG8_LDB(B1, 1, 1); PG8_STAGE(PG8_SB(1, 0), b3, voffB);
            PG8_BAR; PG8_WAIT_L(0); PG8_MMA(0, 1, At, B1); PG8_BAR;
            PG8_LDA(At, 1, 1); PG8_STAGE(PG8_SA(1, 0), a3, voffA);
            PG8_BAR; PG8_WAIT_L(0); PG8_MMA(1, 0, At, B0); PG8_BAR; PG8_SCHED;
            PG8_STAGE(PG8_SB(1, 1), b3 + hstepB, voffB);
            PG8_WAIT_V(6); PG8_BAR; PG8_MMA(1, 1, At, B1); PG8_BAR;
            }
        }
        if constexpr (ALIGN_EPI) { if (wr == 0) PG8_BAR; }
        if constexpr (!Epi::AFTER_DRAIN) { E(acc, cur, wr, wc, fr, fq); S.done(cur); }
        if (!has_next) break;
#pragma unroll
        for (int a = 0; a < 2; ++a)
#pragma unroll
            for (int b = 0; b < 2; ++b)
#pragma unroll
                for (int m = 0; m < 4; ++m)
#pragma unroll
                    for (int n = 0; n < 2; ++n) acc[a][b][m][n] = (f32x4){0.f, 0.f, 0.f, 0.f};
        cur = nxt; cA = nA; cB = nB; ++ui;
        if constexpr (ALIGN_EPI) { if (wr == 1) PG8_BAR; }
    }
    PG8_WAIT_V(0);
    if constexpr (!ALIGN_EPI) { if (wr == 0) PG8_BAR; }
    PG8_BAR;
#undef PG8_ABASE
#undef PG8_BBASE
#undef PG8_SA
#undef PG8_SB
#undef PG8_STAGE
#undef PG8_LDA
#undef PG8_LDB
#undef PG8_MMA
#undef PG8_WAIT_V
#undef PG8_WAIT_L
#undef PG8_BAR
#undef PG8_SCHED
}
}

namespace att {
using bf16 = unsigned short;
constexpr int D = 128, NW = 8, QBLK = 32, KVBLK = 64;
constexpr float SCALE = 0.088388347648318440f;
constexpr float THR = 8.f;
constexpr float NEG = -1.0e5f;
constexpr int LDQ = 6144, LDK = 6144, LDO = 3072;
constexpr size_t SHM_V = KVBLK * D * 2, SHM_K = KVBLK * D * 2, SHM_ATTN = 2 * SHM_V + 2 * SHM_K + NW * 64 * 4;
constexpr int TBL_OFF = 69632;

using bf16x8 = __attribute__((ext_vector_type(8))) short;
using s16x4  = __attribute__((ext_vector_type(4))) short;
using f32x16 = __attribute__((ext_vector_type(16))) float;
using u32x4  = __attribute__((ext_vector_type(4))) unsigned;
#define KSWZ(row, colB) ((row) * 256 + ((colB) ^ (((row) & 7) << 4)))
#define SBAR() __builtin_amdgcn_sched_barrier(0)
__device__ __forceinline__ int crow(int r, int hi) { return (r & 3) + 8 * (r >> 2) + 4 * hi; }
__device__ __forceinline__ unsigned cvtpk(float lo, float hi) { unsigned r; asm volatile("v_cvt_pk_bf16_f32 %0, %1, %2" : "=v"(r) : "v"(lo), "v"(hi)); return r; }

struct Par { int qpos0, kpos0, r0, rows, kr0; float slopeR, sinkR; };

__device__ __forceinline__ void partialSM(f32x16& p0, f32x16& p1, float& m_reg, float& mn, float& alpha) {
  constexpr float C = SCALE * 1.4426950408889634f;
  float pmax = p0[0]; for (int r = 1; r < 16; ++r) pmax = fmaxf(pmax, p0[r]); for (int r = 0; r < 16; ++r) pmax = fmaxf(pmax, p1[r]);
  { auto rr = __builtin_amdgcn_permlane32_swap(__float_as_uint(pmax), __float_as_uint(pmax), false, false);
    pmax = fmaxf(__uint_as_float(rr[0]), __uint_as_float(rr[1])); }
  if (__builtin_expect(__all(pmax - m_reg <= THR / SCALE), 1)) { mn = m_reg; alpha = 1.f; }
  else { mn = fmaxf(m_reg, pmax); alpha = __builtin_amdgcn_exp2f((m_reg - mn) * C); m_reg = mn; }
  float mnC = -mn * C;
  for (int r = 0; r < 16; ++r) p0[r] = fmaf(p0[r], C, mnC); for (int r = 0; r < 16; ++r) p1[r] = fmaf(p1[r], C, mnC);
  for (int r = 0; r < 16; ++r) p0[r] = __builtin_amdgcn_exp2f(p0[r]);
}
__device__ __forceinline__ void finishSM(f32x16& p0, f32x16& p1, float alpha, float& l_reg, bf16x8& pa0, bf16x8& pa1, bf16x8& pa2, bf16x8& pa3) {
  for (int r = 0; r < 16; ++r) p1[r] = __builtin_amdgcn_exp2f(p1[r]);
  float ps = 0; for (int r = 0; r < 16; ++r) ps += p0[r]; for (int r = 0; r < 16; ++r) ps += p1[r];
  { auto rr = __builtin_amdgcn_permlane32_swap(__float_as_uint(ps), __float_as_uint(ps), false, false);
    ps = __uint_as_float(rr[0]) + __uint_as_float(rr[1]); }
  l_reg = l_reg * alpha + ps;
#define PK4(P, BASE, OUT) do { unsigned a0 = cvtpk(P[BASE + 0], P[BASE + 1]), a1 = cvtpk(P[BASE + 2], P[BASE + 3]);   \
    unsigned b0 = cvtpk(P[BASE + 4], P[BASE + 5]), b1 = cvtpk(P[BASE + 6], P[BASE + 7]);                              \
    auto r0 = __builtin_amdgcn_permlane32_swap(a0, b0, false, false); auto r1 = __builtin_amdgcn_permlane32_swap(a1, b1, false, false); \
    u32x4 w = {r0[0], r1[0], r0[1], r1[1]}; OUT = *reinterpret_cast<bf16x8*>(&w); } while (0)
  PK4(p0, 0, pa0); PK4(p0, 8, pa1); PK4(p1, 0, pa2); PK4(p1, 8, pa3);
#undef PK4
}
__device__ __forceinline__ void qkt(f32x16& p0, f32x16& p1, const bf16* Ks, const bf16x8* qr, int r32, int hi) {
  p0 = f32x16{}; p1 = f32x16{};
  for (int d0 = 0; d0 < 8; ++d0) { int cb = (d0 * 16 + hi * 8) * 2;
    bf16x8 b0 = *reinterpret_cast<const bf16x8*>((const char*)Ks + KSWZ(r32, cb));
    bf16x8 b1 = *reinterpret_cast<const bf16x8*>((const char*)Ks + KSWZ(32 + r32, cb));
    p0 = __builtin_amdgcn_mfma_f32_32x32x16_bf16(b0, qr[d0], p0, 0, 0, 0);
    p1 = __builtin_amdgcn_mfma_f32_32x32x16_bf16(b1, qr[d0], p1, 0, 0, 0); }
}
template <int MODE>
__device__ __forceinline__ void modify(f32x16& p0, f32x16& p1, int jt, const Par& P, int wid, int r32, int hi, const float* tbl) {
  if constexpr (MODE == 1) {
    const int qpos = P.qpos0 + wid * 32 + r32, kb = P.kpos0 + 64 * jt;
#pragma unroll
    for (int r = 0; r < 16; ++r) { const int kp = kb + crow(r, hi); int d0 = qpos - kp; d0 = d0 < 0 ? -d0 : d0; int d1 = qpos - (kp + 32); d1 = d1 < 0 ? -d1 : d1;
      p0[r] = (d0 <= 128) ? p0[r] - P.slopeR * (float)d0 : NEG; p1[r] = (d1 <= 128) ? p1[r] - P.slopeR * (float)d1 : NEG; }
  }
  if constexpr (MODE == 2) {
    const int r = P.r0 + (wid >> 1), c = 32 * (wid & 1) + r32;
    int rs = r - 4; rs = rs < 0 ? 0 : rs; rs = rs > P.rows - 8 ? P.rows - 8 : rs;
    int cs = c - 8; cs = cs < 0 ? 0 : cs; cs = cs > 48 ? 48 : cs;
    const int kr = P.kr0 + jt;
    if ((unsigned)(kr - rs) < 8u) {
      const float* tb = tbl + (kr - r + 7) * 32;
      int A = 4 * hi - cs, B = 4 * hi + 15 - c; asm volatile("" : "+v"(A), "+v"(B));
#pragma unroll
      for (int q = 0; q < 16; ++q) { const int kq = (q & 3) + 8 * (q >> 2);
        const int i0 = ((unsigned)(kq + A) < 16u) ? kq + B : 31, i1 = ((unsigned)(kq + 32 + A) < 16u) ? kq + 32 + B : 31;
        p0[q] += tb[i0]; p1[q] += tb[i1];
        if ((q & 3) == 3) asm volatile("" ::: "memory"); }
    } else {
#pragma unroll
      for (int q = 0; q < 16; ++q) { p0[q] = NEG; p1[q] = NEG; }
    }
  }
}
__device__ __forceinline__ int v_st(int k, int c) { const int kk = (k & ~0xC) | ((k & 4) << 1) | ((k & 8) >> 1); return ((kk >> 3) * 4 + (c >> 5)) * 512 + ((kk & 7) * 32 + (c & 31)) * 2; }
__device__ __forceinline__ int v_rd_base(int lane) { return ((lane & 3) << 3) | (((lane >> 2) & 3) << 6) | (((lane >> 4) & 1) << 5) | (((lane >> 5) & 1) << 8); }
constexpr int v_rd_off(int d0, int ks, int half) { return d0 * 512 + ks * 4096 + half * 2048; }
template <int OFF> __device__ __forceinline__ s16x4 tr_read(int vb) {
  s16x4 r; asm volatile("ds_read_b64_tr_b16 %0, %1 offset:%2" : "=&v"(r) : "v"(vb), "i"(OFF) : "memory"); return r;
}
template <int D0> __device__ __forceinline__ void pv_one(f32x16& od, int vb, bf16x8 pa0, bf16x8 pa1, bf16x8 pa2, bf16x8 pa3) {
  const s16x4 l0 = tr_read<v_rd_off(D0, 0, 0)>(vb), h0 = tr_read<v_rd_off(D0, 0, 1)>(vb), l1 = tr_read<v_rd_off(D0, 1, 0)>(vb), h1 = tr_read<v_rd_off(D0, 1, 1)>(vb);
  const s16x4 l2 = tr_read<v_rd_off(D0, 2, 0)>(vb), h2 = tr_read<v_rd_off(D0, 2, 1)>(vb), l3 = tr_read<v_rd_off(D0, 3, 0)>(vb), h3 = tr_read<v_rd_off(D0, 3, 1)>(vb);
  asm volatile("s_waitcnt lgkmcnt(0)" ::: "memory"); SBAR();
#define PK(L, H) (bf16x8){L[0], L[1], L[2], L[3], H[0], H[1], H[2], H[3]}
  od = __builtin_amdgcn_mfma_f32_32x32x16_bf16(pa0, PK(l0, h0), od, 0, 0, 0);
  od = __builtin_amdgcn_mfma_f32_32x32x16_bf16(pa1, PK(l1, h1), od, 0, 0, 0);
  od = __builtin_amdgcn_mfma_f32_32x32x16_bf16(pa2, PK(l2, h2), od, 0, 0, 0);
  od = __builtin_amdgcn_mfma_f32_32x32x16_bf16(pa3, PK(l3, h3), od, 0, 0, 0);
#undef PK
}
__device__ __forceinline__ void pv_d0(f32x16* o, int vb, bf16x8 pa0, bf16x8 pa1, bf16x8 pa2, bf16x8 pa3) {
  pv_one<0>(o[0], vb, pa0, pa1, pa2, pa3); pv_one<1>(o[1], vb, pa0, pa1, pa2, pa3); pv_one<2>(o[2], vb, pa0, pa1, pa2, pa3); pv_one<3>(o[3], vb, pa0, pa1, pa2, pa3);
}

template <int MODE>
__device__ __forceinline__ void attn_body(const bf16* __restrict__ Qb, const bf16* __restrict__ Kh, const bf16* __restrict__ Vh, bf16* __restrict__ Ob, int NT, char* lds, const Par P, const int tid) {
  const int wid = __builtin_amdgcn_readfirstlane(tid >> 6), lane = tid & 63, r32 = lane & 31, hi = lane >> 5;
  bf16* V_lds = (bf16*)lds; bf16* K_lds = (bf16*)(lds + 2 * SHM_V);
  float* ws = (float*)(lds + 2 * SHM_V + 2 * SHM_K) + wid * 64; float* li_l = ws; float* al_l = ws + 32;
  const float* tbl = (const float*)(lds + TBL_OFF);
  float m_reg = (MODE == 0) ? -1e30f : NEG, l_reg = 0; f32x16 o[4] = {}; bf16x8 qr[8];
  const unsigned qoff = (unsigned)((wid * QBLK + r32) * LDQ + hi * 8) * 2u;
#pragma unroll
  for (int d0 = 0; d0 < 8; ++d0) qr[d0] = *reinterpret_cast<const bf16x8*>((const char*)Qb + qoff + d0 * 32);
  const int sr = tid >> 4, sc = (tid & 15) * 8, vst0 = v_st(sr, sc), vst1 = v_st(32 + sr, sc);
  const unsigned kvo0 = (unsigned)(sr * LDK + sc) * 2u, kvo1 = kvo0 + (unsigned)(32 * LDK * 2);
  const int vb0 = (int)(uintptr_t)V_lds + v_rd_base(lane);
  struct { bf16x8 vs0, vs1, ks0, ks1; } sr_[2];
#define SLOAD(i, k0) do { const char* vp_ = (const char*)Vh + (size_t)(k0) * (LDK * 2); const char* kp_ = (const char*)Kh + (size_t)(k0) * (LDK * 2); \
    sr_[i].vs0 = *reinterpret_cast<const bf16x8*>(vp_ + kvo0); sr_[i].vs1 = *reinterpret_cast<const bf16x8*>(vp_ + kvo1); \
    sr_[i].ks0 = *reinterpret_cast<const bf16x8*>(kp_ + kvo0); sr_[i].ks1 = *reinterpret_cast<const bf16x8*>(kp_ + kvo1); } while (0)
#define SWRITE(b, i) do { *(bf16x8*)((char*)V_lds + (b) * SHM_V + vst0) = sr_[i].vs0;          \
    *(bf16x8*)((char*)V_lds + (b) * SHM_V + vst1) = sr_[i].vs1; int kc = sc * 2;               \
    *(bf16x8*)((char*)K_lds + (b) * SHM_K + KSWZ(sr, kc)) = sr_[i].ks0;                       \
    *(bf16x8*)((char*)K_lds + (b) * SHM_K + KSWZ(32 + sr, kc)) = sr_[i].ks1; } while (0)
#define SWAIT() asm volatile("s_waitcnt vmcnt(4)" ::: "memory")
#define RESC(a) do { if (__any((a) < 1.f)) { if (hi == 0) al_l[r32] = (a); asm volatile("s_waitcnt lgkmcnt(0)" ::: "memory"); \
    for (int d = 0; d < 4; ++d) for (int r = 0; r < 16; ++r) o[d][r] *= al_l[crow(r, hi)]; } } while (0)
  f32x16 pA0, pA1, pB0, pB1; float mnA, mnB, alA, alB; bf16x8 pa0, pa1, pa2, pa3;
  constexpr int SE = 0, SO = 1;
  SLOAD(SE, 0); asm volatile("s_waitcnt vmcnt(0)" ::: "memory"); SWRITE(0, SE); __syncthreads();
  qkt(pA0, pA1, K_lds, qr, r32, hi); modify<MODE>(pA0, pA1, 0, P, wid, r32, hi, tbl); partialSM(pA0, pA1, m_reg, mnA, alA);
  SLOAD(SO, KVBLK); if (2 < NT) SLOAD(SE, 2 * KVBLK);
  SWAIT(); SWRITE(1, SO); __syncthreads();
  for (int j = 1; j + 1 < NT; j += 2) {
    SBAR(); qkt(pB0, pB1, (bf16*)((char*)K_lds + SHM_K), qr, r32, hi); modify<MODE>(pB0, pB1, j, P, wid, r32, hi, tbl);
    finishSM(pA0, pA1, alA, l_reg, pa0, pa1, pa2, pa3); SBAR();
    SLOAD(SO, (j + 2) * KVBLK); SBAR();
    pv_d0(o, vb0, pa0, pa1, pa2, pa3); partialSM(pB0, pB1, m_reg, mnB, alB);
    __syncthreads(); SWAIT(); SWRITE(0, SE);
    RESC(alB); __syncthreads();
    SBAR(); qkt(pA0, pA1, K_lds, qr, r32, hi); modify<MODE>(pA0, pA1, j + 1, P, wid, r32, hi, tbl);
    finishSM(pB0, pB1, alB, l_reg, pa0, pa1, pa2, pa3); SBAR();
    if (j + 3 < NT) SLOAD(SE, (j + 3) * KVBLK); SBAR();
    pv_d0(o, vb0 + (int)SHM_V, pa0, pa1, pa2, pa3); partialSM(pA0, pA1, m_reg, mnA, alA);
    __syncthreads(); SWAIT(); SWRITE(1, SO);
    RESC(alA); __syncthreads();
  }
  SBAR(); qkt(pB0, pB1, (bf16*)((char*)K_lds + SHM_K), qr, r32, hi); modify<MODE>(pB0, pB1, NT - 1, P, wid, r32, hi, tbl);
  finishSM(pA0, pA1, alA, l_reg, pa0, pa1, pa2, pa3); SBAR();
  pv_d0(o, vb0, pa0, pa1, pa2, pa3); partialSM(pB0, pB1, m_reg, mnB, alB);
  __syncthreads(); RESC(alB);
  finishSM(pB0, pB1, alB, l_reg, pa0, pa1, pa2, pa3); SBAR();
  pv_d0(o, vb0 + (int)SHM_V, pa0, pa1, pa2, pa3);
  if constexpr (MODE == 1) l_reg += __builtin_amdgcn_exp2f((P.sinkR - m_reg) * (SCALE * 1.4426950408889634f));
  if (hi == 0) li_l[r32] = l_reg; asm volatile("s_waitcnt lgkmcnt(0)" ::: "memory");
  float rli[16];
#pragma unroll
  for (int r = 0; r < 16; ++r) rli[r] = __builtin_amdgcn_rcpf(li_l[crow(r, hi)]);
  const unsigned ooff = (unsigned)((wid * QBLK + 4 * hi) * LDO + r32) * 2u;
#pragma unroll
  for (int r = 0; r < 16; ++r) { const int orow0 = (r & 3) + 8 * (r >> 2);
#pragma unroll
    for (int d0 = 0; d0 < 4; ++d0) *reinterpret_cast<bf16*>((char*)Ob + ooff + (unsigned)(orow0 * LDO + d0 * 32) * 2u) = (bf16)(cvtpk(o[d0][r] * rli[r], 0.f) & 0xffffu); }
  __syncthreads();
#undef SLOAD
#undef SWRITE
#undef SWAIT
#undef RESC
}
template <int MODE>
__device__ __forceinline__ void attn_body_simple(const bf16* __restrict__ Qb, const bf16* __restrict__ Kh, const bf16* __restrict__ Vh, bf16* __restrict__ Ob, int NT, char* lds, const Par P, const int tid) {
  const int wid = __builtin_amdgcn_readfirstlane(tid >> 6), lane = tid & 63, r32 = lane & 31, hi = lane >> 5;
  char* V_lds = lds; char* K_lds = lds + 2 * SHM_V;
  float* ws = (float*)(lds + 2 * SHM_V + 2 * SHM_K) + wid * 64; float* li_l = ws; float* al_l = ws + 32;
  const float* tbl = (const float*)(lds + TBL_OFF);
  float m_reg = NEG, l_reg = 0; f32x16 o[4] = {}; bf16x8 qr[8];
  const unsigned qoff = (unsigned)((wid * QBLK + r32) * LDQ + hi * 8) * 2u;
#pragma unroll
  for (int d0 = 0; d0 < 8; ++d0) qr[d0] = *reinterpret_cast<const bf16x8*>((const char*)Qb + qoff + d0 * 32);
  const int sr = tid >> 4, sc = (tid & 15) * 8, vst0 = v_st(sr, sc), vst1 = v_st(32 + sr, sc), kst0 = KSWZ(sr, sc * 2), kst1 = KSWZ(32 + sr, sc * 2);
  const unsigned kvo0 = (unsigned)(sr * LDK + sc) * 2u, kvo1 = kvo0 + (unsigned)(32 * LDK * 2);
  const int vb0 = (int)(uintptr_t)V_lds + v_rd_base(lane);
  bf16x8 vs0, vs1, ks0, ks1;
#define SLD(k0) do { const char* vp_ = (const char*)Vh + (size_t)(k0) * (LDK * 2); const char* kp_ = (const char*)Kh + (size_t)(k0) * (LDK * 2); \
    vs0 = *reinterpret_cast<const bf16x8*>(vp_ + kvo0); vs1 = *reinterpret_cast<const bf16x8*>(vp_ + kvo1); ks0 = *reinterpret_cast<const bf16x8*>(kp_ + kvo0); ks1 = *reinterpret_cast<const bf16x8*>(kp_ + kvo1); } while (0)
  SLD(0);
  for (int jt = 0; jt < NT; ++jt) {
    const int b = jt & 1; char* Vb = V_lds + b * SHM_V; char* Kb = K_lds + b * SHM_K;
    *(bf16x8*)(Vb + vst0) = vs0; *(bf16x8*)(Vb + vst1) = vs1; *(bf16x8*)(Kb + kst0) = ks0; *(bf16x8*)(Kb + kst1) = ks1;
    if (jt + 1 < NT) SLD((jt + 1) * KVBLK);
    __syncthreads();
    f32x16 p0, p1; float mn, alpha; bf16x8 pa0, pa1, pa2, pa3;
    qkt(p0, p1, (const bf16*)Kb, qr, r32, hi); modify<MODE>(p0, p1, jt, P, wid, r32, hi, tbl);
    partialSM(p0, p1, m_reg, mn, alpha);
    if (__any(alpha < 1.f)) { if (hi == 0) al_l[r32] = alpha; asm volatile("s_waitcnt lgkmcnt(0)" ::: "memory");
      for (int d = 0; d < 4; ++d) for (int r = 0; r < 16; ++r) o[d][r] *= al_l[crow(r, hi)]; }
    finishSM(p0, p1, alpha, l_reg, pa0, pa1, pa2, pa3);
    pv_d0(o, vb0 + b * (int)SHM_V, pa0, pa1, pa2, pa3);
  }
  if constexpr (MODE == 1) l_reg += __builtin_amdgcn_exp2f((P.sinkR - m_reg) * (SCALE * 1.4426950408889634f));
  if (hi == 0) li_l[r32] = l_reg; asm volatile("s_waitcnt lgkmcnt(0)" ::: "memory");
  float rli[16];
#pragma unroll
  for (int r = 0; r < 16; ++r) rli[r] = __builtin_amdgcn_rcpf(li_l[crow(r, hi)]);
  const unsigned ooff = (unsigned)((wid * QBLK + 4 * hi) * LDO + r32) * 2u;
#pragma unroll
  for (int r = 0; r < 16; ++r) { const int orow0 = (r & 3) + 8 * (r >> 2);
#pragma unroll
    for (int d0 = 0; d0 < 4; ++d0) *reinterpret_cast<bf16*>((char*)Ob + ooff + (unsigned)(orow0 * LDO + d0 * 32) * 2u) = (bf16)(cvtpk(o[d0][r] * rli[r], 0.f) & 0xffffu); }
  __syncthreads();
#undef SLD
}
#undef KSWZ
#undef SBAR
}

constexpr int NWAVES = 8;
constexpr int DM = 2048, DFF = 5632, DIN = 6144, HD = 128, NLAYER = 2;
constexpr int MTOT = 65536, MC = 16384, NCHUNK = 4;
constexpr float EPS = 1e-6f;
constexpr int C_QA = 0, C_KA = 1024, C_VA = 2048, C_QB = 3072, C_KB = 4096, C_VB = 4352, C_QC = 4608, C_KC = 5632, C_VC = 5888;
constexpr size_t MiB = 1u << 20;
constexpr size_t WS_CTL = 0, CTL_ZERO_BYTES = 1 * MiB;
constexpr size_t WS_ROPE = 1 * MiB;
constexpr size_t WS_W = 2 * MiB;
constexpr size_t W13_BYTES = (size_t)2 * DFF * DM * 2, WD_BYTES = (size_t)DM * DFF * 2, WIN_BYTES = (size_t)DIN * DM * 2, WGATE_BYTES = (size_t)3 * DM * DM * 2,
                 WBR_BYTES = (size_t)3 * DM * 1024 * 2, WOUT3_BYTES = (size_t)DM * 3 * DM * 2;
constexpr size_t LW_W13_1 = 0, LW_WD_1 = LW_W13_1 + W13_BYTES, LW_WIN = LW_WD_1 + WD_BYTES, LW_WGATE = LW_WIN + WIN_BYTES, LW_WBR = LW_WGATE + WGATE_BYTES,
                 LW_WOUT3 = LW_WBR + WBR_BYTES, LW_W13_2 = LW_WOUT3 + WOUT3_BYTES, LW_WD_2 = LW_W13_2 + W13_BYTES, LAYER_W_BYTES = LW_WD_2 + WD_BYTES;
constexpr size_t WS_H = WS_W + NLAYER * LAYER_W_BYTES;
constexpr size_t WS_QKV = WS_H + (size_t)MC * DM * 2;
constexpr size_t WS_BB = WS_QKV + (size_t)MC * DIN * 2;
constexpr size_t WS_O = WS_BB + (size_t)MC * DIN * 2;
constexpr size_t WS_END = WS_O + (size_t)MC * 3072 * 2;
static_assert(LAYER_W_BYTES % 256 == 0 && WS_H % 256 == 0, "ws map alignment");
constexpr int CW_BAR = 4096;
constexpr int RING_OFF = 0, RING_BYTES = 131072;
constexpr int LDSCTL_OFF = RING_BYTES, MISC_OFF = LDSCTL_OFF + 320;
constexpr int LDS_BYTES = 147456;

#define GAS __attribute__((address_space(1)))
#define LAS __attribute__((address_space(3)))
typedef unsigned short bf16;
typedef unsigned v4u __attribute__((ext_vector_type(4)));
typedef unsigned v2u __attribute__((ext_vector_type(2)));
typedef float f32x4 __attribute__((ext_vector_type(4)));
typedef GAS unsigned gu32;
#define LDS_WAIT() asm volatile("s_waitcnt lgkmcnt(0)" ::: "memory")
#define VM_WAIT() asm volatile("s_waitcnt vmcnt(0)" ::: "memory")
__device__ __forceinline__ unsigned f2bf(float f) { unsigned u = __builtin_bit_cast(unsigned, f); return (u + 0x7fffu + ((u >> 16) & 1u)) >> 16; }
__device__ __forceinline__ unsigned pk2(float lo, float hi) { return f2bf(lo) | (f2bf(hi) << 16); }

__device__ __forceinline__ int launder_s(int x) { asm volatile("" : "+s"(x)); return x; }
__device__ __forceinline__ int launder_v(int x) { asm volatile("" : "+v"(x)); return x; }
__device__ __forceinline__ int lane_id_local() { unsigned m = ~0u; asm volatile("" : "+s"(m)); return (int)__builtin_amdgcn_mbcnt_hi(m, __builtin_amdgcn_mbcnt_lo(m, 0u)); }

#define XB_TMO      128
#define XB_XCNT(j)  (256  + 64 * (j))
#define XB_XSUB(j)  (1280 + 64 * (j))
#define XB_XGEN(j)  (2304 + 64 * (j))
#define XB_TOP      3328
#define XB_TOPGEN   3392
#define XCD_BAR_WORDS 3456
#define XB_SPIN_CAP (1u << 22)

__device__ __forceinline__ unsigned xb_ld(unsigned* p)              { return __hip_atomic_load(p, __ATOMIC_RELAXED, __HIP_MEMORY_SCOPE_AGENT); }
__device__ __forceinline__ unsigned xb_add(unsigned* p, unsigned v) { return __hip_atomic_fetch_add(p, v, __ATOMIC_RELAXED, __HIP_MEMORY_SCOPE_AGENT); }
__device__ __forceinline__ unsigned xb_xcc_id() { return (unsigned)__builtin_amdgcn_s_getreg((3 << 11) | 20) & 0xFu; }
#define XB_SPIN(cond, bar) do { unsigned _sp = 0; while (cond) { __builtin_amdgcn_s_sleep(1); \
    if ((++_sp & 255u) == 0u) { if (xb_ld(&(bar)[XB_TMO])) break; if (_sp > XB_SPIN_CAP) { atomicAdd(&(bar)[XB_TMO], 1u); break; } } } } while (0)

struct XcdBarrier { unsigned* bar; unsigned x; volatile LAS unsigned* st; };

__device__ __forceinline__ XcdBarrier xcd_barrier_post(unsigned* bar, volatile LAS unsigned* st) {
    XcdBarrier b; b.bar = bar; b.x = xb_xcc_id(); b.st = st;
    if (threadIdx.x == 0) (void)xb_add(&bar[XB_XCNT(b.x)], 1u);
    return b;
}
__device__ __forceinline__ void xcd_barrier_complete(unsigned* bar, unsigned x, unsigned& nloc, unsigned& nx) {
    const unsigned G = gridDim.x * gridDim.y * gridDim.z;
    unsigned sum, cnt, mine, sp = 0u;
    for (;;) {
        sum = 0u; cnt = 0u; mine = 0u;
#pragma unroll
        for (unsigned j = 0; j < 16; ++j) { const unsigned c = xb_ld(&bar[XB_XCNT(j)]); sum += c; cnt += (c > 0u) ? 1u : 0u; mine = (j == x) ? c : mine; }
        if (sum == G) break;
        __builtin_amdgcn_s_sleep(1);
        if ((++sp & 255u) == 0u) { if (xb_ld(&bar[XB_TMO])) break; if (sp > XB_SPIN_CAP) { atomicAdd(&bar[XB_TMO], 1u); break; } }
    }
    nloc = mine > 0u ? mine : 1u; nx = cnt > 0u ? cnt : 1u;
}
__device__ __forceinline__ void xcd_barrier(const XcdBarrier& b, const int wave_s) {
    asm volatile("s_waitcnt vmcnt(0)" ::: "memory");
    __syncthreads();
    if (launder_s(wave_s) == 0 && lane_id_local() == 0) {
        unsigned* bar = b.bar; unsigned bx_ = b.x; asm volatile("" : "+s"(bar), "+s"(bx_));
        __builtin_amdgcn_s_waitcnt(0);
        unsigned nloc = b.st[0], nx = b.st[1];
        if (nloc == 0u) { xcd_barrier_complete(bar, bx_, nloc, nx); b.st[0] = nloc; b.st[1] = nx; }
        const unsigned old = xb_add(&bar[XB_XSUB(bx_)], 1u);
        const unsigned gen = old / nloc;
        if (old + 1u == (gen + 1u) * nloc) {
            __builtin_amdgcn_fence(__ATOMIC_RELEASE, "agent");
            asm volatile("s_waitcnt vmcnt(0)" ::: "memory");
            const unsigned og = xb_add(&bar[XB_TOP], 1u);
            const unsigned tg = og / nx;
            if (og + 1u == (tg + 1u) * nx) xb_add(&bar[XB_TOPGEN], 1u);
            else XB_SPIN(xb_ld(&bar[XB_TOPGEN]) == tg, bar);
            __builtin_amdgcn_fence(__ATOMIC_ACQUIRE, "agent");
            xb_add(&bar[XB_XGEN(bx_)], 1u);
            asm volatile("s_waitcnt vmcnt(0)" ::: "memory");
        } else {
            XB_SPIN(xb_ld(&bar[XB_XGEN(bx_)]) == gen, bar);
            __builtin_amdgcn_fence(__ATOMIC_ACQUIRE, "agent");
            asm volatile("s_waitcnt vmcnt(0)" ::: "memory");
        }
    }
    __syncthreads();
}

__device__ __forceinline__ float shx(float v, int mask, int lane) { return __builtin_bit_cast(float, __builtin_amdgcn_ds_bpermute((lane ^ mask) << 2, __builtin_bit_cast(int, v))); }
__device__ __forceinline__ float wave_sum(float v, int lane) {
#pragma unroll
    for (int o = 1; o < 64; o <<= 1) v += shx(v, o, lane);
    return v;
}
__device__ __forceinline__ void transpose_item(const float* W, int ldw, int k0, int n0, bf16* dst, int ldd, int ncopy, int cstride, LAS float* scr, int lane) {
#pragma unroll 8
    for (int i = 0; i < 32; ++i) { const int kk = 2 * i + (lane >> 5); scr[kk * 33 + (lane & 31)] = W[(size_t)(k0 + kk) * ldw + n0 + (lane & 31)]; }
    LDS_WAIT(); asm volatile("" ::: "memory");
    const int c = lane & 7;
#pragma unroll
    for (int j = 0; j < 4; ++j) { const int n = (lane >> 3) + 8 * j; const LAS float* s = scr + (8 * c) * 33 + n;
        v4u o; o.x = pk2(s[0 * 33], s[1 * 33]); o.y = pk2(s[2 * 33], s[3 * 33]); o.z = pk2(s[4 * 33], s[5 * 33]); o.w = pk2(s[6 * 33], s[7 * 33]);
        for (int q = 0; q < ncopy; ++q) *(GAS v4u*)(dst + (size_t)n * ldd + q * cstride + k0 + 8 * c) = o; }
    LDS_WAIT(); asm volatile("" ::: "memory");
}
__device__ __forceinline__ void convert_matrix(const float* W, int K, int N, bf16* dst, int ldd, int mode, int ncopy, int cstride, LAS float* scr, int gw, int ngw, int lane) {
    const int nblk = N / 32, nitems = (K / 64) * nblk;
    for (int it = gw; it < nitems; it += ngw) { const int kb = it / nblk, nb = it % nblk, n0 = 32 * nb; const int drow = mode ? ((n0 >> 7) * 256 + (n0 & 127)) : n0;
        transpose_item(W, N, 64 * kb, n0, dst + (size_t)drow * ldd, ldd, ncopy, cstride, scr, lane); }
}
__device__ __forceinline__ void rms_row_to_bf16(const float* xrow, const float* g, bf16* orow, int lane) {
    const GAS f32x4* xr = (const GAS f32x4*)xrow + lane; const GAS f32x4* gr = (const GAS f32x4*)g + lane;
    f32x4 v[8]; float s = 0.f;
#pragma unroll
    for (int j = 0; j < 8; ++j) { v[j] = xr[64 * j]; s += (v[j].x * v[j].x + v[j].y * v[j].y) + (v[j].z * v[j].z + v[j].w * v[j].w); }
    const float rstd = 1.f / sqrtf(wave_sum(s, lane) * (1.f / DM) + EPS);
    GAS v2u* o8 = (GAS v2u*)orow + lane;
#pragma unroll
    for (int j = 0; j < 8; ++j) { const f32x4 gg = gr[64 * j]; v2u w; w.x = pk2(v[j].x * rstd * gg.x, v[j].y * rstd * gg.y); w.y = pk2(v[j].z * rstd * gg.z, v[j].w * rstd * gg.w); o8[64 * j] = w; }
}

struct Args { const float* in[23]; float* out; unsigned char* ws; int ph_lo, ph_hi; };
constexpr int NPH_PER = 13, NPHASE = 1 + NCHUNK * NLAYER * NPH_PER;
typedef const __attribute__((address_space(4))) Args* KArgs;
__device__ __forceinline__ KArgs kargs() { unsigned long long p = (unsigned long long)__builtin_amdgcn_kernarg_segment_ptr(); asm volatile("" : "+s"(p)); return (KArgs)p; }

#define PH_PRE \
    const int wave = launder_s(wave_s); const int lane = lane_id_local(); const int tid = wave * 64 + lane; (void)lane; (void)wave; \
    const KArgs ap = kargs(); const int bx = launder_s((int)blockIdx.x), G = launder_s((int)gridDim.x); \
    const int vcu = (G % 8 == 0) ? (bx % 8) * (G / 8) + bx / 8 : bx; const int gw = vcu * NWAVES + wave, NGW = G * NWAVES; (void)gw; (void)NGW; \
    unsigned char* const ws = ap->ws; (void)ws;
#define PH_PRE_CL \
    PH_PRE \
    const int c2 = launder_s(cl); const int chunk = c2 >> 1, layer = c2 & 1; (void)chunk; (void)layer; \
    const int S = chunk < 2 ? 8192 : 4096; (void)S; \
    float* const xo = ap->out + (size_t)chunk * MC * DM; (void)xo; \
    unsigned char* const wl = ws + WS_W + (size_t)layer * LAYER_W_BYTES; (void)wl; \
    bf16* const Hb = (bf16*)(ws + WS_H); bf16* const QKV = (bf16*)(ws + WS_QKV); bf16* const BB = (bf16*)(ws + WS_BB); bf16* const Ob = (bf16*)(ws + WS_O); (void)Hb; (void)QKV; (void)BB; (void)Ob;
#define XIN_PTR (chunk < 2 ? ap->in[0] + (size_t)chunk * MC * DM : ap->in[1] + (size_t)(chunk - 2) * MC * DM)

__global__ void __launch_bounds__(NWAVES * 64, 2) mk_fwd(Args args) {
    extern __shared__ __attribute__((aligned(16))) unsigned char lds[];
    LAS unsigned char* const ldsL = (LAS unsigned char*)lds;
    volatile LAS unsigned* const MISC = (volatile LAS unsigned*)(ldsL + MISC_OFF);
    const int wave_s = __builtin_amdgcn_readfirstlane((int)threadIdx.x >> 6);
    for (int u = threadIdx.x; u < (LDS_BYTES - LDSCTL_OFF) / 4; u += NWAVES * 64) ((LAS unsigned*)(ldsL + LDSCTL_OFF))[u] = 0u;
    __syncthreads();
    XcdBarrier bar = xcd_barrier_post((unsigned*)((gu32*)(args.ws + WS_CTL) + CW_BAR), MISC + 8);
    const int lo = args.ph_lo, hi = args.ph_hi;
#ifndef PHMASK
#define PHMASK 0xFFFFFFFFu
#endif
#define INM(bit, k) (((PHMASK >> (bit)) & 1u) && lo <= (k) && (k) < hi)
#define IN(k) (lo <= (k) && (k) < hi)
#define SEAM(k) do { if (IN(k) && IN((k) + 1)) xcd_barrier(bar, wave_s); } while (0)

    if (INM(0, 0)) {
        PH_PRE
        LAS float* scr = (LAS float*)(ldsL + RING_OFF + wave * 16384);
        for (int l = 0; l < NLAYER; ++l) {
            unsigned char* wl = ws + WS_W + (size_t)l * LAYER_W_BYTES;
            convert_matrix(ap->in[3] + (size_t)l * DM * DFF, DM, DFF, (bf16*)(wl + LW_W13_1), DM, 1, 1, 0, scr, gw, NGW, lane);
            convert_matrix(ap->in[4] + (size_t)l * DM * DFF, DM, DFF, (bf16*)(wl + LW_W13_1) + (size_t)128 * DM, DM, 1, 1, 0, scr, gw, NGW, lane);
            convert_matrix(ap->in[5] + (size_t)l * DFF * DM, DFF, DM, (bf16*)(wl + LW_WD_1), DFF, 0, 1, 0, scr, gw, NGW, lane);
            convert_matrix(ap->in[7] + (size_t)l * DM * DIN, DM, DIN, (bf16*)(wl + LW_WIN), DM, 0, 1, 0, scr, gw, NGW, lane);
            for (int i = 0; i < 3; ++i) convert_matrix(ap->in[8] + (size_t)(l * 3 + i) * DM * DM, DM, DM, (bf16*)(wl + LW_WGATE) + (size_t)i * DM * DM, DM, 0, 1, 0, scr, gw, NGW, lane);
            for (int i = 0; i < 3; ++i) convert_matrix(ap->in[17] + (size_t)(l * 3 + i) * 1024 * DM, 1024, DM, (bf16*)(wl + LW_WBR) + (size_t)i * DM * 1024, 1024, 0, 1, 0, scr, gw, NGW, lane);
            convert_matrix(ap->in[18] + (size_t)l * DM * DM, DM, DM, (bf16*)(wl + LW_WOUT3), 3 * DM, 0, 3, DM, scr, gw, NGW, lane);
            convert_matrix(ap->in[20] + (size_t)l * DM * DFF, DM, DFF, (bf16*)(wl + LW_W13_2), DM, 1, 1, 0, scr, gw, NGW, lane);
            convert_matrix(ap->in[21] + (size_t)l * DM * DFF, DM, DFF, (bf16*)(wl + LW_W13_2) + (size_t)128 * DM, DM, 1, 1, 0, scr, gw, NGW, lane);
            convert_matrix(ap->in[22] + (size_t)l * DFF * DM, DFF, DM, (bf16*)(wl + LW_WD_2), DFF, 0, 1, 0, scr, gw, NGW, lane);
        }
        { float* rope = (float*)(ws + WS_ROPE); const int gt = bx * (NWAVES * 64) + tid;
          if (gt < 128 * 32) { const int pos = gt >> 5, j = gt & 31;
              double f = 1.0; for (int q = 0; q < j; ++q) f *= 0.74989420933245582730;
              const double x2 = f * f; double c = 1.0, s = f, tc = 1.0, ts = f;
              for (int n = 1; n <= 12; ++n) { tc *= -x2 / (double)((2 * n - 1) * (2 * n)); c += tc; ts *= -x2 / (double)((2 * n) * (2 * n + 1)); s += ts; }
              double cr = 1.0, si = 0.0; for (int q = 0; q < pos; ++q) { const double t = cr * c - si * s; si = cr * s + si * c; cr = t; }
              rope[2 * gt] = (float)cr; rope[2 * gt + 1] = (float)si; } }
    }
    SEAM(0);

    for (int cl = 0; cl < NCHUNK * NLAYER; ++cl) {
        const int pb = 1 + cl * NPH_PER;
        if (hi <= pb || lo >= pb + NPH_PER) continue;

        if (INM(1, pb + 0)) { PH_PRE_CL const float* x0 = layer == 0 ? XIN_PTR : xo; const float* g = ap->in[2] + layer * DM;
            for (int m = gw; m < MC; m += NGW) rms_row_to_bf16(x0 + (size_t)m * DM, g, Hb + (size_t)m * DM, lane); }
        SEAM(pb + 0);
        if (INM(2, pb + 1)) { PH_PRE_CL pg8::Gemm g{Hb, (const bf16*)(wl + LW_W13_1), MC, 2 * DFF, DM, DM, DM, 0, 0}; pg8::StaticOrder So; So.init(MC, 2 * DFF, G, bx);
            pg8::EpiSwiglu E{QKV, DFF}; pg8::gemm_phase<pg8::EpiSwiglu, pg8::StaticOrder, true, true>(ldsL + RING_OFF, g, So, E, tid); }
        SEAM(pb + 1);
        if (INM(3, pb + 2)) { PH_PRE_CL const float* x0 = layer == 0 ? XIN_PTR : xo;
            pg8::Gemm g{QKV, (const bf16*)(wl + LW_WD_1), MC, DM, DFF, DFF, DFF, 0, 0}; pg8::StaticOrder So; So.init(MC, DM, G, bx);
            pg8::EpiResid E{x0, xo, DM, 0.5f}; pg8::gemm_phase<pg8::EpiResid, pg8::StaticOrder, true, true>(ldsL + RING_OFF, g, So, E, tid); }
        SEAM(pb + 2);
        if (INM(4, pb + 3)) { PH_PRE_CL const float* g = ap->in[6] + layer * DM; for (int m = gw; m < MC; m += NGW) rms_row_to_bf16(xo + (size_t)m * DM, g, Hb + (size_t)m * DM, lane); }
        SEAM(pb + 3);
        if (INM(5, pb + 4)) { PH_PRE_CL pg8::Gemm g{Hb, (const bf16*)(wl + LW_WIN), MC, DIN, DM, DM, DM, 0, 0}; pg8::StaticOrder So; So.init(MC, DIN, G, bx);
            pg8::EpiBf16 E{QKV, DIN}; pg8::gemm_phase<pg8::EpiBf16, pg8::StaticOrder, true, true>(ldsL + RING_OFF, g, So, E, tid); }
        SEAM(pb + 4);
        if (INM(6, pb + 5)) { PH_PRE_CL
            const float* rope = (const float*)(ws + WS_ROPE);
            const int sub = lane >> 4, t16 = lane & 15;
            for (int task = gw; task < MC * 9; task += NGW) {
                const int m = task / 9, hidx = (task % 9) * 4 + sub;
                int cb; const float* gp; bool rp = false;
                if (hidx < 8) { cb = hidx; gp = ap->in[9]; } else if (hidx < 16) { cb = hidx; gp = ap->in[10]; }
                else if (hidx < 24) { cb = 24 + (hidx - 16); gp = ap->in[12]; rp = true; } else if (hidx < 26) { cb = 32 + (hidx - 24); gp = ap->in[13]; rp = true; }
                else if (hidx < 34) { cb = 36 + (hidx - 26); gp = ap->in[14]; } else { cb = 44 + (hidx - 34); gp = ap->in[15]; }
                gp += layer * HD + 8 * t16;
                GAS v4u* p = (GAS v4u*)(QKV + (size_t)m * DIN + cb * 128 + 8 * t16);
                const v4u raw = *p;
                float x[8] = {pg8::bf_lo(raw.x), pg8::bf_hi(raw.x), pg8::bf_lo(raw.y), pg8::bf_hi(raw.y), pg8::bf_lo(raw.z), pg8::bf_hi(raw.z), pg8::bf_lo(raw.w), pg8::bf_hi(raw.w)};
                float ss = 0.f;
#pragma unroll
                for (int i = 0; i < 8; ++i) ss += x[i] * x[i];
                ss += shx(ss, 1, lane); ss += shx(ss, 2, lane); ss += shx(ss, 4, lane); ss += shx(ss, 8, lane);
                const float rstd = 1.f / sqrtf(ss * (1.f / HD) + EPS);
                const f32x4 g0 = *(const GAS f32x4*)gp, g1 = *(const GAS f32x4*)(gp + 4);
                x[0] *= rstd * g0.x; x[1] *= rstd * g0.y; x[2] *= rstd * g0.z; x[3] *= rstd * g0.w; x[4] *= rstd * g1.x; x[5] *= rstd * g1.y; x[6] *= rstd * g1.z; x[7] *= rstd * g1.w;
                const int tpos = m % S, pos = (t16 & 8) ? (tpos & 63) : (tpos >> 6);
                const bool first = (t16 & 4) == 0; const int j0 = 8 * (t16 & 3);
                const GAS f32x4* rt = (const GAS f32x4*)(rope + ((size_t)pos * 32 + j0) * 2);
                const f32x4 cs0 = rt[0], cs1 = rt[1], cs2 = rt[2], cs3 = rt[3];
                const float cc[8] = {cs0.x, cs0.z, cs1.x, cs1.z, cs2.x, cs2.z, cs3.x, cs3.z}, sn[8] = {cs0.y, cs0.w, cs1.y, cs1.w, cs2.y, cs2.w, cs3.y, cs3.w};
                float y[8];
#pragma unroll
                for (int i = 0; i < 8; ++i) { const float other = shx(x[i], 4, lane); y[i] = rp ? (x[i] * cc[i] + (first ? -other : other) * sn[i]) : x[i]; }
                v4u w; w.x = pk2(y[0], y[1]); w.y = pk2(y[2], y[3]); w.z = pk2(y[4], y[5]); w.w = pk2(y[6], y[7]);
                *p = w;
            }
        }
        SEAM(pb + 5);
        if (INM(7, pb + 6)) {
#ifndef ATTMASK
#define ATTMASK 7
#endif
          if (ATTMASK & 1) { PH_PRE_CL
            const int nqb = S / 256, nunit = MC / 256 * 8;
            for (int u = vcu; u < nunit; u += G) {
                const int qb = u % nqb, h = (u / nqb) % 8, sq = u / (nqb * 8); const int kvh = h >> 2;
                const size_t row0 = (size_t)sq * S;
                att::Par P{0, 0, 0, 0, 0, 0.f, 0.f};
                att::attn_body<0>(QKV + (row0 + (size_t)qb * 256) * DIN + C_QB + h * 128, QKV + row0 * DIN + C_KB + kvh * 128, QKV + row0 * DIN + C_VB + kvh * 128,
                                  Ob + (row0 + (size_t)qb * 256) * 3072 + 1024 + h * 128, S / 64, (char*)lds + RING_OFF, P, tid);
            } }
          if (ATTMASK & 2) { PH_PRE_CL
            const int rows = S / 64, nqb = S / 256, nunit = MC / 256 * 8;
            for (int u = vcu; u < nunit; u += G) {
                const int qb = u % nqb, h = (u / nqb) % 8, sq = u / (nqb * 8);
                const size_t row0 = (size_t)sq * S;
                int kr0 = qb * 4 - 4; kr0 = kr0 < 0 ? 0 : kr0; kr0 = kr0 > rows - 12 ? rows - 12 : kr0;
                { const float* rb = ap->in[11] + (size_t)(layer * 8 + h) * 465; float* tb = (float*)((char*)lds + RING_OFF + att::TBL_OFF);
                  if (tid < 480) { const int rr = tid >> 5, cc = tid & 31; tb[tid] = (cc < 31) ? rb[rr * 31 + cc] * (1.0f / att::SCALE) : att::NEG; } }
                att::Par P{0, 0, qb * 4, rows, kr0, 0.f, 0.f};
                att::attn_body_simple<2>(QKV + (row0 + (size_t)qb * 256) * DIN + C_QA + h * 128, QKV + (row0 + (size_t)kr0 * 64) * DIN + C_KA + h * 128, QKV + (row0 + (size_t)kr0 * 64) * DIN + C_VA + h * 128,
                                  Ob + (row0 + (size_t)qb * 256) * 3072 + h * 128, 12, (char*)lds + RING_OFF, P, tid);
            } }
          if (ATTMASK & 4) { PH_PRE_CL
            const int nqb = S / 256, nunit = MC / 256 * 8;
            for (int u = vcu; u < nunit; u += G) {
                const int qb = u % nqb, h = (u / nqb) % 8, sq = u / (nqb * 8); const int kvh = h >> 2;
                const size_t row0 = (size_t)sq * S;
                int ks = qb * 256 - 128; ks = ks < 0 ? 0 : ks; ks = ks > S - 512 ? S - 512 : ks;
                const float slope = exp2f(-(float)(h + 1)), sink = ap->in[16][layer * 8 + h];
                att::Par P{qb * 256, ks, 0, 0, 0, slope * (1.0f / att::SCALE), sink * (1.0f / att::SCALE)};
                att::attn_body_simple<1>(QKV + (row0 + (size_t)qb * 256) * DIN + C_QC + h * 128, QKV + (row0 + (size_t)ks) * DIN + C_KC + kvh * 128, QKV + (row0 + (size_t)ks) * DIN + C_VC + kvh * 128,
                                  Ob + (row0 + (size_t)qb * 256) * 3072 + 2048 + h * 128, 8, (char*)lds + RING_OFF, P, tid);
            } }
        }
        SEAM(pb + 6);
        if (INM(8, pb + 7)) { PH_PRE_CL pg8::Gemm g{Ob, (const bf16*)(wl + LW_WBR), MC, DIN, 1024, 3072, 1024, 8, 1024}; pg8::StaticOrder So; So.init(MC, DIN, G, bx);
            pg8::EpiBf16 E{BB, DIN}; pg8::gemm_phase<pg8::EpiBf16, pg8::StaticOrder, true, true>(ldsL + RING_OFF, g, So, E, tid); }
        SEAM(pb + 7);
        if (INM(9, pb + 8)) { PH_PRE_CL pg8::Gemm g{Hb, (const bf16*)(wl + LW_WGATE), MC, DIN, DM, DM, DM, 0, 0}; pg8::StaticOrder So; So.init(MC, DIN, G, bx);
            pg8::EpiGate E{BB, DIN}; pg8::gemm_phase<pg8::EpiGate, pg8::StaticOrder, true, true>(ldsL + RING_OFF, g, So, E, tid); }
        SEAM(pb + 8);
        if (INM(10, pb + 9)) { PH_PRE_CL pg8::Gemm g{BB, (const bf16*)(wl + LW_WOUT3), MC, DM, DIN, DIN, DIN, 0, 0}; pg8::StaticOrder So; So.init(MC, DM, G, bx);
            pg8::EpiResid E{xo, xo, DM, 1.0f}; pg8::gemm_phase<pg8::EpiResid, pg8::StaticOrder, true, true>(ldsL + RING_OFF, g, So, E, tid); }
        SEAM(pb + 9);
        if (INM(11, pb + 10)) { PH_PRE_CL const float* g = ap->in[19] + layer * DM; for (int m = gw; m < MC; m += NGW) rms_row_to_bf16(xo + (size_t)m * DM, g, Hb + (size_t)m * DM, lane); }
        SEAM(pb + 10);
        if (INM(12, pb + 11)) { PH_PRE_CL pg8::Gemm g{Hb, (const bf16*)(wl + LW_W13_2), MC, 2 * DFF, DM, DM, DM, 0, 0}; pg8::StaticOrder So; So.init(MC, 2 * DFF, G, bx);
            pg8::EpiSwiglu E{QKV, DFF}; pg8::gemm_phase<pg8::EpiSwiglu, pg8::StaticOrder, true, true>(ldsL + RING_OFF, g, So, E, tid); }
        SEAM(pb + 11);
        if (INM(13, pb + 12)) { PH_PRE_CL pg8::Gemm g{QKV, (const bf16*)(wl + LW_WD_2), MC, DM, DFF, DFF, DFF, 0, 0}; pg8::StaticOrder So; So.init(MC, DM, G, bx);
            pg8::EpiResid E{xo, xo, DM, 0.5f}; pg8::gemm_phase<pg8::EpiResid, pg8::StaticOrder, true, true>(ldsL + RING_OFF, g, So, E, tid); }
        SEAM(pb + 12);
    }
#undef IN
#undef SEAM
}

extern "C" void kernel_launch(void* const* d_in, const int* in_sizes, int n_in, void* d_out, int out_size, void* d_ws, size_t ws_size, hipStream_t stream) {
    static int grid = 0;
    if (grid == 0) {
        if (n_in != 23 || out_size != MTOT * DM || ws_size < WS_END) { fprintf(stderr, "kernel_launch: unexpected shapes: n_in %d out %d ws %zu (need %zu)\n", n_in, out_size, ws_size, (size_t)WS_END); grid = -1; return; }
        int dev = 0, cus = 0, per_cu = 0;
        if (hipGetDevice(&dev) != hipSuccess || hipDeviceGetAttribute(&cus, hipDeviceAttributeMultiprocessorCount, dev) != hipSuccess) { grid = -1; return; }
        if (hipFuncSetAttribute((const void*)mk_fwd, hipFuncAttributeMaxDynamicSharedMemorySize, LDS_BYTES) != hipSuccess) { fprintf(stderr, "kernel_launch: hipFuncSetAttribute failed\n"); grid = -1; return; }
        if (hipOccupancyMaxActiveBlocksPerMultiprocessor(&per_cu, (const void*)mk_fwd, NWAVES * 64, LDS_BYTES) != hipSuccess || per_cu < 1)
            fprintf(stderr, "kernel_launch: occupancy query reports %d workgroups per CU\n", per_cu);
        (void)hipGetLastError();
        grid = cus;
    }
    if (grid < 0) return;
    if (hipMemsetAsync((char*)d_ws + WS_CTL, 0, CTL_ZERO_BYTES, stream) != hipSuccess) return;
    Args a{};
    for (int i = 0; i < 23; ++i) a.in[i] = (const float*)d_in[i];
    a.out = (float*)d_out; a.ws = (unsigned char*)d_ws;
#if MK_ONE_LAUNCH
    a.ph_lo = 0; a.ph_hi = NPHASE;
    hipLaunchKernelGGL(mk_fwd, dim3(grid), dim3(NWAVES * 64), LDS_BYTES, stream, a);
#else
    for (int p = 0; p < NPHASE; ++p) { a.ph_lo = p; a.ph_hi = p + 1; hipLaunchKernelGGL(mk_fwd, dim3(grid), dim3(NWAVES * 64), LDS_BYTES, stream, a); }
#endif
    const hipError_t le = hipPeekAtLastError();
    if (le != hipSuccess) fprintf(stderr, "kernel_launch: launch failed: %s\n", hipGetErrorName(le));
}
```

```cpp
#include <hip/hip_runtime.h>
#include <cstdio>
#include <cstdint>

#ifndef MK_ONE_LAUNCH
#define MK_ONE_LAUNCH 1
#endif

namespace pg8 {
#define PG8_LAS __attribute__((address_space(3)))
typedef unsigned short bf16_t;
typedef short bf16x8 __attribute__((ext_vector_type(8)));
typedef float f32x4 __attribute__((ext_vector_type(4)));
typedef unsigned u32x4 __attribute__((ext_vector_type(4)));
constexpr int BM = 256, BK = 64, HALF = 128, HTB = HALF * BK * 2  , STAGE_BYTES = 8 * HTB, NXCD = 8, WGM = 4;

__host__ __device__ __forceinline__ int lds_byte(int r, int c) { const int st = (r >> 4) * 2 + (c >> 5), rr = r & 15, cc = c & 31, ob = rr * 64 + cc * 2; return st * 1024 + (ob ^ (((ob >> 9) & 1) << 5)); }
__host__ __device__ __forceinline__ void stage_rc(int b, int& R, int& C) { const int st = b / 1024, sb = b % 1024, swz = sb ^ (((sb >> 9) & 1) << 5); R = (st >> 1) * 16 + swz / 64; C = (st & 1) * 32 + (swz % 64) / 2; }
__host__ __device__ __forceinline__ int perm32(int rho) { const int n = rho >> 4, i = rho & 15; return 8 * (i >> 2) + 4 * n + (i & 3); }

struct Unit { int pm, pn, slot, fill; };
struct Gemm { const bf16_t* A; const bf16_t* Bt; int M, N, K, lda, ldb, grp, grp_a, ablk, bblk; };

struct StaticOrder {
    int nM, nN, nwg, G, c;
    __host__ __device__ void init(int M, int N, int G_, int c_) { nM = M / BM; nN = N / BM; nwg = nM * nN; G = G_; c = c_; }
    __host__ __device__ bool next(int i, Unit& u) const {
        const long L = (long)i * G + c; if (L >= nwg) return false;
        int wgid = (int)L; { const int q = nwg / NXCD, r = nwg % NXCD, xcd = wgid % NXCD, off = wgid / NXCD; wgid = (xcd < r ? xcd * (q + 1) : r * (q + 1) + (xcd - r) * q) + off; }
        const int nig = WGM * nN, gid = wgid / nig, fm = gid * WGM, gsz = (nM - fm) < WGM ? (nM - fm) : WGM;
        u.pm = fm + ((wgid % nig) % gsz); u.pn = (wgid % nig) / gsz;
        int pg = -1; if (i > 0) { int w2 = (int)(L - G); { const int q = nwg / NXCD, r = nwg % NXCD, xcd = w2 % NXCD, off = w2 / NXCD; w2 = (xcd < r ? xcd * (q + 1) : r * (q + 1) + (xcd - r) * q) + off; } pg = w2 / nig; }
        u.slot = gid & 1; u.fill = (pg != gid) ? 1 : 0; return true;
    }
    __device__ __forceinline__ void a_ready(const Unit&) const {}
    __device__ __forceinline__ void done(const Unit&) const {}
};

struct RsOrder : StaticOrder {
    const float* ssq; PG8_LAS float* tab; float inv_ncol, eps; int tid;
    __device__ __forceinline__ void a_ready(const Unit& u) const {
        if (u.fill && tid < 256) {
            const f32x4* p = (const f32x4*)(ssq + (size_t)(u.pm * BM + tid) * 32); float s = 0.f;
#pragma unroll
            for (int j = 0; j < 8; ++j) { const f32x4 a = p[j]; s += (a[0] + a[1]) + (a[2] + a[3]); }
            tab[u.slot * 256 + tid] = __builtin_amdgcn_rsqf(s * inv_ncol + eps);
        }
    }
};
struct TriOrder : RsOrder {
    int nN3;
    __host__ __device__ void init3(int M, int N3, int G_, int c_) { init(M, N3, G_, c_); nN3 = N3 / BM; }
    __host__ __device__ bool next(int i, Unit& u) const {
        const int t = i / 3, sub = i - 3 * t;
        if (!StaticOrder::next(t, u)) return false;
        u.pn += nN3 * sub; if (sub) u.fill = 0; return true;
    }
};
typedef float f32x2_t __attribute__((ext_vector_type(2))); typedef __bf16 bf16x2_t __attribute__((ext_vector_type(2)));
__device__ __forceinline__ unsigned cvt_pk_bf16(float lo, float hi) { const f32x2_t v = {lo, hi}; return __builtin_bit_cast(unsigned, __builtin_convertvector(v, bf16x2_t)); }
__device__ __forceinline__ float bf_lo(unsigned w) { return __uint_as_float(w << 16); }
__device__ __forceinline__ float bf_hi(unsigned w) { return __uint_as_float(w & 0xffff0000u); }
__device__ __forceinline__ float sigmoid_f(float x) { return __builtin_amdgcn_rcpf(1.0f + __builtin_amdgcn_exp2f(-1.4426950408889634f * x)); }

__device__ __forceinline__ float shx(float v, int mask, int lane) { return __builtin_bit_cast(float, __builtin_amdgcn_ds_bpermute((lane ^ mask) << 2, __builtin_bit_cast(int, v))); }
__device__ __forceinline__ float sum_x16(float v) { const auto r = __builtin_amdgcn_permlane16_swap(__float_as_uint(v), __float_as_uint(v), false, false); return __uint_as_float(r[0]) + __uint_as_float(r[1]); }
__device__ __forceinline__ float sum_x32(float v) { const auto r = __builtin_amdgcn_permlane32_swap(__float_as_uint(v), __float_as_uint(v), false, false); return __uint_as_float(r[0]) + __uint_as_float(r[1]); }
constexpr int NSSQ = 32;
__device__ __forceinline__ void load_rstd(const PG8_LAS float* rtab, int slot, int lrow0, float (&rs)[2][4]) {
#pragma unroll
    for (int ai = 0; ai < 2; ++ai)
#pragma unroll
        for (int m = 0; m < 4; ++m) rs[ai][m] = rtab ? rtab[slot * 256 + lrow0 + ai * HALF + m * 16] : 1.0f;
}
struct EpiBf16 {
    static constexpr bool PERM = true, AFTER_DRAIN = false;
    bf16_t* O; int ldc; const PG8_LAS float* rtab;
    __device__ __forceinline__ void operator()(const f32x4 (&acc)[2][2][4][2], const Unit& u, int wr, int wc, int fr, int fq) const {
        const int row0 = u.pm * BM + wr * 64 + fr, col0 = u.pn * BM + wc * 32 + 8 * fq;
        float rs[2][4]; load_rstd(rtab, u.slot, wr * 64 + fr, rs);
#pragma unroll
        for (int ai = 0; ai < 2; ++ai)
#pragma unroll
            for (int m = 0; m < 4; ++m) { bf16_t* rowp = O + (size_t)(row0 + ai * HALF + m * 16) * ldc + col0; const float r = rs[ai][m];
#pragma unroll
                for (int bj = 0; bj < 2; ++bj) { const f32x4 v0 = acc[ai][bj][m][0] * r, v1 = acc[ai][bj][m][1] * r;
                    u32x4 w; w.x = cvt_pk_bf16(v0[0], v0[1]); w.y = cvt_pk_bf16(v0[2], v0[3]); w.z = cvt_pk_bf16(v1[0], v1[1]); w.w = cvt_pk_bf16(v1[2], v1[3]);
                    *(u32x4*)(rowp + bj * HALF) = w; } }
    }
};
struct EpiTileImg {
    static constexpr bool PERM = true, AFTER_DRAIN = false;
    bf16_t* T; int ntn, tid;
    __device__ __forceinline__ void operator()(const f32x4 (&acc)[2][2][4][2], const Unit& u, int wr, int wc, int fr, int fq) const {
        char* const tb = (char*)T + (size_t)(u.pm * ntn + u.pn) * 131072; unsigned voff = (unsigned)tid * 16u; asm volatile("" : "+v"(voff));
#pragma unroll
        for (int ai = 0; ai < 2; ++ai)
#pragma unroll
            for (int m = 0; m < 4; ++m)
#pragma unroll
                for (int bj = 0; bj < 2; ++bj) { const f32x4 v0 = acc[ai][bj][m][0], v1 = acc[ai][bj][m][1];
                    u32x4 w; w.x = cvt_pk_bf16(v0[0], v0[1]); w.y = cvt_pk_bf16(v0[2], v0[3]); w.z = cvt_pk_bf16(v1[0], v1[1]); w.w = cvt_pk_bf16(v1[2], v1[3]);
                    *(u32x4*)(tb + (size_t)(((ai * 4 + m) * 2 + bj) * 8192) + voff) = w; }
    }
};
struct EpiSwiglu {
    static constexpr bool PERM = true, AFTER_DRAIN = false;
    bf16_t* O; int ldc; const PG8_LAS float* rtab;
    __device__ __forceinline__ void operator()(const f32x4 (&acc)[2][2][4][2], const Unit& u, int wr, int wc, int fr, int fq) const {
        const int lrow0 = wr * 64 + fr, kt = 2 * u.pn + (wc >> 1), cc = (wc & 1) * 32 + 8 * fq;
        bf16_t* const blk = O + ((size_t)u.pm * (ldc / BK) + kt) * (BM * BK) + cc;
        float rs[2][4]; load_rstd(rtab, u.slot, lrow0, rs);
#pragma unroll
        for (int ai = 0; ai < 2; ++ai)
#pragma unroll
            for (int m = 0; m < 4; ++m) { bf16_t* rowp = blk + (lrow0 + ai * HALF + m * 16) * BK; const float r = rs[ai][m], rn = -1.4426950408889634f * r, r2 = r * r;
                float h[8], ee[8];
#pragma unroll
                for (int n = 0; n < 2; ++n)
#pragma unroll
                    for (int j = 0; j < 4; ++j) { ee[n * 4 + j] = __builtin_amdgcn_exp2f(acc[ai][0][m][n][j] * rn); h[n * 4 + j] = acc[ai][0][m][n][j] * acc[ai][1][m][n][j]; }
#pragma unroll
                for (int j = 0; j < 8; ++j) ee[j] = __builtin_amdgcn_rcpf(1.0f + ee[j]) * r2;
#pragma unroll
                for (int j = 0; j < 8; ++j) h[j] = h[j] * ee[j];
                u32x4 w; w.x = cvt_pk_bf16(h[0], h[1]); w.y = cvt_pk_bf16(h[2], h[3]); w.z = cvt_pk_bf16(h[4], h[5]); w.w = cvt_pk_bf16(h[6], h[7]);
                *(u32x4*)rowp = w; }
    }
};
struct EpiResidX {
    static constexpr bool PERM = true, AFTER_DRAIN = false;
    bf16_t* xb; float* out32; float* ssq; int ldc; float alpha;
    struct Bt { u32x4 v[2][2]; };
    __device__ __forceinline__ void ld(Bt& b, int row0, int col0, int k) const {
#pragma unroll
        for (int mm = 0; mm < 2; ++mm)
#pragma unroll
            for (int bj = 0; bj < 2; ++bj) b.v[mm][bj] = *(const u32x4*)(xb + (size_t)(row0 + (k >> 1) * HALF + (2 * (k & 1) + mm) * 16) * ldc + col0 + bj * HALF);
    }
    __device__ __forceinline__ void st(const Bt& b, const f32x4 (&acc)[2][2][4][2], const Unit& u, int row0, int col0, int wc, int fq, int k) const {
        const int ai = k >> 1, mp = k & 1;
#pragma unroll
        for (int mm = 0; mm < 2; ++mm) { const int m = 2 * mp + mm, row = row0 + ai * HALF + m * 16; const size_t off = (size_t)row * ldc + col0; float ss = 0.f;
#pragma unroll
            for (int bj = 0; bj < 2; ++bj) { const u32x4 r = b.v[mm][bj];
                const f32x4 o0 = (f32x4){bf_lo(r.x), bf_hi(r.x), bf_lo(r.y), bf_hi(r.y)} + acc[ai][bj][m][0] * alpha, o1 = (f32x4){bf_lo(r.z), bf_hi(r.z), bf_lo(r.w), bf_hi(r.w)} + acc[ai][bj][m][1] * alpha;
                if (out32) { *(f32x4*)(out32 + off + bj * HALF) = o0; *(f32x4*)(out32 + off + bj * HALF + 4) = o1; }
                else { u32x4 w; w.x = cvt_pk_bf16(o0[0], o0[1]); w.y = cvt_pk_bf16(o0[2], o0[3]); w.z = cvt_pk_bf16(o1[0], o1[1]); w.w = cvt_pk_bf16(o1[2], o1[3]);
                    *(u32x4*)(xb + off + bj * HALF) = w;
                    ss += ((o0[0] * o0[0] + o0[1] * o0[1]) + (o0[2] * o0[2] + o0[3] * o0[3])) + ((o1[0] * o1[0] + o1[1] * o1[1]) + (o1[2] * o1[2] + o1[3] * o1[3])); } }
            if (!out32) { ss = sum_x32(sum_x16(ss)); if (fq == 0) ssq[(size_t)row * NSSQ + u.pn * 4 + wc] = ss; } }
    }
    __device__ __forceinline__ void operator()(const f32x4 (&acc)[2][2][4][2], const Unit& u, int wr, int wc, int fr, int fq) const {
        const int row0 = u.pm * BM + wr * 64 + fr, col0 = u.pn * BM + wc * 32 + 8 * fq;
        Bt bA, bB;
        ld(bA, row0, col0, 0);
        ld(bB, row0, col0, 1); st(bA, acc, u, row0, col0, wc, fq, 0);
        ld(bA, row0, col0, 2); st(bB, acc, u, row0, col0, wc, fq, 1);
        ld(bB, row0, col0, 3); st(bA, acc, u, row0, col0, wc, fq, 2);
        st(bB, acc, u, row0, col0, wc, fq, 3);
    }
};
struct EpiGateAcc {
    static constexpr bool PERM = true, AFTER_DRAIN = false;
    const bf16_t* B; int ldb; float* scr; bf16_t* Mg; int ldm; const PG8_LAS float* rtab; int tid, nN3;
    struct Bt { u32x4 b[2]; u32x4 mo[2]; };
#define SCRQ(q) (*(u32x4*)(sb + (size_t)(q) * 8192 + voff))
    __device__ __forceinline__ void ld(Bt& t, int sub, const char* bimg, char* sb, unsigned voff, int k) const {
#pragma unroll
        for (int bj = 0; bj < 2; ++bj) { t.b[bj] = *(const u32x4*)(bimg + (size_t)((k * 2 + bj) * 8192) + voff);
            const int q = k * 2 + bj;
            if (sub != 0) t.mo[bj] = SCRQ(q); else t.mo[bj] = (u32x4){0u, 0u, 0u, 0u}; }
    }
    __device__ __forceinline__ void st(const Bt& t, const f32x4 (&acc)[2][2][4][2], float r, int sub, int row0, int colm, char* sb, unsigned voff, int k) const {
        const int ai = k >> 2, m = k & 3;
        const float rn = -1.4426950408889634f * r;
#pragma unroll
        for (int bj = 0; bj < 2; ++bj) { const f32x4 v0 = acc[ai][bj][m][0] * rn, v1 = acc[ai][bj][m][1] * rn; const u32x4 bb = t.b[bj];
            f32x4 t0, t1; float ee[8];
#pragma unroll
            for (int j = 0; j < 4; ++j) { ee[j] = __builtin_amdgcn_exp2f(v0[j]); ee[4 + j] = __builtin_amdgcn_exp2f(v1[j]); }
#pragma unroll
            for (int j = 0; j < 8; ++j) ee[j] = __builtin_amdgcn_rcpf(1.0f + ee[j]);
            t0[0] = ee[0] * bf_lo(bb.x); t0[1] = ee[1] * bf_hi(bb.x); t0[2] = ee[2] * bf_lo(bb.y); t0[3] = ee[3] * bf_hi(bb.y);
            t1[0] = ee[4] * bf_lo(bb.z); t1[1] = ee[5] * bf_hi(bb.z); t1[2] = ee[6] * bf_lo(bb.w); t1[3] = ee[7] * bf_hi(bb.w);
            const u32x4 mm = t.mo[bj];
            t0[0] += bf_lo(mm.x); t0[1] += bf_hi(mm.x); t0[2] += bf_lo(mm.y); t0[3] += bf_hi(mm.y); t1[0] += bf_lo(mm.z); t1[1] += bf_hi(mm.z); t1[2] += bf_lo(mm.w); t1[3] += bf_hi(mm.w);
            u32x4 w; w.x = cvt_pk_bf16(t0[0], t0[1]); w.y = cvt_pk_bf16(t0[2], t0[3]); w.z = cvt_pk_bf16(t1[0], t1[1]); w.w = cvt_pk_bf16(t1[2], t1[3]);
            if (sub != 2) SCRQ(k * 2 + bj) = w;
            else *(u32x4*)(Mg + (size_t)(row0 + ai * HALF + m * 16) * ldm + colm + bj * HALF) = w; }
    }
    __device__ __forceinline__ void operator()(const f32x4 (&acc)[2][2][4][2], const Unit& u, int wr, int wc, int fr, int fq) const {
        const int sub = u.pn / nN3, pn3 = u.pn - sub * nN3;
        const int row0 = u.pm * BM + wr * 64 + fr, colm = pn3 * BM + wc * 32 + 8 * fq;
        const char* const bimg = (const char*)B + (size_t)(u.pm * ldb + u.pn) * 131072;
        float rs[2][4]; load_rstd(rtab, u.slot, wr * 64 + fr, rs);
        char* const sb = (char*)scr; unsigned voff = (unsigned)tid * 16u; asm volatile("" : "+v"(voff));
        Bt t0, t1, t2, t3;
        ld(t0, sub, bimg, sb, voff, 0); ld(t1, sub, bimg, sb, voff, 1); ld(t2, sub, bimg, sb, voff, 2);
        ld(t3, sub, bimg, sb, voff, 3); st(t0, acc, rs[0][0], sub, row0, colm, sb, voff, 0);
        ld(t0, sub, bimg, sb, voff, 4); st(t1, acc, rs[0][1], sub, row0, colm, sb, voff, 1);
        ld(t1, sub, bimg, sb, voff, 5); st(t2, acc, rs[0][2], sub, row0, colm, sb, voff, 2);
        ld(t2, sub, bimg, sb, voff, 6); st(t3, acc, rs[0][3], sub, row0, colm, sb, voff, 3);
        ld(t3, sub, bimg, sb, voff, 7); st(t0, acc, rs[1][0], sub, row0, colm, sb, voff, 4);
        st(t1, acc, rs[1][1], sub, row0, colm, sb, voff, 5);
        st(t2, acc, rs[1][2], sub, row0, colm, sb, voff, 6);
        st(t3, acc, rs[1][3], sub, row0, colm, sb, voff, 7);
    }
#undef SCRQ
};

template <class Epi, class Sched, bool ALIGN_EPI = false, bool SP2 = false>
__device__ __forceinline__ void gemm_phase(PG8_LAS unsigned char* lds, const Gemm g, const Sched& S, const Epi& E, const int tid) {
    const int wid = __builtin_amdgcn_readfirstlane(tid >> 6), lane = tid & 63, wr = wid >> 2, wc = wid & 3, fr = lane & 15, fq = lane >> 4;
    const int K = g.K, nt = K / BK;
    unsigned voffA[2], voffB[2];
#pragma unroll
    for (int i = 0; i < 2; ++i) { int R, C; stage_rc(tid * 16 + i * 8192, R, C); const int Rb = Epi::PERM ? ((R & ~31) + perm32(R & 31)) : R;
        voffA[i] = (unsigned)(R * (g.ablk ? BK : g.lda) + C) * 2u; voffB[i] = (unsigned)(Rb * (g.bblk ? BK : g.ldb) + C) * 2u; }
    const size_t kstepA = g.ablk ? (size_t)(BM * BK * 2) : (size_t)(BK * 2), kstepB = g.bblk ? (size_t)(BM * BK * 2) : (size_t)(BK * 2);
    const size_t hstepA = (size_t)HALF * (g.ablk ? BK : g.lda) * 2, hstepB = (size_t)HALF * (g.bblk ? BK : g.ldb) * 2;
    const size_t tstepA = g.ablk ? (size_t)nt * (BM * BK * 2) : 2 * hstepA, tstepB = g.bblk ? (size_t)nt * (BM * BK * 2) : 2 * hstepB;
    const unsigned ldsw = (unsigned)wid * 1024u;
    const unsigned ldsb = (unsigned)__builtin_amdgcn_readfirstlane((int)(unsigned)(unsigned long long)(lds + ldsw));
    const int aoff = lds_byte(wr * 64 + fr, fq * 8), boff = lds_byte(wc * 32 + fr, fq * 8);
#define PG8_ABASE(u) ((const char*)g.A + (size_t)(u).pm * tstepA + (g.grp ? (size_t)(((u).pn / g.grp) * g.grp_a) * 2 : (size_t)0))
#define PG8_BBASE(u) ((const char*)g.Bt + (size_t)(u).pn * tstepB)
#define PG8_SA(b, h) (((b) * 2 + (h)) * HTB)
#define PG8_SB(b, h) ((4 + (b) * 2 + (h)) * HTB)
#define PG8_STAGE(bufoff, gbase, voff) do { const char* _g = (const char*)(gbase); const unsigned _l = ldsb + (unsigned)(bufoff); unsigned _k; _Pragma("unroll") for (int _i = 0; _i < 2; ++_i) \
        asm volatile("s_mov_b32 %0, m0\n\ts_mov_b32 m0, %3\n\ts_nop 3\n\tglobal_load_lds_dwordx4 %1, %2\n\ts_mov_b32 m0, %0" : "=&s"(_k) : "v"((voff)[_i]), "s"(_g), "s"(_l + _i * 8192u) : "memory"); } while (0)
#define PG8_LDA(dst, b, h) do { _Pragma("unroll") for (int m = 0; m < 4; ++m) _Pragma("unroll") for (int k = 0; k < 2; ++k) dst[m][k] = *(const PG8_LAS bf16x8*)(lds + PG8_SA(b, h) + aoff + m * 2048 + k * 1024); } while (0)
#define PG8_LDB(dst, b, h) do { _Pragma("unroll") for (int n = 0; n < 2; ++n) _Pragma("unroll") for (int k = 0; k < 2; ++k) dst[n][k] = *(const PG8_LAS bf16x8*)(lds + PG8_SB(b, h) + boff + n * 2048 + k * 1024); } while (0)
#define PG8_MMA(ai, bj, At, Bt) do { __builtin_amdgcn_s_setprio(1); _Pragma("unroll") for (int m = 0; m < 4; ++m) _Pragma("unroll") for (int n = 0; n < 2; ++n) _Pragma("unroll") for (int k = 0; k < 2; ++k) \
        acc[ai][bj][m][n] = __builtin_amdgcn_mfma_f32_16x16x32_bf16(Bt[n][k], At[m][k], acc[ai][bj][m][n], 0, 0, 0); __builtin_amdgcn_s_setprio(0); } while (0)
#define PG8_WAIT_V(n) asm volatile("s_waitcnt vmcnt(" #n ")" ::: "memory")
#define PG8_WAIT_L(n) asm volatile("s_waitcnt lgkmcnt(" #n ")" ::: "memory")
#define PG8_BAR __builtin_amdgcn_s_barrier()
#define PG8_SCHED __builtin_amdgcn_sched_barrier(0)
    Unit cur, nxt; int ui = 0;
    if (!S.next(0, cur)) return;
    f32x4 acc[2][2][4][2];
#pragma unroll
    for (int a = 0; a < 2; ++a)
#pragma unroll
        for (int b = 0; b < 2; ++b)
#pragma unroll
            for (int m = 0; m < 4; ++m)
#pragma unroll
                for (int n = 0; n < 2; ++n) acc[a][b][m][n] = (f32x4){0.f, 0.f, 0.f, 0.f};
    bf16x8 At[4][2], B0[2][2], B1[2][2];
    const char* cA = PG8_ABASE(cur); const char* cB = PG8_BBASE(cur);
    S.a_ready(cur);
    if constexpr (SP2) {
        PG8_STAGE(PG8_SB(0, 0), cB, voffB); PG8_STAGE(PG8_SB(0, 1), cB + hstepB, voffB); PG8_STAGE(PG8_SA(0, 0), cA, voffA); PG8_STAGE(PG8_SA(0, 1), cA + hstepA, voffA);
        if (wr == 1) PG8_BAR;
        PG8_WAIT_V(2); PG8_BAR;
        PG8_STAGE(PG8_SB(1, 0), cB + kstepB, voffB); PG8_STAGE(PG8_SA(1, 0), cA + kstepA, voffA); PG8_STAGE(PG8_SB(1, 1), cB + hstepB + kstepB, voffB);
        PG8_WAIT_V(6); PG8_BAR;
    } else {
        PG8_STAGE(PG8_SB(0, 0), cB, voffB); PG8_STAGE(PG8_SA(0, 0), cA, voffA); PG8_STAGE(PG8_SB(0, 1), cB + hstepB, voffB); PG8_STAGE(PG8_SA(0, 1), cA + hstepA, voffA);
        if (wr == 1) PG8_BAR;
        PG8_WAIT_V(4); PG8_BAR;
        PG8_STAGE(PG8_SB(1, 0), cB + kstepB, voffB); PG8_STAGE(PG8_SA(1, 0), cA + kstepA, voffA); PG8_STAGE(PG8_SB(1, 1), cB + hstepB + kstepB, voffB);
        PG8_WAIT_V(6); PG8_BAR;
    }
    for (;;) {
        const bool has_next = S.next(ui + 1, nxt);
        const char* nA = has_next ? PG8_ABASE(nxt) : cA; const char* nB = has_next ? PG8_BBASE(nxt) : cB;
        for (int t = 0; t < nt; t += 2) {
            const bool last = (t == nt - 2);
            const char* a1 = cA + (size_t)(t + 1) * kstepA;
            const char* a2 = last ? nA : cA + (size_t)(t + 2) * kstepA; const char* b2 = last ? nB : cB + (size_t)(t + 2) * kstepB;
            const char* a3 = a2 + kstepA; const char* b3 = b2 + kstepB;
            if (last && has_next) S.a_ready(nxt);
            if constexpr (SP2) {
            PG8_LDB(B0, 0, 0); PG8_LDB(B1, 0, 1); PG8_SCHED; PG8_LDA(At, 0, 0); PG8_STAGE(PG8_SA(1, 1), a1 + hstepA, voffA);
            PG8_WAIT_V(8); PG8_WAIT_L(0); PG8_BAR; PG8_MMA(0, 0, At, B0); PG8_MMA(0, 1, At, B1); PG8_BAR; PG8_SCHED;
            PG8_LDA(At, 0, 1); PG8_STAGE(PG8_SB(0, 0), b2, voffB); PG8_STAGE(PG8_SB(0, 1), b2 + hstepB, voffB); PG8_STAGE(PG8_SA(0, 0), a2, voffA);
            PG8_WAIT_V(8); PG8_WAIT_L(0); PG8_BAR; PG8_MMA(1, 0, At, B0); PG8_MMA(1, 1, At, B1); PG8_BAR; PG8_SCHED;
            PG8_LDB(B0, 1, 0); PG8_LDB(B1, 1, 1); PG8_SCHED; PG8_LDA(At, 1, 0); PG8_STAGE(PG8_SA(0, 1), a2 + hstepA, voffA);
            PG8_WAIT_V(8); PG8_WAIT_L(0); PG8_BAR; PG8_MMA(0, 0, At, B0); PG8_MMA(0, 1, At, B1); PG8_BAR; PG8_SCHED;
            PG8_LDA(At, 1, 1); PG8_STAGE(PG8_SB(1, 0), b3, voffB); PG8_STAGE(PG8_SB(1, 1), b3 + hstepB, voffB); PG8_STAGE(PG8_SA(1, 0), a3, voffA);
            PG8_WAIT_V(8); PG8_WAIT_L(0); PG8_BAR; PG8_MMA(1, 0, At, B0); PG8_MMA(1, 1, At, B1); PG8_BAR; PG8_SCHED;
            } else {
            PG8_LDB(B0, 0, 0); PG8_SCHED; PG8_LDA(At, 0, 0); PG8_STAGE(PG8_SA(1, 1), a1 + hstepA, voffA);
            PG8_WAIT_L(8); PG8_BAR; PG8_WAIT_L(0); PG8_MMA(0, 0, At, B0); PG8_BAR; PG8_SCHED;
            PG8_LDB(B1, 0, 1); PG8_STAGE(PG8_SB(0, 0), b2, voffB);
            PG8_BAR; PG8_WAIT_L(0); PG8_MMA(0, 1, At, B1); PG8_BAR;
            PG8_LDA(At, 0, 1); PG8_STAGE(PG8_SA(0, 0), a2, voffA);
            PG8_BAR; PG8_WAIT_L(0); PG8_MMA(1, 0, At, B0); PG8_BAR; PG8_SCHED;
            PG8_STAGE(PG8_SB(0, 1), b2 + hstepB, voffB);
            PG8_WAIT_V(6); PG8_BAR; PG8_MMA(1, 1, At, B1); PG8_BAR;
            PG8_LDB(B0, 1, 0); PG8_SCHED; PG8_LDA(At, 1, 0); PG8_STAGE(PG8_SA(0, 1), a2 + hstepA, voffA);
            PG8_WAIT_L(8); PG8_BAR; PG8_WAIT_L(0); PG8_MMA(0, 0, At, B0); PG8_BAR; PG8_SCHED;
            PG8_LDB(B1, 1, 1); PG8_STAGE(PG8_SB(1, 0), b3, voffB);
            PG8_BAR; PG8_WAIT_L(0); PG8_MMA(0, 1, At, B1); PG8_BAR;
            PG8_LDA(At, 1, 1); PG8_STAGE(PG8_SA(1, 0), a3, voffA);
            PG8_BAR; PG8_WAIT_L(0); PG8_MMA(1, 0, At, B0); PG8_BAR; PG8_SCHED;
            PG8_STAGE(PG8_SB(1, 1), b3 + hstepB, voffB);
            PG8_WAIT_V(6); PG8_BAR; PG8_MMA(1, 1, At, B1); PG8_BAR;
            }
        }
        if constexpr (ALIGN_EPI) { if (wr == 0) PG8_BAR; }
        if constexpr (!Epi::AFTER_DRAIN) { E(acc, cur, wr, wc, fr, fq); S.done(cur); }
        if (!has_next) break;
#pragma unroll
        for (int a = 0; a < 2; ++a)
#pragma unroll
            for (int b = 0; b < 2; ++b)
#pragma unroll
                for (int m = 0; m < 4; ++m)
#pragma unroll
                    for (int n = 0; n < 2; ++n) acc[a][b][m][n] = (f32x4){0.f, 0.f, 0.f, 0.f};
        cur = nxt; cA = nA; cB = nB; ++ui;
        if constexpr (ALIGN_EPI) { if (wr == 1) PG8_BAR; }
    }
    PG8_WAIT_V(0);
    if constexpr (!ALIGN_EPI) { if (wr == 0) PG8_BAR; }
    PG8_BAR;
#undef PG8_ABASE
#undef PG8_BBASE
#undef PG8_SA
#undef PG8_SB
#undef PG8_STAGE
#undef PG8_LDA
#undef PG8_LDB
#undef PG8_MMA
#undef PG8_WAIT_V
#undef PG8_WAIT_L
#undef PG8_BAR
#undef PG8_SCHED
}
}

namespace att {
using bf16 = unsigned short;
constexpr int D = 128, NW = 8, QBLK = 32, KVBLK = 64;
constexpr float SCALE = 0.088388347648318440f;
constexpr float THR = 8.f;
constexpr float NEG = -1.0e5f;
constexpr int LDQ = 6144, LDK = 6144, LDO = 3072;
constexpr size_t SHM_V = KVBLK * D * 2, SHM_K = KVBLK * D * 2, SHM_ATTN = 2 * SHM_V + 2 * SHM_K + NW * 64 * 4;
constexpr int TBL_OFF = 69632;

using bf16x8 = __attribute__((ext_vector_type(8))) short;
using s16x4  = __attribute__((ext_vector_type(4))) short;
using f32x16 = __attribute__((ext_vector_type(16))) float;
using u32x4  = __attribute__((ext_vector_type(4))) unsigned;
#define KSWZ(row, colB) ((row) * 256 + ((colB) ^ (((row) & 7) << 4)))
#define SBAR() __builtin_amdgcn_sched_barrier(0)
__device__ __forceinline__ int crow(int r, int hi) { return (r & 3) + 8 * (r >> 2) + 4 * hi; }
__device__ __forceinline__ unsigned cvtpk(float lo, float hi) { const pg8::f32x2_t v = {lo, hi}; return __builtin_bit_cast(unsigned, __builtin_convertvector(v, pg8::bf16x2_t)); }

struct Par { int qpos0, kpos0, r0, rows, kr0; float slopeR, sinkR; const float* gq; const float* rope; int qt0; };

__device__ __forceinline__ void partialSM(f32x16& p0, f32x16& p1, float& m_reg, float& mn, float& alpha) {
  constexpr float C = SCALE * 1.4426950408889634f;
  float pmax = p0[0]; for (int r = 1; r < 16; ++r) pmax = fmaxf(pmax, p0[r]); for (int r = 0; r < 16; ++r) pmax = fmaxf(pmax, p1[r]);
  { auto rr = __builtin_amdgcn_permlane32_swap(__float_as_uint(pmax), __float_as_uint(pmax), false, false);
    pmax = fmaxf(__uint_as_float(rr[0]), __uint_as_float(rr[1])); }
  if (__builtin_expect(__all(pmax - m_reg <= THR / SCALE), 1)) { mn = m_reg; alpha = 1.f; }
  else { mn = fmaxf(m_reg, pmax); alpha = __builtin_amdgcn_exp2f((m_reg - mn) * C); m_reg = mn; }
  float mnC = -mn * C;
  for (int r = 0; r < 16; ++r) p0[r] = fmaf(p0[r], C, mnC); for (int r = 0; r < 16; ++r) p1[r] = fmaf(p1[r], C, mnC);
  for (int r = 0; r < 16; ++r) p0[r] = __builtin_amdgcn_exp2f(p0[r]);
}
template <int NEXP = 16>
__device__ __forceinline__ void finishSM(f32x16& p0, f32x16& p1, float alpha, float& l_reg, bf16x8& pa0, bf16x8& pa1, bf16x8& pa2, bf16x8& pa3) {
  for (int r = 16 - NEXP; r < 16; ++r) p1[r] = __builtin_amdgcn_exp2f(p1[r]);
  float ps = 0; for (int r = 0; r < 16; ++r) ps += p0[r]; for (int r = 0; r < 16; ++r) ps += p1[r];
  { auto rr = __builtin_amdgcn_permlane32_swap(__float_as_uint(ps), __float_as_uint(ps), false, false);
    ps = __uint_as_float(rr[0]) + __uint_as_float(rr[1]); }
  l_reg = l_reg * alpha + ps;
#define PK4(P, BASE, OUT) do { unsigned a0 = cvtpk(P[BASE + 0], P[BASE + 1]), a1 = cvtpk(P[BASE + 2], P[BASE + 3]);   \
    unsigned b0 = cvtpk(P[BASE + 4], P[BASE + 5]), b1 = cvtpk(P[BASE + 6], P[BASE + 7]);                              \
    auto r0 = __builtin_amdgcn_permlane32_swap(a0, b0, false, false); auto r1 = __builtin_amdgcn_permlane32_swap(a1, b1, false, false); \
    u32x4 w = {r0[0], r1[0], r0[1], r1[1]}; OUT = *reinterpret_cast<bf16x8*>(&w); } while (0)
  PK4(p0, 0, pa0); PK4(p0, 8, pa1); PK4(p1, 0, pa2); PK4(p1, 8, pa3);
#undef PK4
}
__device__ __forceinline__ void qkt(f32x16& p0, f32x16& p1, const bf16* Ks, const bf16x8* qr, int r32, int hi) {
  p0 = f32x16{}; p1 = f32x16{};
  for (int d0 = 0; d0 < 8; ++d0) { int cb = (d0 * 16 + hi * 8) * 2;
    bf16x8 b0 = *reinterpret_cast<const bf16x8*>((const char*)Ks + KSWZ(r32, cb));
    bf16x8 b1 = *reinterpret_cast<const bf16x8*>((const char*)Ks + KSWZ(32 + r32, cb));
    p0 = __builtin_amdgcn_mfma_f32_32x32x16_bf16(b0, qr[d0], p0, 0, 0, 0);
    p1 = __builtin_amdgcn_mfma_f32_32x32x16_bf16(b1, qr[d0], p1, 0, 0, 0); }
}
__device__ __forceinline__ void qkt_rel(f32x16& p0, f32x16& p1, const bf16* Ks, const bf16x8* qr, int r32, int hi, const f32x16& nm) {
  { bf16x8 b0 = *reinterpret_cast<const bf16x8*>((const char*)Ks + KSWZ(r32, hi * 16)); bf16x8 b1 = *reinterpret_cast<const bf16x8*>((const char*)Ks + KSWZ(32 + r32, hi * 16));
    p0 = __builtin_amdgcn_mfma_f32_32x32x16_bf16(b0, qr[0], nm, 0, 0, 0); p1 = __builtin_amdgcn_mfma_f32_32x32x16_bf16(b1, qr[0], nm, 0, 0, 0); }
  for (int d0 = 1; d0 < 8; ++d0) { int cb = ((d0 & 3) * 16 + hi * 8) * 2;
    bf16x8 b0 = *reinterpret_cast<const bf16x8*>((const char*)Ks + KSWZ(r32, cb) + (d0 >> 2) * 128);
    bf16x8 b1 = *reinterpret_cast<const bf16x8*>((const char*)Ks + KSWZ(32 + r32, cb) + (d0 >> 2) * 128);
    p0 = __builtin_amdgcn_mfma_f32_32x32x16_bf16(b0, qr[d0], p0, 0, 0, 0);
    p1 = __builtin_amdgcn_mfma_f32_32x32x16_bf16(b1, qr[d0], p1, 0, 0, 0); }
}
template <bool FIRST>
__device__ __forceinline__ void partialSM_rel(f32x16& p0, f32x16& p1, float& m_reg, f32x16& nm, float& alpha) {
  float pmax = p0[0]; for (int r = 1; r < 16; ++r) pmax = fmaxf(pmax, p0[r]); for (int r = 0; r < 16; ++r) pmax = fmaxf(pmax, p1[r]);
  { auto rr = __builtin_amdgcn_permlane32_swap(__float_as_uint(pmax), __float_as_uint(pmax), false, false);
    pmax = fmaxf(__uint_as_float(rr[0]), __uint_as_float(rr[1])); }
  if (!FIRST && __builtin_expect(__all(pmax <= THR * 1.4426950408889634f), 1)) { alpha = 1.f; }
  else { const float d = FIRST ? pmax : fmaxf(pmax, 0.f); alpha = FIRST ? 1.f : __builtin_amdgcn_exp2f(-d); m_reg += d;
    for (int r = 0; r < 16; ++r) { p0[r] -= d; p1[r] -= d; }
    for (int r = 0; r < 16; ++r) nm[r] = -m_reg; }
  for (int r = 0; r < 16; ++r) p0[r] = __builtin_amdgcn_exp2f(p0[r]);
  for (int r = 0; r < 8; ++r) p1[r] = __builtin_amdgcn_exp2f(p1[r]);
}
template <int MODE>
__device__ __forceinline__ void modify(f32x16& p0, f32x16& p1, int jt, const Par& P, int wid, int r32, int hi, const float* tbl) {
  if constexpr (MODE == 1) {
    const int qpos = P.qpos0 + wid * 32 + r32, kb = P.kpos0 + 64 * jt;
#pragma unroll
    for (int r = 0; r < 16; ++r) { const int kp = kb + crow(r, hi); int d0 = qpos - kp; d0 = d0 < 0 ? -d0 : d0; int d1 = qpos - (kp + 32); d1 = d1 < 0 ? -d1 : d1;
      p0[r] = (d0 <= 128) ? p0[r] - P.slopeR * (float)d0 : NEG; p1[r] = (d1 <= 128) ? p1[r] - P.slopeR * (float)d1 : NEG; }
  }
  if constexpr (MODE == 2) {
    const int r = P.r0 + (wid >> 1), c = 32 * (wid & 1) + r32;
    int rs = r - 4; rs = rs < 0 ? 0 : rs; rs = rs > P.rows - 8 ? P.rows - 8 : rs;
    int cs = c - 8; cs = cs < 0 ? 0 : cs; cs = cs > 48 ? 48 : cs;
    const int kr = P.kr0 + jt;
    if ((unsigned)(kr - rs) < 8u) {
      const float* tb = tbl + (kr - r + 7) * 32;
      int A = 4 * hi - cs, B = 4 * hi + 15 - c; asm volatile("" : "+v"(A), "+v"(B));
#pragma unroll
      for (int q = 0; q < 16; ++q) { const int kq = (q & 3) + 8 * (q >> 2);
        const int i0 = ((unsigned)(kq + A) < 16u) ? kq + B : 31, i1 = ((unsigned)(kq + 32 + A) < 16u) ? kq + 32 + B : 31;
        p0[q] += tb[i0]; p1[q] += tb[i1];
        if ((q & 3) == 3) asm volatile("" ::: "memory"); }
    } else {
#pragma unroll
      for (int q = 0; q < 16; ++q) { p0[q] = NEG; p1[q] = NEG; }
    }
  }
}
template <bool ROPE>
__device__ __forceinline__ void load_q(bf16x8 (&qr)[8], const char* Qp, const Par& P, int qrow, int hi) {
  float x[8][8]; float ss = 0.f;
#pragma unroll
  for (int d0 = 0; d0 < 8; ++d0) { const bf16x8 raw = *reinterpret_cast<const bf16x8*>(Qp + d0 * 32);
#pragma unroll
    for (int e = 0; e < 8; ++e) { x[d0][e] = __uint_as_float(((unsigned)(unsigned short)raw[e]) << 16); ss += x[d0][e] * x[d0][e]; } }
  { auto rr = __builtin_amdgcn_permlane32_swap(__float_as_uint(ss), __float_as_uint(ss), false, false); ss = __uint_as_float(rr[0]) + __uint_as_float(rr[1]); }
  const float rstd = __builtin_amdgcn_rsqf(ss * (1.0f / 128.0f) + 1e-6f) * (ROPE ? SCALE * 1.4426950408889634f : 1.0f);
#pragma unroll
  for (int d0 = 0; d0 < 8; ++d0) { const float* gp = P.gq + d0 * 16 + hi * 8;
#pragma unroll
    for (int e = 0; e < 8; ++e) x[d0][e] *= rstd * gp[e]; }
  if constexpr (ROPE) {
    const int t = P.qt0 + qrow; int hiR = hi; asm volatile("" : "+v"(hiR));
#pragma unroll
    for (int hb = 0; hb < 2; ++hb) { const int pos = hb ? (t & 63) : (t >> 6);
#pragma unroll
      for (int dd = 0; dd < 2; ++dd) { const float* cs = P.rope + ((size_t)pos * 32 + dd * 16 + hiR * 8) * 2; const int da = 4 * hb + dd, db = da + 2;
#pragma unroll
        for (int e = 0; e < 8; ++e) { const float c = cs[2 * e], s = cs[2 * e + 1], a = x[da][e], b = x[db][e]; x[da][e] = a * c - b * s; x[db][e] = b * c + a * s; } } }
  }
#pragma unroll
  for (int d0 = 0; d0 < 8; ++d0) { u32x4 w = {cvtpk(x[d0][0], x[d0][1]), cvtpk(x[d0][2], x[d0][3]), cvtpk(x[d0][4], x[d0][5]), cvtpk(x[d0][6], x[d0][7])}; qr[d0] = *reinterpret_cast<bf16x8*>(&w); }
}
__device__ __forceinline__ int v_st(int k, int c) { const int kk = (k & ~0xC) | ((k & 4) << 1) | ((k & 8) >> 1); return ((kk >> 3) * 4 + (c >> 5)) * 512 + ((kk & 7) * 32 + (c & 31)) * 2; }
__device__ __forceinline__ int v_rd_base(int lane) { return ((lane & 3) << 3) | (((lane >> 2) & 3) << 6) | (((lane >> 4) & 1) << 5) | (((lane >> 5) & 1) << 8); }
constexpr int v_rd_off(int d0, int ks, int half) { return d0 * 512 + ks * 4096 + half * 2048; }
template <int OFF> __device__ __forceinline__ s16x4 tr_read(int vb) {
  s16x4 r; asm volatile("ds_read_b64_tr_b16 %0, %1 offset:%2" : "=&v"(r) : "v"(vb), "i"(OFF) : "memory"); return r;
}
template <int D0> __device__ __forceinline__ void pv_one(f32x16& od, int vb, bf16x8 pa0, bf16x8 pa1, bf16x8 pa2, bf16x8 pa3) {
  const s16x4 l0 = tr_read<v_rd_off(D0, 0, 0)>(vb), h0 = tr_read<v_rd_off(D0, 0, 1)>(vb), l1 = tr_read<v_rd_off(D0, 1, 0)>(vb), h1 = tr_read<v_rd_off(D0, 1, 1)>(vb);
  const s16x4 l2 = tr_read<v_rd_off(D0, 2, 0)>(vb), h2 = tr_read<v_rd_off(D0, 2, 1)>(vb), l3 = tr_read<v_rd_off(D0, 3, 0)>(vb), h3 = tr_read<v_rd_off(D0, 3, 1)>(vb);
  asm volatile("s_waitcnt lgkmcnt(0)" ::: "memory"); SBAR();
#define PK(L, H) (bf16x8){L[0], L[1], L[2], L[3], H[0], H[1], H[2], H[3]}
  od = __builtin_amdgcn_mfma_f32_32x32x16_bf16(pa0, PK(l0, h0), od, 0, 0, 0);
  od = __builtin_amdgcn_mfma_f32_32x32x16_bf16(pa1, PK(l1, h1), od, 0, 0, 0);
  od = __builtin_amdgcn_mfma_f32_32x32x16_bf16(pa2, PK(l2, h2), od, 0, 0, 0);
  od = __builtin_amdgcn_mfma_f32_32x32x16_bf16(pa3, PK(l3, h3), od, 0, 0, 0);
#undef PK
}
__device__ __forceinline__ void pv_d0(f32x16* o, int vb, bf16x8 pa0, bf16x8 pa1, bf16x8 pa2, bf16x8 pa3) {
  pv_one<0>(o[0], vb, pa0, pa1, pa2, pa3); pv_one<1>(o[1], vb, pa0, pa1, pa2, pa3); pv_one<2>(o[2], vb, pa0, pa1, pa2, pa3); pv_one<3>(o[3], vb, pa0, pa1, pa2, pa3);
}

constexpr int GA_SLOT = 16384, GA_K = 0, GA_V = 4 * GA_SLOT, GA_WS = 134144;
__device__ __forceinline__ void glds16(const char* gbase, unsigned voff, unsigned ldsaddr) {
  unsigned sv; asm volatile("s_mov_b32 %0, m0\n\ts_mov_b32 m0, %3\n\ts_nop 3\n\tglobal_load_lds_dwordx4 %1, %2\n\ts_mov_b32 m0, %0" : "=&s"(sv) : "v"(voff), "s"(gbase), "s"(ldsaddr) : "memory"); }
typedef short v4i16_t __attribute__((ext_vector_type(4)));
typedef __attribute__((address_space(3))) char* lds_ptr;
template <int OFF> __device__ __forceinline__ s16x4 vtr(lds_ptr vb) {
  return __builtin_bit_cast(s16x4, __builtin_amdgcn_ds_read_tr16_b64_v4i16((__attribute__((address_space(3))) v4i16_t*)(vb + OFF))); }
template <int D0, int BASE> __device__ __forceinline__ void pv_oneB(f32x16& od, lds_ptr vb, bf16x8 pa0, bf16x8 pa1, bf16x8 pa2, bf16x8 pa3) {
  const s16x4 l0 = vtr<BASE + v_rd_off(D0, 0, 0)>(vb), h0 = vtr<BASE + v_rd_off(D0, 0, 1)>(vb), l1 = vtr<BASE + v_rd_off(D0, 1, 0)>(vb), h1 = vtr<BASE + v_rd_off(D0, 1, 1)>(vb);
  const s16x4 l2 = vtr<BASE + v_rd_off(D0, 2, 0)>(vb), h2 = vtr<BASE + v_rd_off(D0, 2, 1)>(vb), l3 = vtr<BASE + v_rd_off(D0, 3, 0)>(vb), h3 = vtr<BASE + v_rd_off(D0, 3, 1)>(vb);
#define PK(L, H) (bf16x8){L[0], L[1], L[2], L[3], H[0], H[1], H[2], H[3]}
  od = __builtin_amdgcn_mfma_f32_32x32x16_bf16(pa0, PK(l0, h0), od, 0, 0, 0);
  od = __builtin_amdgcn_mfma_f32_32x32x16_bf16(pa1, PK(l1, h1), od, 0, 0, 0);
  od = __builtin_amdgcn_mfma_f32_32x32x16_bf16(pa2, PK(l2, h2), od, 0, 0, 0);
  od = __builtin_amdgcn_mfma_f32_32x32x16_bf16(pa3, PK(l3, h3), od, 0, 0, 0);
#undef PK
}
template <int BASE> __device__ __forceinline__ void pv_d0B(f32x16* o, lds_ptr vb, bf16x8 pa0, bf16x8 pa1, bf16x8 pa2, bf16x8 pa3) {
  pv_oneB<0, BASE>(o[0], vb, pa0, pa1, pa2, pa3); pv_oneB<1, BASE>(o[1], vb, pa0, pa1, pa2, pa3); pv_oneB<2, BASE>(o[2], vb, pa0, pa1, pa2, pa3); pv_oneB<3, BASE>(o[3], vb, pa0, pa1, pa2, pa3);
}
struct KF { bf16x8 a, b; };
template <int OFF> __device__ __forceinline__ bf16x8 kld(lds_ptr p) { return *(const __attribute__((address_space(3))) bf16x8*)(p + OFF); }
#define KLDP(F, SLOT, d0) do { F.a = kld<(SLOT) * GA_SLOT + ((d0) >> 2) * 128>(kq[(d0) & 3]); F.b = kld<(SLOT) * GA_SLOT + ((d0) >> 2) * 128 + 8192>(kq[(d0) & 3]); } while (0)
#define PIN(x) asm volatile("" : "+v"(x))
#define MFMA32(a, b, c) __builtin_amdgcn_mfma_f32_32x32x16_bf16(a, b, c, 0, 0, 0)
template <int KS>
__device__ __forceinline__ void qk_softmax(f32x16& C0, f32x16& C1, KF& ka, KF& kb, const lds_ptr (&kq)[4], const bf16x8 (&qr)[8], const f32x16& nm,
                                           f32x16& P0, f32x16& P1, float alpha, float& l_reg, bf16x8& pa0, bf16x8& pa1, bf16x8& pa2, bf16x8& pa3) {
  float sacc; unsigned a0, a1, b0, b1;
#define EXP1(i) P1[i] = __builtin_amdgcn_exp2f(P1[i]); PIN(P1)
#define SWZ(OUT) do { auto r0_ = __builtin_amdgcn_permlane32_swap(a0, b0, false, false); auto r1_ = __builtin_amdgcn_permlane32_swap(a1, b1, false, false); \
    u32x4 w_ = {r0_[0], r1_[0], r0_[1], r1_[1]}; OUT = *reinterpret_cast<bf16x8*>(&w_); PIN(OUT); } while (0)
  C0 = MFMA32(ka.a, qr[0], nm); EXP1(8);  sacc = P0[0] + P0[1];            a0 = cvtpk(P0[0], P0[1]);   PIN(sacc); PIN(a0); SBAR();
  C1 = MFMA32(ka.b, qr[0], nm); EXP1(9);  sacc += P0[2]; sacc += P0[3];    a1 = cvtpk(P0[2], P0[3]);   PIN(sacc); PIN(a1); SBAR();
  KLDP(ka, KS, 2); SBAR();
  C0 = MFMA32(kb.a, qr[1], C0); EXP1(10); sacc += P0[4]; sacc += P0[5];    b0 = cvtpk(P0[4], P0[5]);   PIN(sacc); PIN(b0); SBAR();
  C1 = MFMA32(kb.b, qr[1], C1); EXP1(11); sacc += P0[6]; sacc += P0[7];    b1 = cvtpk(P0[6], P0[7]);   PIN(sacc); SWZ(pa0); SBAR();
  KLDP(kb, KS, 3); SBAR();
  C0 = MFMA32(ka.a, qr[2], C0); EXP1(12); sacc += P0[8]; sacc += P0[9];    a0 = cvtpk(P0[8], P0[9]);   PIN(sacc); PIN(a0); SBAR();
  C1 = MFMA32(ka.b, qr[2], C1); EXP1(13); sacc += P0[10]; sacc += P0[11];  a1 = cvtpk(P0[10], P0[11]); PIN(sacc); PIN(a1); SBAR();
  KLDP(ka, KS, 4); SBAR();
  C0 = MFMA32(kb.a, qr[3], C0); EXP1(14); sacc += P0[12]; sacc += P0[13];  b0 = cvtpk(P0[12], P0[13]); PIN(sacc); PIN(b0); SBAR();
  C1 = MFMA32(kb.b, qr[3], C1); EXP1(15); sacc += P0[14]; sacc += P0[15];  b1 = cvtpk(P0[14], P0[15]); PIN(sacc); SWZ(pa1); SBAR();
  KLDP(kb, KS, 5); SBAR();
  C0 = MFMA32(ka.a, qr[4], C0); sacc += P1[0]; sacc += P1[1];    a0 = cvtpk(P1[0], P1[1]);   PIN(sacc); PIN(a0); SBAR();
  C1 = MFMA32(ka.b, qr[4], C1); sacc += P1[2]; sacc += P1[3];    a1 = cvtpk(P1[2], P1[3]);   PIN(sacc); PIN(a1); SBAR();
  KLDP(ka, KS, 6); SBAR();
  C0 = MFMA32(kb.a, qr[5], C0); sacc += P1[4]; sacc += P1[5];    b0 = cvtpk(P1[4], P1[5]);   PIN(sacc); PIN(b0); SBAR();
  C1 = MFMA32(kb.b, qr[5], C1); sacc += P1[6]; sacc += P1[7];    b1 = cvtpk(P1[6], P1[7]);   PIN(sacc); SWZ(pa2); SBAR();
  KLDP(kb, KS, 7); SBAR();
  C0 = MFMA32(ka.a, qr[6], C0); sacc += P1[8]; sacc += P1[9];    a0 = cvtpk(P1[8], P1[9]);   PIN(sacc); PIN(a0); SBAR();
  C1 = MFMA32(ka.b, qr[6], C1); sacc += P1[10]; sacc += P1[11];  a1 = cvtpk(P1[10], P1[11]); PIN(sacc); PIN(a1); SBAR();
  C0 = MFMA32(kb.a, qr[7], C0); sacc += P1[12]; sacc += P1[13];  b0 = cvtpk(P1[12], P1[13]); PIN(sacc); PIN(b0); SBAR();
  C1 = MFMA32(kb.b, qr[7], C1); sacc += P1[14]; sacc += P1[15];  b1 = cvtpk(P1[14], P1[15]); PIN(sacc); SWZ(pa3);
  { auto rr = __builtin_amdgcn_permlane32_swap(__float_as_uint(sacc), __float_as_uint(sacc), false, false); sacc = __uint_as_float(rr[0]) + __uint_as_float(rr[1]); }
  l_reg = l_reg * alpha + sacc; SBAR();
#undef EXP1
#undef SWZ
}
struct VF { s16x4 l0, h0, l1, h1, l2, h2, l3, h3; };
template <int BASE, int D0> __device__ __forceinline__ void rdg(VF& f, lds_ptr vb) {
  f.l0 = vtr<BASE + v_rd_off(D0, 0, 0)>(vb); f.h0 = vtr<BASE + v_rd_off(D0, 0, 1)>(vb); f.l1 = vtr<BASE + v_rd_off(D0, 1, 0)>(vb); f.h1 = vtr<BASE + v_rd_off(D0, 1, 1)>(vb);
  f.l2 = vtr<BASE + v_rd_off(D0, 2, 0)>(vb); f.h2 = vtr<BASE + v_rd_off(D0, 2, 1)>(vb); f.l3 = vtr<BASE + v_rd_off(D0, 3, 0)>(vb); f.h3 = vtr<BASE + v_rd_off(D0, 3, 1)>(vb); }
#define MX3(a, b, c) fmaxf(fmaxf((a), (b)), (c))
#define PKF(L, H) (bf16x8){L[0], L[1], L[2], L[3], H[0], H[1], H[2], H[3]}
template <int BASE, int KSN>
__device__ __forceinline__ void pv_softmax(f32x16* o, lds_ptr vb, bf16x8 pa0, bf16x8 pa1, bf16x8 pa2, bf16x8 pa3, f32x16& C0, f32x16& C1, float& m_reg, f32x16& nm, float& alpha, KF& ka, KF& kb, const lds_ptr (&kq)[4]) {
  VF fa, fb; float mx0, mx1;
  rdg<BASE, 0>(fa, vb); rdg<BASE, 1>(fb, vb); SBAR();
  o[0] = MFMA32(pa0, PKF(fa.l0, fa.h0), o[0]); mx0 = MX3(C0[0], C0[1], C0[2]);    mx1 = MX3(C0[3], C0[4], C0[5]);    mx0 = MX3(mx0, C0[6], C0[7]);   mx1 = MX3(mx1, C0[8], C0[9]);   PIN(mx0); PIN(mx1); SBAR();
  o[0] = MFMA32(pa1, PKF(fa.l1, fa.h1), o[0]); mx0 = MX3(mx0, C0[10], C0[11]);    mx1 = MX3(mx1, C0[12], C0[13]);    mx0 = MX3(mx0, C0[14], C0[15]); mx1 = MX3(mx1, C1[0], C1[1]);   PIN(mx0); PIN(mx1); SBAR();
  o[0] = MFMA32(pa2, PKF(fa.l2, fa.h2), o[0]); mx0 = MX3(mx0, C1[2], C1[3]);      mx1 = MX3(mx1, C1[4], C1[5]);      mx0 = MX3(mx0, C1[6], C1[7]);   mx1 = MX3(mx1, C1[8], C1[9]);   PIN(mx0); PIN(mx1); SBAR();
  o[0] = MFMA32(pa3, PKF(fa.l3, fa.h3), o[0]); mx0 = MX3(mx0, C1[10], C1[11]);    mx1 = MX3(mx1, C1[12], C1[13]);    mx0 = MX3(mx0, C1[14], C1[15]); float pmax = fmaxf(mx0, mx1);
  { auto rr = __builtin_amdgcn_permlane32_swap(__float_as_uint(pmax), __float_as_uint(pmax), false, false); pmax = fmaxf(__uint_as_float(rr[0]), __uint_as_float(rr[1])); } PIN(pmax); SBAR();
  rdg<BASE, 2>(fa, vb); SBAR();
  if (__builtin_expect(__all(pmax <= THR * 1.4426950408889634f), 1)) { alpha = 1.f; }
  else { const float d = fmaxf(pmax, 0.f); alpha = __builtin_amdgcn_exp2f(-d); m_reg += d;
    for (int r = 0; r < 16; ++r) { C0[r] -= d; C1[r] -= d; }
    for (int r = 0; r < 16; ++r) nm[r] = -m_reg; }
  SBAR();
#define EX2(C, i) C[i] = __builtin_amdgcn_exp2f(C[i]); C[i + 1] = __builtin_amdgcn_exp2f(C[i + 1]); PIN(C); SBAR()
  o[1] = MFMA32(pa0, PKF(fb.l0, fb.h0), o[1]); EX2(C0, 0);
  o[1] = MFMA32(pa1, PKF(fb.l1, fb.h1), o[1]); EX2(C0, 2);
  o[1] = MFMA32(pa2, PKF(fb.l2, fb.h2), o[1]); EX2(C0, 4);
  o[1] = MFMA32(pa3, PKF(fb.l3, fb.h3), o[1]); EX2(C0, 6);
  rdg<BASE, 3>(fb, vb); KLDP(ka, KSN, 0); KLDP(kb, KSN, 1); SBAR();
  o[2] = MFMA32(pa0, PKF(fa.l0, fa.h0), o[2]); EX2(C0, 8);
  o[2] = MFMA32(pa1, PKF(fa.l1, fa.h1), o[2]); EX2(C0, 10);
  o[2] = MFMA32(pa2, PKF(fa.l2, fa.h2), o[2]); EX2(C0, 12);
  o[2] = MFMA32(pa3, PKF(fa.l3, fa.h3), o[2]); EX2(C0, 14);
  o[3] = MFMA32(pa0, PKF(fb.l0, fb.h0), o[3]); EX2(C1, 0);
  o[3] = MFMA32(pa1, PKF(fb.l1, fb.h1), o[3]); EX2(C1, 2);
  o[3] = MFMA32(pa2, PKF(fb.l2, fb.h2), o[3]); EX2(C1, 4);
  o[3] = MFMA32(pa3, PKF(fb.l3, fb.h3), o[3]); EX2(C1, 6);
#undef EX2
}
template <int MODE>
__device__ __forceinline__ void attn_body(const bf16* __restrict__ Qb, const bf16* __restrict__ Kh, const bf16* __restrict__ Vh, bf16* __restrict__ Ob, int NT, char* lds, const Par P, const int tid) {
  static_assert(MODE == 0, "dense only");
  const int wid = __builtin_amdgcn_readfirstlane(tid >> 6), lane = tid & 63, r32 = lane & 31, hi = lane >> 5;
  float* ws = (float*)(lds + GA_WS) + wid * 64; float* li_l = ws; float* al_l = ws + 32;
  float m_reg = 0.f, l_reg = 0; f32x16 nm = {}; f32x16 o[4] = {}; bf16x8 qr[8];
  unsigned kof0, kof1, vof0, vof1;
  { const int rw0 = wid * 8 + (lane >> 4), rw1 = rw0 + 4; kof0 = (unsigned)(rw0 * LDK * 2 + (((lane & 15) ^ (rw0 & 7)) << 4)); kof1 = (unsigned)(rw1 * LDK * 2 + (((lane & 15) ^ (rw1 & 7)) << 4));
    const int s0 = wid * 4 + (lane >> 5), s1 = s0 + 2, kl = (lane & 31) >> 2, cl = (lane & 3) * 8;
    const int kk0 = (s0 >> 2) * 8 + kl, kk1 = (s1 >> 2) * 8 + kl, k0 = (kk0 & ~0xC) | ((kk0 & 4) << 1) | ((kk0 & 8) >> 1), k1 = (kk1 & ~0xC) | ((kk1 & 4) << 1) | ((kk1 & 8) >> 1);
    vof0 = (unsigned)(k0 * LDK * 2 + ((s0 & 3) * 32 + cl) * 2); vof1 = (unsigned)(k1 * LDK * 2 + ((s1 & 3) * 32 + cl) * 2); }
  const unsigned lds0 = (unsigned)(uintptr_t)lds;
  const unsigned kdst = (unsigned)__builtin_amdgcn_readfirstlane((int)(lds0 + GA_K + wid * 2048)), vdst = (unsigned)__builtin_amdgcn_readfirstlane((int)(lds0 + GA_V + wid * 2048));
#define DMA_K(t, slot) do { const char* g_ = (const char*)Kh + (size_t)(t) * (KVBLK * LDK * 2); glds16(g_, kof0, kdst + (slot) * GA_SLOT); glds16(g_, kof1, kdst + (slot) * GA_SLOT + 1024); } while (0)
#define DMA_V(t, slot) do { const char* g_ = (const char*)Vh + (size_t)(t) * (KVBLK * LDK * 2); glds16(g_, vof0, vdst + (slot) * GA_SLOT); glds16(g_, vof1, vdst + (slot) * GA_SLOT + 1024); } while (0)
#define WAIT_BAR(N) asm volatile("s_waitcnt vmcnt(" #N ") lgkmcnt(0)\n\ts_barrier" ::: "memory")
  DMA_K(0, 0); DMA_V(0, 0); DMA_K(1, 1); DMA_K(2, 2); DMA_V(1, 1); DMA_K(3, 3); DMA_V(2, 2);
  const unsigned qoff = (unsigned)((wid * QBLK + r32) * LDQ + hi * 8) * 2u;
  load_q<true>(qr, (const char*)Qb + qoff, P, wid * QBLK + r32, hi);
  const lds_ptr vb0 = (lds_ptr)(lds + GA_V) + v_rd_base(lane);
  lds_ptr kq[4];
#pragma unroll
  for (int i = 0; i < 4; ++i) kq[i] = (lds_ptr)(lds + GA_K) + KSWZ(r32, i * 32 + hi * 16);
  KF ka, kb;
#define RESC(a) do { if (__any((a) < 1.f)) { if (hi == 0) al_l[r32] = (a); asm volatile("s_waitcnt lgkmcnt(0)" ::: "memory"); \
    for (int d = 0; d < 4; ++d) for (int r = 0; r < 16; ++r) o[d][r] *= al_l[crow(r, hi)]; } } while (0)
  f32x16 pA0, pA1, pB0, pB1; float alA, alB; bf16x8 pa0, pa1, pa2, pa3;
#define STEP(C0, C1, AC, P0, P1, AP, j, KS, VS, DK, DV, CLAMP) do { \
    SBAR(); qk_softmax<KS>(C0, C1, ka, kb, kq, qr, nm, P0, P1, AP, l_reg, pa0, pa1, pa2, pa3); \
    { int tk = (j) + 3, tv = (j) + 2; if (CLAMP) { tk = tk < NT - 1 ? tk : NT - 1; tv = tv < NT - 1 ? tv : NT - 1; } DMA_K(tk, DK); DMA_V(tv, DV); } SBAR(); \
    pv_softmax<(VS) * GA_SLOT, ((KS) + 1) & 3>(o, vb0, pa0, pa1, pa2, pa3, C0, C1, m_reg, nm, AC, ka, kb, kq); \
    RESC(AC); WAIT_BAR(6); } while (0)
  WAIT_BAR(0);
  qkt_rel(pA0, pA1, (const bf16*)(lds + GA_K), qr, r32, hi, nm); partialSM_rel<true>(pA0, pA1, m_reg, nm, alA);
  KLDP(ka, 1, 0); KLDP(kb, 1, 1);
  WAIT_BAR(6);
  int j = 1;
  for (; j + 6 < NT; j += 4) {
    STEP(pB0, pB1, alB, pA0, pA1, alA, j,     1, 0, 0, 3, false);
    STEP(pA0, pA1, alA, pB0, pB1, alB, j + 1, 2, 1, 1, 0, false);
    STEP(pB0, pB1, alB, pA0, pA1, alA, j + 2, 3, 2, 2, 1, false);
    STEP(pA0, pA1, alA, pB0, pB1, alB, j + 3, 0, 3, 3, 2, false);
  }
  STEP(pB0, pB1, alB, pA0, pA1, alA, j,     1, 0, 0, 3, true);
  STEP(pA0, pA1, alA, pB0, pB1, alB, j + 1, 2, 1, 1, 0, true);
  STEP(pB0, pB1, alB, pA0, pA1, alA, j + 2, 3, 2, 2, 1, true);
  finishSM<8>(pB0, pB1, alB, l_reg, pa0, pa1, pa2, pa3); SBAR();
  pv_d0B<3 * GA_SLOT>(o, vb0, pa0, pa1, pa2, pa3);
  asm volatile("s_waitcnt vmcnt(0)" ::: "memory");
  if (hi == 0) li_l[r32] = l_reg; asm volatile("s_waitcnt lgkmcnt(0)" ::: "memory");
  float rli[16];
#pragma unroll
  for (int r = 0; r < 16; ++r) rli[r] = __builtin_amdgcn_rcpf(li_l[crow(r, hi)]);
  const unsigned ooff = (unsigned)((wid * QBLK + 4 * hi) * LDO + r32) * 2u;
#pragma unroll
  for (int r = 0; r < 16; ++r) { const int orow0 = (r & 3) + 8 * (r >> 2);
#pragma unroll
    for (int d0 = 0; d0 < 4; ++d0) *reinterpret_cast<bf16*>((char*)Ob + ooff + (unsigned)(orow0 * LDO + d0 * 32) * 2u) = (bf16)(cvtpk(o[d0][r] * rli[r], 0.f) & 0xffffu); }
  asm volatile("s_waitcnt lgkmcnt(0)\n\ts_barrier" ::: "memory");
#undef DMA_K
#undef DMA_V
#undef WAIT_BAR
#undef RESC
#undef STEP
}
template <int MODE>
__device__ __forceinline__ void attn_body_simple(const bf16* __restrict__ Qb, const bf16* __restrict__ Kh, const bf16* __restrict__ Vh, bf16* __restrict__ Ob, int NT, char* lds, const Par P, const int tid) {
  const int wid = __builtin_amdgcn_readfirstlane(tid >> 6), lane = tid & 63, r32 = lane & 31, hi = lane >> 5;
  char* V_lds = lds; char* K_lds = lds + 2 * SHM_V;
  float* ws = (float*)(lds + 2 * SHM_V + 2 * SHM_K) + wid * 64; float* li_l = ws; float* al_l = ws + 32;
  const float* tbl = (const float*)(lds + TBL_OFF);
  float m_reg = NEG, l_reg = 0; f32x16 o[4] = {}; bf16x8 qr[8];
  const unsigned qoff = (unsigned)((wid * QBLK + r32) * LDQ + hi * 8) * 2u;
  load_q<false>(qr, (const char*)Qb + qoff, P, wid * QBLK + r32, hi);
  const int sr = tid >> 4, sc = (tid & 15) * 8, vst0 = v_st(sr, sc), vst1 = v_st(32 + sr, sc), kst0 = KSWZ(sr, sc * 2), kst1 = KSWZ(32 + sr, sc * 2);
  const unsigned kvo0 = (unsigned)(sr * LDK + sc) * 2u, kvo1 = kvo0 + (unsigned)(32 * LDK * 2);
  const int vb0 = (int)(uintptr_t)V_lds + v_rd_base(lane);
  bf16x8 vs0, vs1, ks0, ks1;
#define SLD(k0) do { const char* vp_ = (const char*)Vh + (size_t)(k0) * (LDK * 2); const char* kp_ = (const char*)Kh + (size_t)(k0) * (LDK * 2); \
    vs0 = *reinterpret_cast<const bf16x8*>(vp_ + kvo0); vs1 = *reinterpret_cast<const bf16x8*>(vp_ + kvo1); ks0 = *reinterpret_cast<const bf16x8*>(kp_ + kvo0); ks1 = *reinterpret_cast<const bf16x8*>(kp_ + kvo1); } while (0)
  SLD(0);
  for (int jt = 0; jt < NT; ++jt) {
    const int b = jt & 1; char* Vb = V_lds + b * SHM_V; char* Kb = K_lds + b * SHM_K;
    *(bf16x8*)(Vb + vst0) = vs0; *(bf16x8*)(Vb + vst1) = vs1; *(bf16x8*)(Kb + kst0) = ks0; *(bf16x8*)(Kb + kst1) = ks1;
    if (jt + 1 < NT) SLD((jt + 1) * KVBLK);
    __syncthreads();
    bool need;
    if constexpr (MODE == 1) { const int kb = P.kpos0 + 64 * jt, qlo = P.qpos0 + wid * 32; need = (kb + 63 >= qlo - 128) && (kb <= qlo + 31 + 128); }
    else { const int r = P.r0 + (wid >> 1); int rs = r - 4; rs = rs < 0 ? 0 : rs; rs = rs > P.rows - 8 ? P.rows - 8 : rs; need = (unsigned)(P.kr0 + jt - rs) < 8u; }
    if (!need) continue;
    f32x16 p0, p1; float mn, alpha; bf16x8 pa0, pa1, pa2, pa3;
    qkt(p0, p1, (const bf16*)Kb, qr, r32, hi); modify<MODE>(p0, p1, jt, P, wid, r32, hi, tbl);
    partialSM(p0, p1, m_reg, mn, alpha);
    if (__any(alpha < 1.f)) { if (hi == 0) al_l[r32] = alpha; asm volatile("s_waitcnt lgkmcnt(0)" ::: "memory");
      for (int d = 0; d < 4; ++d) for (int r = 0; r < 16; ++r) o[d][r] *= al_l[crow(r, hi)]; }
    finishSM(p0, p1, alpha, l_reg, pa0, pa1, pa2, pa3);
    pv_d0(o, vb0 + b * (int)SHM_V, pa0, pa1, pa2, pa3);
  }
  if constexpr (MODE == 1) l_reg += __builtin_amdgcn_exp2f((P.sinkR - m_reg) * (SCALE * 1.4426950408889634f));
  if (hi == 0) li_l[r32] = l_reg; asm volatile("s_waitcnt lgkmcnt(0)" ::: "memory");
  float rli[16];
#pragma unroll
  for (int r = 0; r < 16; ++r) rli[r] = __builtin_amdgcn_rcpf(li_l[crow(r, hi)]);
  const unsigned ooff = (unsigned)((wid * QBLK + 4 * hi) * LDO + r32) * 2u;
#pragma unroll
  for (int r = 0; r < 16; ++r) { const int orow0 = (r & 3) + 8 * (r >> 2);
#pragma unroll
    for (int d0 = 0; d0 < 4; ++d0) *reinterpret_cast<bf16*>((char*)Ob + ooff + (unsigned)(orow0 * LDO + d0 * 32) * 2u) = (bf16)(cvtpk(o[d0][r] * rli[r], 0.f) & 0xffffu); }
  __syncthreads();
#undef SLD
}
#undef KSWZ
#undef SBAR
#undef MX3
#undef PIN
#undef PKF
#undef MFMA32
#undef KLDP
}

constexpr int NWAVES = 8;
constexpr int DM = 2048, DFF = 5632, DIN = 6144, HD = 128, NLAYER = 2;
constexpr int MTOT = 65536, MC = 32768, NCHUNK = 2;
constexpr float EPS = 1e-6f;
constexpr int C_QA = 0, C_KA = 1024, C_VA = 2048, C_QB = 3072, C_KB = 4096, C_VB = 4352, C_QC = 4608, C_KC = 5632, C_VC = 5888;
constexpr size_t MiB = 1u << 20;
constexpr size_t WS_CTL = 0, CTL_ZERO_BYTES = 1 * MiB;
constexpr size_t WS_ROPE = 1 * MiB;
constexpr size_t WS_W = 2 * MiB;
constexpr size_t W13_BYTES = (size_t)2 * DFF * DM * 2, WD_BYTES = (size_t)DM * DFF * 2, WIN_BYTES = (size_t)DIN * DM * 2, WGATE_BYTES = (size_t)3 * DM * DM * 2,
                 WBR_BYTES = (size_t)3 * DM * 1024 * 2, WOUT3_BYTES = (size_t)DM * DM * 2;
constexpr size_t LW_W13_1 = 0, LW_WD_1 = LW_W13_1 + W13_BYTES, LW_WIN = LW_WD_1 + WD_BYTES, LW_WGATE = LW_WIN + WIN_BYTES, LW_WBR = LW_WGATE + WGATE_BYTES,
                 LW_WOUT3 = LW_WBR + WBR_BYTES, LW_W13_2 = LW_WOUT3 + WOUT3_BYTES, LW_WD_2 = LW_W13_2 + W13_BYTES, LAYER_W_BYTES = LW_WD_2 + WD_BYTES;
constexpr size_t WS_H = WS_W + NLAYER * LAYER_W_BYTES;
constexpr size_t WS_QKV = WS_H + (size_t)MC * DM * 2;
constexpr size_t WS_BB = WS_QKV;
constexpr size_t WS_O = WS_QKV + (size_t)MC * DIN * 2;
constexpr size_t WS_MRG = WS_O;
constexpr size_t WS_SSQ = WS_O + (size_t)MC * 3072 * 2;
constexpr size_t WS_SCR = WS_SSQ + (size_t)MC * 32 * 4;
constexpr size_t WS_END = WS_SCR + (size_t)304 * 262144;
static_assert(LAYER_W_BYTES % 256 == 0 && WS_H % 256 == 0, "ws map alignment");
constexpr int CW_BAR = 4096;
constexpr int RING_OFF = 0, RING_BYTES = 131072;
constexpr int LDSCTL_OFF = RING_BYTES, MISC_OFF = LDSCTL_OFF + 320, RTAB_OFF = LDSCTL_OFF + 1024;
constexpr int LDS_BYTES = 147456;
static_assert(RING_OFF == 0 && att::GA_WS >= RTAB_OFF + 2048 && att::GA_WS + att::NW * 256 <= LDS_BYTES && att::GA_V + 4 * att::GA_SLOT <= RING_BYTES, "the dense attention rings fill the stage ring; its per-wave scratch sits behind the row-scale tables");

#define GAS __attribute__((address_space(1)))
#define LAS __attribute__((address_space(3)))
typedef unsigned short bf16;
typedef unsigned v4u __attribute__((ext_vector_type(4)));
typedef unsigned v2u __attribute__((ext_vector_type(2)));
typedef float f32x4 __attribute__((ext_vector_type(4)));
typedef GAS unsigned gu32;
#define LDS_WAIT() asm volatile("s_waitcnt lgkmcnt(0)" ::: "memory")
#define VM_WAIT() asm volatile("s_waitcnt vmcnt(0)" ::: "memory")
__device__ __forceinline__ unsigned f2bf(float f) { unsigned u = __builtin_bit_cast(unsigned, f); return (u + 0x7fffu + ((u >> 16) & 1u)) >> 16; }
__device__ __forceinline__ unsigned pk2(float lo, float hi) { return f2bf(lo) | (f2bf(hi) << 16); }

__device__ __forceinline__ int launder_s(int x) { asm volatile("" : "+s"(x)); return x; }
__device__ __forceinline__ int launder_v(int x) { asm volatile("" : "+v"(x)); return x; }
__device__ __forceinline__ int lane_id_local() { unsigned m = ~0u; asm volatile("" : "+s"(m)); return (int)__builtin_amdgcn_mbcnt_hi(m, __builtin_amdgcn_mbcnt_lo(m, 0u)); }

#define XB_TMO      128
#define XB_XCNT(j)  (256  + 64 * (j))
#define XB_XSUB(j)  (1280 + 64 * (j))
#define XB_XGEN(j)  (2304 + 64 * (j))
#define XB_TOP      3328
#define XB_TOPGEN   3392
#define XCD_BAR_WORDS 3456
#define XB_SPIN_CAP (1u << 22)

__device__ __forceinline__ unsigned xb_ld(unsigned* p)              { return __hip_atomic_load(p, __ATOMIC_RELAXED, __HIP_MEMORY_SCOPE_AGENT); }
__device__ __forceinline__ unsigned xb_add(unsigned* p, unsigned v) { return __hip_atomic_fetch_add(p, v, __ATOMIC_RELAXED, __HIP_MEMORY_SCOPE_AGENT); }
__device__ __forceinline__ unsigned xb_xcc_id() { return (unsigned)__builtin_amdgcn_s_getreg((3 << 11) | 20) & 0xFu; }
#define XB_SPIN(cond, bar) do { unsigned _sp = 0; while (cond) { __builtin_amdgcn_s_sleep(1); \
    if ((++_sp & 255u) == 0u) { if (xb_ld(&(bar)[XB_TMO])) break; if (_sp > XB_SPIN_CAP) { atomicAdd(&(bar)[XB_TMO], 1u); break; } } } } while (0)

struct XcdBarrier { unsigned* bar; unsigned x; volatile LAS unsigned* st; };

__device__ __forceinline__ XcdBarrier xcd_barrier_post(unsigned* bar, volatile LAS unsigned* st) {
    XcdBarrier b; b.bar = bar; b.x = xb_xcc_id(); b.st = st;
    if (threadIdx.x == 0) (void)xb_add(&bar[XB_XCNT(b.x)], 1u);
    return b;
}
__device__ __forceinline__ void xcd_barrier_complete(unsigned* bar, unsigned x, unsigned& nloc, unsigned& nx) {
    const unsigned G = gridDim.x * gridDim.y * gridDim.z;
    unsigned sum, cnt, mine, sp = 0u;
    for (;;) {
        sum = 0u; cnt = 0u; mine = 0u;
#pragma unroll
        for (unsigned j = 0; j < 16; ++j) { const unsigned c = xb_ld(&bar[XB_XCNT(j)]); sum += c; cnt += (c > 0u) ? 1u : 0u; mine = (j == x) ? c : mine; }
        if (sum == G) break;
        __builtin_amdgcn_s_sleep(1);
        if ((++sp & 255u) == 0u) { if (xb_ld(&bar[XB_TMO])) break; if (sp > XB_SPIN_CAP) { atomicAdd(&bar[XB_TMO], 1u); break; } }
    }
    nloc = mine > 0u ? mine : 1u; nx = cnt > 0u ? cnt : 1u;
}
__device__ __forceinline__ void xcd_barrier(const XcdBarrier& b, const int wave_s) {
    asm volatile("s_waitcnt vmcnt(0)" ::: "memory");
    __syncthreads();
    if (launder_s(wave_s) == 0 && lane_id_local() == 0) {
        unsigned* bar = b.bar; unsigned bx_ = b.x; asm volatile("" : "+s"(bar), "+s"(bx_));
        __builtin_amdgcn_s_waitcnt(0);
        unsigned nloc = b.st[0], nx = b.st[1];
        if (nloc == 0u) { xcd_barrier_complete(bar, bx_, nloc, nx); b.st[0] = nloc; b.st[1] = nx; }
        const unsigned old = xb_add(&bar[XB_XSUB(bx_)], 1u);
        const unsigned gen = old / nloc;
        if (old + 1u == (gen + 1u) * nloc) {
            __builtin_amdgcn_fence(__ATOMIC_RELEASE, "agent");
            asm volatile("s_waitcnt vmcnt(0)" ::: "memory");
            const unsigned og = xb_add(&bar[XB_TOP], 1u);
            const unsigned tg = og / nx;
            if (og + 1u == (tg + 1u) * nx) xb_add(&bar[XB_TOPGEN], 1u);
            else XB_SPIN(xb_ld(&bar[XB_TOPGEN]) == tg, bar);
            __builtin_amdgcn_fence(__ATOMIC_ACQUIRE, "agent");
            xb_add(&bar[XB_XGEN(bx_)], 1u);
            asm volatile("s_waitcnt vmcnt(0)" ::: "memory");
        } else {
            XB_SPIN(xb_ld(&bar[XB_XGEN(bx_)]) == gen, bar);
            __builtin_amdgcn_fence(__ATOMIC_ACQUIRE, "agent");
            asm volatile("s_waitcnt vmcnt(0)" ::: "memory");
        }
    }
    __syncthreads();
}

using pg8::shx;
__device__ __forceinline__ float wave_sum(float v, int lane) {
#pragma unroll
    for (int o = 1; o < 64; o <<= 1) v += shx(v, o, lane);
    return v;
}
__device__ __forceinline__ void row_to_xb(const float* xrow, bf16* orow, float* ssqrow, int lane) {
    const GAS f32x4* xr = (const GAS f32x4*)xrow + lane;
    f32x4 v[8]; float s = 0.f;
#pragma unroll
    for (int j = 0; j < 8; ++j) { v[j] = xr[64 * j]; s += (v[j].x * v[j].x + v[j].y * v[j].y) + (v[j].z * v[j].z + v[j].w * v[j].w); }
    s = wave_sum(s, lane);
    GAS v2u* o8 = (GAS v2u*)orow + lane;
#pragma unroll
    for (int j = 0; j < 8; ++j) { v2u w; w.x = pk2(v[j].x, v[j].y); w.y = pk2(v[j].z, v[j].w); o8[64 * j] = w; }
    if (lane < pg8::NSSQ) ssqrow[lane] = lane == 0 ? s : 0.f;
}

__device__ __forceinline__ void convert_item(const float* W, int K, int N, bf16* dst, int ldd, int mode, const float* gain, int item, int lane) {
    const int nb = N >> 8, kb = item / nb, n0 = ((item - kb * nb) << 8) + 4 * lane, k0 = 32 * kb;
    bf16* dp;
    if (mode == 2) dp = dst + (((size_t)(n0 >> 8) * (K >> 6) + (k0 >> 6)) * 256 + (n0 & 255)) * 64 + (k0 & 63);
    else dp = dst + (size_t)(mode ? ((n0 >> 7) * 256 + (n0 & 127)) : n0) * ldd + k0;
    const int rp = (mode == 2) ? 64 : ldd;
#pragma unroll 1
    for (int t8 = 0; t8 < 4; ++t8) {
        f32x4 v[8];
#pragma unroll
        for (int t = 0; t < 8; ++t) { const int k = k0 + 8 * t8 + t; const float gk = gain ? gain[k] : 1.0f; v[t] = *(const GAS f32x4*)(W + (size_t)k * N + n0) * gk; }
#pragma unroll
        for (int e = 0; e < 4; ++e) { v4u o; o.x = pk2(v[0][e], v[1][e]); o.y = pk2(v[2][e], v[3][e]); o.z = pk2(v[4][e], v[5][e]); o.w = pk2(v[6][e], v[7][e]);
            *(GAS v4u*)(dp + (size_t)e * rp + 8 * t8) = o; }
    }
}

struct Args { const float* in[23]; float* out; unsigned char* ws; int ph_lo, ph_hi, pad0, pad1; };
constexpr int NPH_PER = 13, NPHASE = 1 + NCHUNK * NLAYER * NPH_PER;
typedef const __attribute__((address_space(4))) Args* KArgs;
__device__ __forceinline__ KArgs kargs() { unsigned long long p = (unsigned long long)__builtin_amdgcn_kernarg_segment_ptr(); asm volatile("" : "+s"(p)); return (KArgs)p; }

__device__ __forceinline__ void convert_flat(KArgs ap, unsigned char* ws, int g, int lane) {
    const int l = g / 12800; int r = g - l * 12800;
    unsigned char* wl = ws + WS_W + (size_t)l * LAYER_W_BYTES;
    const float* g1 = ap->in[2] + l * DM; const float* gm = ap->in[6] + l * DM; const float* g2 = ap->in[19] + l * DM;
    if (r < 1408) { convert_item(ap->in[3] + (size_t)l * DM * DFF, DM, DFF, (bf16*)(wl + LW_W13_1), DM, 1, g1, r, lane); return; } r -= 1408;
    if (r < 1408) { convert_item(ap->in[4] + (size_t)l * DM * DFF, DM, DFF, (bf16*)(wl + LW_W13_1) + (size_t)128 * DM, DM, 1, g1, r, lane); return; } r -= 1408;
    if (r < 1408) { convert_item(ap->in[5] + (size_t)l * DFF * DM, DFF, DM, (bf16*)(wl + LW_WD_1), DFF, 2, nullptr, r, lane); return; } r -= 1408;
    if (r < 1536) { convert_item(ap->in[7] + (size_t)l * DM * DIN, DM, DIN, (bf16*)(wl + LW_WIN), DM, 0, gm, r, lane); return; } r -= 1536;
    if (r < 1536) { const int i = r / 512; convert_item(ap->in[8] + (size_t)(l * 3 + i) * DM * DM, DM, DM, (bf16*)(wl + LW_WGATE) + (size_t)i * DM * DM, DM, 0, gm, r - 512 * i, lane); return; } r -= 1536;
    if (r < 768) { const int i = r / 256; convert_item(ap->in[17] + (size_t)(l * 3 + i) * 1024 * DM, 1024, DM, (bf16*)(wl + LW_WBR) + (size_t)i * DM * 1024, 1024, 0, nullptr, r - 256 * i, lane); return; } r -= 768;
    if (r < 512) { convert_item(ap->in[18] + (size_t)l * DM * DM, DM, DM, (bf16*)(wl + LW_WOUT3), DM, 0, nullptr, r, lane); return; } r -= 512;
    if (r < 1408) { convert_item(ap->in[20] + (size_t)l * DM * DFF, DM, DFF, (bf16*)(wl + LW_W13_2), DM, 1, g2, r, lane); return; } r -= 1408;
    if (r < 1408) { convert_item(ap->in[21] + (size_t)l * DM * DFF, DM, DFF, (bf16*)(wl + LW_W13_2) + (size_t)128 * DM, DM, 1, g2, r, lane); return; } r -= 1408;
    convert_item(ap->in[22] + (size_t)l * DFF * DM, DFF, DM, (bf16*)(wl + LW_WD_2), DFF, 2, nullptr, r, lane);
}
#define PH_PRE \
    const int wave = launder_s(wave_s); const int lane = lane_id_local(); const int tid = wave * 64 + lane; (void)lane; (void)wave; \
    const KArgs ap = kargs(); const int bx = launder_s((int)blockIdx.x), G = launder_s((int)gridDim.x); \
    const int vcu = (G % 8 == 0) ? (bx % 8) * (G / 8) + bx / 8 : bx; const int gw = vcu * NWAVES + wave, NGW = G * NWAVES; (void)gw; (void)NGW; \
    unsigned char* const ws = ap->ws; (void)ws;
#define PH_PRE_CL \
    PH_PRE \
    const int c2 = launder_s(cl); const int chunk = c2 >> 1, layer = c2 & 1; (void)chunk; (void)layer; \
    const int S = chunk < 1 ? 8192 : 4096; (void)S; \
    float* const xo = ap->out + (size_t)chunk * MC * DM; (void)xo; \
    unsigned char* const wl = ws + WS_W + (size_t)layer * LAYER_W_BYTES; (void)wl; \
    float* const SSQ = (float*)(ws + WS_SSQ); (void)SSQ; bf16* const Hb = (bf16*)(ws + WS_H); bf16* const QKV = (bf16*)(ws + WS_QKV); bf16* const BB = (bf16*)(ws + WS_BB); bf16* const Ob = (bf16*)(ws + WS_O); (void)Hb; (void)QKV; (void)BB; (void)Ob;
#define XIN_PTR (chunk < 1 ? ap->in[0] : ap->in[1])

__global__ void __launch_bounds__(NWAVES * 64, 2) mk_fwd(Args args) {
    extern __shared__ __attribute__((aligned(16))) unsigned char lds[];
    LAS unsigned char* const ldsL = (LAS unsigned char*)lds;
    volatile LAS unsigned* const MISC = (volatile LAS unsigned*)(ldsL + MISC_OFF);
    const int wave_s = __builtin_amdgcn_readfirstlane((int)threadIdx.x >> 6);
    for (int u = threadIdx.x; u < (LDS_BYTES - LDSCTL_OFF) / 4; u += NWAVES * 64) ((LAS unsigned*)(ldsL + LDSCTL_OFF))[u] = 0u;
    __syncthreads();
    XcdBarrier bar = xcd_barrier_post((unsigned*)((gu32*)(args.ws + WS_CTL) + CW_BAR), MISC + 8);
    const int lo = args.ph_lo, hi = args.ph_hi;
#define IN(k) (lo <= (k) && (k) < hi)
#define SEAM(k) do { if (IN(k) && IN((k) + 1)) xcd_barrier(bar, wave_s); } while (0)

    if (IN(0)) {
        PH_PRE
        for (int g = gw; g < NLAYER * 12800; g += NGW) convert_flat(ap, ws, g, lane);
        { float* rope = (float*)(ws + WS_ROPE); const int gt = bx * (NWAVES * 64) + tid;
          if (gt < 128 * 32) { const int pos = gt >> 5, j = gt & 31;
              double f = 1.0; for (int q = 0; q < j; ++q) f *= 0.74989420933245582730;
              const double x2 = f * f; double c = 1.0, s = f, tc = 1.0, ts = f;
              for (int n = 1; n <= 12; ++n) { tc *= -x2 / (double)((2 * n - 1) * (2 * n)); c += tc; ts *= -x2 / (double)((2 * n) * (2 * n + 1)); s += ts; }
              double cr = 1.0, si = 0.0; for (int q = 0; q < pos; ++q) { const double t = cr * c - si * s; si = cr * s + si * c; cr = t; }
              rope[2 * gt] = (float)cr; rope[2 * gt + 1] = (float)si; } }
    }
    SEAM(0);

    for (int cl = 0; cl < NCHUNK * NLAYER; ++cl) {
        const int pb = 1 + cl * NPH_PER;
        if (hi <= pb || lo >= pb + NPH_PER) continue;

        if (IN(pb + 0) && (cl & 1) == 0) { PH_PRE_CL const float* x0 = XIN_PTR;
            for (int m = gw; m < MC; m += NGW) row_to_xb(x0 + (size_t)m * DM, Hb + (size_t)m * DM, SSQ + (size_t)m * pg8::NSSQ, lane); }
        if ((cl & 1) == 0) SEAM(pb + 0);
        if (IN(pb + 1)) { PH_PRE_CL pg8::Gemm g{Hb, (const bf16*)(wl + LW_W13_1), MC, 2 * DFF, DM, DM, DM, 0, 0, 0, 0}; pg8::RsOrder So; So.init(MC, 2 * DFF, G, bx); So.ssq = SSQ; So.tab = (LAS float*)(ldsL + RTAB_OFF); So.inv_ncol = 1.0f / DM; So.eps = EPS; So.tid = tid;
            pg8::EpiSwiglu E{QKV, DFF, (const LAS float*)(ldsL + RTAB_OFF)}; pg8::gemm_phase<pg8::EpiSwiglu, pg8::RsOrder, true, true>(ldsL + RING_OFF, g, So, E, tid); }
        SEAM(pb + 1);
        if (IN(pb + 2)) { PH_PRE_CL
            pg8::Gemm g{QKV, (const bf16*)(wl + LW_WD_1), MC, DM, DFF, DFF, DFF, 0, 0, 1, 1}; pg8::StaticOrder So; So.init(MC, DM, G, bx);
            pg8::EpiResidX E{Hb, nullptr, SSQ, DM, 0.5f}; pg8::gemm_phase<pg8::EpiResidX, pg8::StaticOrder, true, true>(ldsL + RING_OFF, g, So, E, tid); }
        SEAM(pb + 2);
        if (IN(pb + 4)) { PH_PRE_CL pg8::Gemm g{Hb, (const bf16*)(wl + LW_WIN), MC, DIN, DM, DM, DM, 0, 0, 0, 0}; pg8::RsOrder So; So.init(MC, DIN, G, bx); So.ssq = SSQ; So.tab = (LAS float*)(ldsL + RTAB_OFF); So.inv_ncol = 1.0f / DM; So.eps = EPS; So.tid = tid;
            pg8::EpiBf16 E{QKV, DIN, (const LAS float*)(ldsL + RTAB_OFF)}; pg8::gemm_phase<pg8::EpiBf16, pg8::RsOrder, true, true>(ldsL + RING_OFF, g, So, E, tid); }
        SEAM(pb + 4);
        if (IN(pb + 5)) { PH_PRE_CL
            const float* rope = (const float*)(ws + WS_ROPE);
            const int sub = lane >> 4, t16 = lane & 15;
            for (int task = gw; task < MC * 3; task += NGW) {
                const int m = task / 3, hidx = (task % 3) * 4 + sub;
                int cb; const float* gp; bool rp = false;
                if (hidx < 2) { cb = 32 + hidx; gp = ap->in[13]; rp = true; } else if (hidx < 10) { cb = 8 + (hidx - 2); gp = ap->in[10]; } else { cb = 44 + (hidx - 10); gp = ap->in[15]; }
                const bool task_rope = (task % 3) == 0;
                gp += layer * HD + 8 * t16;
                GAS v4u* p = (GAS v4u*)(QKV + (size_t)m * DIN + cb * 128 + 8 * t16);
                const v4u raw = *p;
                float x[8] = {pg8::bf_lo(raw.x), pg8::bf_hi(raw.x), pg8::bf_lo(raw.y), pg8::bf_hi(raw.y), pg8::bf_lo(raw.z), pg8::bf_hi(raw.z), pg8::bf_lo(raw.w), pg8::bf_hi(raw.w)};
                float ss = 0.f;
#pragma unroll
                for (int i = 0; i < 8; ++i) ss += x[i] * x[i];
                ss += shx(ss, 1, lane); ss += shx(ss, 2, lane); ss += shx(ss, 4, lane); ss += shx(ss, 8, lane);
                const float rstd = __builtin_amdgcn_rsqf(ss * (1.f / HD) + EPS);
                const f32x4 g0 = *(const GAS f32x4*)gp, g1 = *(const GAS f32x4*)(gp + 4);
                x[0] *= rstd * g0.x; x[1] *= rstd * g0.y; x[2] *= rstd * g0.z; x[3] *= rstd * g0.w; x[4] *= rstd * g1.x; x[5] *= rstd * g1.y; x[6] *= rstd * g1.z; x[7] *= rstd * g1.w;
                float y[8];
#pragma unroll
                for (int i = 0; i < 8; ++i) y[i] = x[i];
                if (task_rope) {
                    const int tpos = m % S, pos = (t16 & 8) ? (tpos & 63) : (tpos >> 6);
                    const bool first = (t16 & 4) == 0; const int j0 = 8 * (t16 & 3);
                    const GAS f32x4* rt = (const GAS f32x4*)(rope + ((size_t)pos * 32 + j0) * 2);
                    const f32x4 cs0 = rt[0], cs1 = rt[1], cs2 = rt[2], cs3 = rt[3];
                    const float cc[8] = {cs0.x, cs0.z, cs1.x, cs1.z, cs2.x, cs2.z, cs3.x, cs3.z}, sn[8] = {cs0.y, cs0.w, cs1.y, cs1.w, cs2.y, cs2.w, cs3.y, cs3.w};
#pragma unroll
                    for (int i = 0; i < 8; ++i) { const float other = shx(x[i], 4, lane); if (rp) y[i] = x[i] * cc[i] + (first ? -other : other) * sn[i]; }
                }
                v4u w; w.x = pk2(y[0], y[1]); w.y = pk2(y[2], y[3]); w.z = pk2(y[4], y[5]); w.w = pk2(y[6], y[7]);
                *p = w;
            }
        }
        SEAM(pb + 5);
        if (IN(pb + 6)) {
          { PH_PRE_CL
            const int nqb = S / 256, nunit = MC / 256 * 8;
            for (int u = vcu; u < nunit; u += G) {
                const int qb = u % nqb, h = (u / nqb) % 8, sq = u / (nqb * 8); const int kvh = h >> 2;
                const size_t row0 = (size_t)sq * S;
                att::Par P{0, 0, 0, 0, 0, 0.f, 0.f, ap->in[12] + layer * HD, (const float*)(ws + WS_ROPE), qb * 256};
                att::attn_body<0>(QKV + (row0 + (size_t)qb * 256) * DIN + C_QB + h * 128, QKV + row0 * DIN + C_KB + kvh * 128, QKV + row0 * DIN + C_VB + kvh * 128,
                                  Ob + (row0 + (size_t)qb * 256) * 3072 + 1024 + h * 128, S / 64, (char*)lds + RING_OFF, P, launder_s(wave_s) * 64 + lane_id_local());
            } }
          { PH_PRE_CL
            const int rows = S / 64, nqb = S / 256, nunit = MC / 256 * 8;
            for (int u = vcu; u < nunit; u += G) {
                const int qb = u % nqb, h = (u / nqb) % 8, sq = u / (nqb * 8);
                const size_t row0 = (size_t)sq * S;
                int kr0 = qb * 4 - 4; kr0 = kr0 < 0 ? 0 : kr0; kr0 = kr0 > rows - 12 ? rows - 12 : kr0;
                { const float* rb = ap->in[11] + (size_t)(layer * 8 + h) * 465; float* tb = (float*)((char*)lds + RING_OFF + att::TBL_OFF);
                  if (tid < 480) { const int rr = tid >> 5, cc = tid & 31; tb[tid] = (cc < 31) ? rb[rr * 31 + cc] * (1.0f / att::SCALE) : att::NEG; } }
                att::Par P{0, 0, qb * 4, rows, kr0, 0.f, 0.f, ap->in[9] + layer * HD, nullptr, qb * 256};
                att::attn_body_simple<2>(QKV + (row0 + (size_t)qb * 256) * DIN + C_QA + h * 128, QKV + (row0 + (size_t)kr0 * 64) * DIN + C_KA + h * 128, QKV + (row0 + (size_t)kr0 * 64) * DIN + C_VA + h * 128,
                                  Ob + (row0 + (size_t)qb * 256) * 3072 + h * 128, 12, (char*)lds + RING_OFF, P, tid);
            } }
          { PH_PRE_CL
            const int nqb = S / 256, nunit = MC / 256 * 8;
            for (int u = vcu; u < nunit; u += G) {
                const int qb = u % nqb, h = (u / nqb) % 8, sq = u / (nqb * 8); const int kvh = h >> 2;
                const size_t row0 = (size_t)sq * S;
                int ks = qb * 256 - 128; ks = ks < 0 ? 0 : ks; ks = ks > S - 512 ? S - 512 : ks;
                const float slope = exp2f(-(float)(h + 1)), sink = ap->in[16][layer * 8 + h];
                att::Par P{qb * 256, ks, 0, 0, 0, slope * (1.0f / att::SCALE), sink * (1.0f / att::SCALE), ap->in[14] + layer * HD, nullptr, qb * 256};
                att::attn_body_simple<1>(QKV + (row0 + (size_t)qb * 256) * DIN + C_QC + h * 128, QKV + (row0 + (size_t)ks) * DIN + C_KC + kvh * 128, QKV + (row0 + (size_t)ks) * DIN + C_VC + kvh * 128,
                                  Ob + (row0 + (size_t)qb * 256) * 3072 + 2048 + h * 128, 8, (char*)lds + RING_OFF, P, tid);
            } }
        }
        SEAM(pb + 6);
        if (IN(pb + 7)) { PH_PRE_CL pg8::Gemm g{Ob, (const bf16*)(wl + LW_WBR), MC, DIN, 1024, 3072, 1024, 8, 1024, 0, 0}; pg8::StaticOrder So; So.init(MC, DIN, G, bx);
            pg8::EpiTileImg E{BB, DIN / 256, tid}; pg8::gemm_phase<pg8::EpiTileImg, pg8::StaticOrder, true, true>(ldsL + RING_OFF, g, So, E, tid); }
        SEAM(pb + 7);
        if (IN(pb + 8)) { PH_PRE_CL pg8::Gemm g{Hb, (const bf16*)(wl + LW_WGATE), MC, DIN, DM, DM, DM, 0, 0, 0, 0}; pg8::TriOrder So; So.init3(MC, DM, G, bx); So.ssq = SSQ; So.tab = (LAS float*)(ldsL + RTAB_OFF); So.inv_ncol = 1.0f / DM; So.eps = EPS; So.tid = tid;
            pg8::EpiGateAcc E{BB, DIN / 256, (float*)(ws + WS_SCR) + (size_t)bx * 65536, (bf16*)(ws + WS_MRG), DM, (const LAS float*)(ldsL + RTAB_OFF), tid, DM / 256};
            pg8::gemm_phase<pg8::EpiGateAcc, pg8::TriOrder, true, true>(ldsL + RING_OFF, g, So, E, tid); }
        SEAM(pb + 8);
        if (IN(pb + 9)) { PH_PRE_CL pg8::Gemm g{(const bf16*)(ws + WS_MRG), (const bf16*)(wl + LW_WOUT3), MC, DM, DM, DM, DM, 0, 0, 0, 0}; pg8::StaticOrder So; So.init(MC, DM, G, bx);
            pg8::EpiResidX E{Hb, nullptr, SSQ, DM, 1.0f}; pg8::gemm_phase<pg8::EpiResidX, pg8::StaticOrder, true, true>(ldsL + RING_OFF, g, So, E, tid); }
        SEAM(pb + 9);
        if (IN(pb + 11)) { PH_PRE_CL pg8::Gemm g{Hb, (const bf16*)(wl + LW_W13_2), MC, 2 * DFF, DM, DM, DM, 0, 0, 0, 0}; pg8::RsOrder So; So.init(MC, 2 * DFF, G, bx); So.ssq = SSQ; So.tab = (LAS float*)(ldsL + RTAB_OFF); So.inv_ncol = 1.0f / DM; So.eps = EPS; So.tid = tid;
            pg8::EpiSwiglu E{QKV, DFF, (const LAS float*)(ldsL + RTAB_OFF)}; pg8::gemm_phase<pg8::EpiSwiglu, pg8::RsOrder, true, true>(ldsL + RING_OFF, g, So, E, tid); }
        SEAM(pb + 11);
        if (IN(pb + 12)) { PH_PRE_CL pg8::Gemm g{QKV, (const bf16*)(wl + LW_WD_2), MC, DM, DFF, DFF, DFF, 0, 0, 1, 1}; pg8::StaticOrder So; So.init(MC, DM, G, bx);
            pg8::EpiResidX E{Hb, (layer == NLAYER - 1) ? xo : nullptr, SSQ, DM, 0.5f}; pg8::gemm_phase<pg8::EpiResidX, pg8::StaticOrder, true, true>(ldsL + RING_OFF, g, So, E, tid); }
        SEAM(pb + 12);
    }
#undef IN
#undef SEAM
}

extern "C" void kernel_launch(void* const* d_in, const int* in_sizes, int n_in, void* d_out, int out_size, void* d_ws, size_t ws_size, hipStream_t stream) {
    static int grid = 0;
    if (grid == 0) {
        if (n_in != 23 || out_size != MTOT * DM || ws_size < WS_END) { fprintf(stderr, "kernel_launch: unexpected shapes: n_in %d out %d ws %zu (need %zu)\n", n_in, out_size, ws_size, (size_t)WS_END); grid = -1; return; }
        int dev = 0, cus = 0, per_cu = 0;
        if (hipGetDevice(&dev) != hipSuccess || hipDeviceGetAttribute(&cus, hipDeviceAttributeMultiprocessorCount, dev) != hipSuccess) { grid = -1; return; }
        if (hipFuncSetAttribute((const void*)mk_fwd, hipFuncAttributeMaxDynamicSharedMemorySize, LDS_BYTES) != hipSuccess) { fprintf(stderr, "kernel_launch: hipFuncSetAttribute failed\n"); grid = -1; return; }
        if (hipOccupancyMaxActiveBlocksPerMultiprocessor(&per_cu, (const void*)mk_fwd, NWAVES * 64, LDS_BYTES) != hipSuccess || per_cu < 1)
            fprintf(stderr, "kernel_launch: occupancy query reports %d workgroups per CU\n", per_cu);
        (void)hipGetLastError();
        grid = cus > 304 ? 304 : cus;
    }
    if (grid < 0) return;
    if (hipMemsetAsync((char*)d_ws + WS_CTL, 0, CTL_ZERO_BYTES, stream) != hipSuccess) return;
    Args a{};
    for (int i = 0; i < 23; ++i) a.in[i] = (const float*)d_in[i];
    a.out = (float*)d_out; a.ws = (unsigned char*)d_ws;
#if MK_ONE_LAUNCH
    a.ph_lo = 0; a.ph_hi = NPHASE;
    hipLaunchKernelGGL(mk_fwd, dim3(grid), dim3(NWAVES * 64), LDS_BYTES, stream, a);
#else
    for (int p = 0; p < NPHASE; ++p) { a.ph_lo = p; a.ph_hi = p + 1; hipLaunchKernelGGL(mk_fwd, dim3(grid), dim3(NWAVES * 64), LDS_BYTES, stream, a); }
#endif
    const hipError_t le = hipPeekAtLastError();
    if (le != hipSuccess) fprintf(stderr, "kernel_launch: launch failed: %s\n", hipGetErrorName(le));
}
```

```cpp
#include <hip/hip_runtime.h>
#include <cstdio>
#include <cstdint>

#ifndef MK_ONE_LAUNCH
#define MK_ONE_LAUNCH 1
#endif

namespace pg8 {
#define PG8_LAS __attribute__((address_space(3)))
typedef unsigned short bf16_t;
typedef short bf16x8 __attribute__((ext_vector_type(8)));
typedef float f32x4 __attribute__((ext_vector_type(4)));
typedef unsigned u32x4 __attribute__((ext_vector_type(4)));
constexpr int BM = 256, BK = 64, HALF = 128, HTB = HALF * BK * 2  , STAGE_BYTES = 8 * HTB, NXCD = 8, WGM = 4;

__host__ __device__ __forceinline__ int lds_byte(int r, int c) { const int st = (r >> 4) * 2 + (c >> 5), rr = r & 15, cc = c & 31, ob = rr * 64 + cc * 2; return st * 1024 + (ob ^ (((ob >> 9) & 1) << 5)); }
__host__ __device__ __forceinline__ void stage_rc(int b, int& R, int& C) { const int st = b / 1024, sb = b % 1024, swz = sb ^ (((sb >> 9) & 1) << 5); R = (st >> 1) * 16 + swz / 64; C = (st & 1) * 32 + (swz % 64) / 2; }
__host__ __device__ __forceinline__ int perm32(int rho) { const int n = rho >> 4, i = rho & 15; return 8 * (i >> 2) + 4 * n + (i & 3); }

struct Unit { int pm, pn, slot, fill; };
struct Gemm { const bf16_t* A; const bf16_t* Bt; int M, N, K, lda, ldb, grp, grp_a, ablk, bblk; };

struct StaticOrder {
    int nM, nN, nwg, G, c;
    __host__ __device__ void init(int M, int N, int G_, int c_) { nM = M / BM; nN = N / BM; nwg = nM * nN; G = G_; c = c_; }
    __host__ __device__ bool next(int i, Unit& u) const {
        const long L = (long)i * G + c; if (L >= nwg) return false;
        int wgid = (int)L; { const int q = nwg / NXCD, r = nwg % NXCD, xcd = wgid % NXCD, off = wgid / NXCD; wgid = (xcd < r ? xcd * (q + 1) : r * (q + 1) + (xcd - r) * q) + off; }
        const int nig = WGM * nN, gid = wgid / nig, fm = gid * WGM, gsz = (nM - fm) < WGM ? (nM - fm) : WGM;
        u.pm = fm + ((wgid % nig) % gsz); u.pn = (wgid % nig) / gsz;
        int pg = -1; if (i > 0) { int w2 = (int)(L - G); { const int q = nwg / NXCD, r = nwg % NXCD, xcd = w2 % NXCD, off = w2 / NXCD; w2 = (xcd < r ? xcd * (q + 1) : r * (q + 1) + (xcd - r) * q) + off; } pg = w2 / nig; }
        u.slot = gid & 1; u.fill = (pg != gid) ? 1 : 0; return true;
    }
    __device__ __forceinline__ void a_ready(const Unit&) const {}
    __device__ __forceinline__ void done(const Unit&) const {}
};

struct RsOrder : StaticOrder {
    const float* ssq; PG8_LAS float* tab; float inv_ncol, eps; int tid;
    __device__ __forceinline__ void a_ready(const Unit& u) const {
        if (u.fill && tid < 256) {
            const f32x4* p = (const f32x4*)(ssq + (size_t)(u.pm * BM + tid) * 32); float s = 0.f;
#pragma unroll
            for (int j = 0; j < 8; ++j) { const f32x4 a = p[j]; s += (a[0] + a[1]) + (a[2] + a[3]); }
            tab[u.slot * 256 + tid] = __builtin_amdgcn_rsqf(s * inv_ncol + eps);
        }
    }
};
struct TriOrder : RsOrder {
    int nN3;
    __host__ __device__ void init3(int M, int N3, int G_, int c_) { init(M, N3, G_, c_); nN3 = N3 / BM; }
    __host__ __device__ bool next(int i, Unit& u) const {
        const int t = i / 3, sub = i - 3 * t;
        if (!StaticOrder::next(t, u)) return false;
        u.pn += nN3 * sub; if (sub) u.fill = 0; return true;
    }
};
typedef float f32x2_t __attribute__((ext_vector_type(2))); typedef __bf16 bf16x2_t __attribute__((ext_vector_type(2)));
__device__ __forceinline__ unsigned cvt_pk_bf16(float lo, float hi) { const f32x2_t v = {lo, hi}; return __builtin_bit_cast(unsigned, __builtin_convertvector(v, bf16x2_t)); }
__device__ __forceinline__ float bf_lo(unsigned w) { return __uint_as_float(w << 16); }
__device__ __forceinline__ float bf_hi(unsigned w) { return __uint_as_float(w & 0xffff0000u); }
__device__ __forceinline__ float sigmoid_f(float x) { return __builtin_amdgcn_rcpf(1.0f + __builtin_amdgcn_exp2f(-1.4426950408889634f * x)); }

__device__ __forceinline__ float shx(float v, int mask, int lane) { return __builtin_bit_cast(float, __builtin_amdgcn_ds_bpermute((lane ^ mask) << 2, __builtin_bit_cast(int, v))); }
__device__ __forceinline__ float sum_x16(float v) { const auto r = __builtin_amdgcn_permlane16_swap(__float_as_uint(v), __float_as_uint(v), false, false); return __uint_as_float(r[0]) + __uint_as_float(r[1]); }
__device__ __forceinline__ float sum_x32(float v) { const auto r = __builtin_amdgcn_permlane32_swap(__float_as_uint(v), __float_as_uint(v), false, false); return __uint_as_float(r[0]) + __uint_as_float(r[1]); }
constexpr int NSSQ = 32;
__device__ __forceinline__ void load_rstd(const PG8_LAS float* rtab, int slot, int lrow0, float (&rs)[2][4]) {
#pragma unroll
    for (int ai = 0; ai < 2; ++ai)
#pragma unroll
        for (int m = 0; m < 4; ++m) rs[ai][m] = rtab ? rtab[slot * 256 + lrow0 + ai * HALF + m * 16] : 1.0f;
}
struct EpiBf16 {
    static constexpr bool PERM = true, AFTER_DRAIN = false;
    bf16_t* O; int ldc; const PG8_LAS float* rtab;
    __device__ __forceinline__ void operator()(const f32x4 (&acc)[2][2][4][2], const Unit& u, int wr, int wc, int fr, int fq) const {
        const int row0 = u.pm * BM + wr * 64 + fr, col0 = u.pn * BM + wc * 32 + 8 * fq;
        float rs[2][4]; load_rstd(rtab, u.slot, wr * 64 + fr, rs);
#pragma unroll
        for (int ai = 0; ai < 2; ++ai)
#pragma unroll
            for (int m = 0; m < 4; ++m) { bf16_t* rowp = O + (size_t)(row0 + ai * HALF + m * 16) * ldc + col0; const float r = rs[ai][m];
#pragma unroll
                for (int bj = 0; bj < 2; ++bj) { const f32x4 v0 = acc[ai][bj][m][0] * r, v1 = acc[ai][bj][m][1] * r;
                    u32x4 w; w.x = cvt_pk_bf16(v0[0], v0[1]); w.y = cvt_pk_bf16(v0[2], v0[3]); w.z = cvt_pk_bf16(v1[0], v1[1]); w.w = cvt_pk_bf16(v1[2], v1[3]);
                    *(u32x4*)(rowp + bj * HALF) = w; } }
    }
};
struct EpiTileImg {
    static constexpr bool PERM = true, AFTER_DRAIN = false;
    bf16_t* T; int ntn, tid;
    __device__ __forceinline__ void operator()(const f32x4 (&acc)[2][2][4][2], const Unit& u, int wr, int wc, int fr, int fq) const {
        char* const tb = (char*)T + (size_t)(u.pm * ntn + u.pn) * 131072; unsigned voff = (unsigned)tid * 16u; asm volatile("" : "+v"(voff));
#pragma unroll
        for (int ai = 0; ai < 2; ++ai)
#pragma unroll
            for (int m = 0; m < 4; ++m)
#pragma unroll
                for (int bj = 0; bj < 2; ++bj) { const f32x4 v0 = acc[ai][bj][m][0], v1 = acc[ai][bj][m][1];
                    u32x4 w; w.x = cvt_pk_bf16(v0[0], v0[1]); w.y = cvt_pk_bf16(v0[2], v0[3]); w.z = cvt_pk_bf16(v1[0], v1[1]); w.w = cvt_pk_bf16(v1[2], v1[3]);
                    *(u32x4*)(tb + (size_t)(((ai * 4 + m) * 2 + bj) * 8192) + voff) = w; }
    }
};
struct EpiSwiglu {
    static constexpr bool PERM = true, AFTER_DRAIN = false;
    bf16_t* O; int ldc; const PG8_LAS float* rtab;
    __device__ __forceinline__ void operator()(const f32x4 (&acc)[2][2][4][2], const Unit& u, int wr, int wc, int fr, int fq) const {
        const int lrow0 = wr * 64 + fr, kt = 2 * u.pn + (wc >> 1), cc = (wc & 1) * 32 + 8 * fq;
        bf16_t* const blk = O + ((size_t)u.pm * (ldc / BK) + kt) * (BM * BK) + cc;
        float rs[2][4]; load_rstd(rtab, u.slot, lrow0, rs);
#pragma unroll
        for (int ai = 0; ai < 2; ++ai)
#pragma unroll
            for (int m = 0; m < 4; ++m) { bf16_t* rowp = blk + (lrow0 + ai * HALF + m * 16) * BK; const float r = rs[ai][m], rn = -1.4426950408889634f * r, r2 = r * r;
                float h[8], ee[8];
#pragma unroll
                for (int n = 0; n < 2; ++n)
#pragma unroll
                    for (int j = 0; j < 4; ++j) { ee[n * 4 + j] = __builtin_amdgcn_exp2f(acc[ai][0][m][n][j] * rn); h[n * 4 + j] = acc[ai][0][m][n][j] * acc[ai][1][m][n][j]; }
#pragma unroll
                for (int j = 0; j < 8; ++j) ee[j] = __builtin_amdgcn_rcpf(1.0f + ee[j]) * r2;
#pragma unroll
                for (int j = 0; j < 8; ++j) h[j] = h[j] * ee[j];
                u32x4 w; w.x = cvt_pk_bf16(h[0], h[1]); w.y = cvt_pk_bf16(h[2], h[3]); w.z = cvt_pk_bf16(h[4], h[5]); w.w = cvt_pk_bf16(h[6], h[7]);
                *(u32x4*)rowp = w; }
    }
};
struct EpiResidX {
    static constexpr bool PERM = true, AFTER_DRAIN = false;
    bf16_t* xb; float* out32; float* ssq; int ldc; float alpha;
    struct Bt { u32x4 v[2][2]; };
    __device__ __forceinline__ void ld(Bt& b, int row0, int col0, int k) const {
#pragma unroll
        for (int mm = 0; mm < 2; ++mm)
#pragma unroll
            for (int bj = 0; bj < 2; ++bj) b.v[mm][bj] = *(const u32x4*)(xb + (size_t)(row0 + (k >> 1) * HALF + (2 * (k & 1) + mm) * 16) * ldc + col0 + bj * HALF);
    }
    __device__ __forceinline__ void st(const Bt& b, const f32x4 (&acc)[2][2][4][2], const Unit& u, int row0, int col0, int wc, int fq, int k) const {
        const int ai = k >> 1, mp = k & 1;
#pragma unroll
        for (int mm = 0; mm < 2; ++mm) { const int m = 2 * mp + mm, row = row0 + ai * HALF + m * 16; const size_t off = (size_t)row * ldc + col0; float ss = 0.f;
#pragma unroll
            for (int bj = 0; bj < 2; ++bj) { const u32x4 r = b.v[mm][bj];
                const f32x4 o0 = (f32x4){bf_lo(r.x), bf_hi(r.x), bf_lo(r.y), bf_hi(r.y)} + acc[ai][bj][m][0] * alpha, o1 = (f32x4){bf_lo(r.z), bf_hi(r.z), bf_lo(r.w), bf_hi(r.w)} + acc[ai][bj][m][1] * alpha;
                if (out32) { *(f32x4*)(out32 + off + bj * HALF) = o0; *(f32x4*)(out32 + off + bj * HALF + 4) = o1; }
                else { u32x4 w; w.x = cvt_pk_bf16(o0[0], o0[1]); w.y = cvt_pk_bf16(o0[2], o0[3]); w.z = cvt_pk_bf16(o1[0], o1[1]); w.w = cvt_pk_bf16(o1[2], o1[3]);
                    *(u32x4*)(xb + off + bj * HALF) = w;
                    ss += ((o0[0] * o0[0] + o0[1] * o0[1]) + (o0[2] * o0[2] + o0[3] * o0[3])) + ((o1[0] * o1[0] + o1[1] * o1[1]) + (o1[2] * o1[2] + o1[3] * o1[3])); } }
            if (!out32) { ss = sum_x32(sum_x16(ss)); if (fq == 0) ssq[(size_t)row * NSSQ + u.pn * 4 + wc] = ss; } }
    }
    __device__ __forceinline__ void operator()(const f32x4 (&acc)[2][2][4][2], const Unit& u, int wr, int wc, int fr, int fq) const {
        const int row0 = u.pm * BM + wr * 64 + fr, col0 = u.pn * BM + wc * 32 + 8 * fq;
        Bt bA, bB;
        ld(bA, row0, col0, 0);
        ld(bB, row0, col0, 1); st(bA, acc, u, row0, col0, wc, fq, 0);
        ld(bA, row0, col0, 2); st(bB, acc, u, row0, col0, wc, fq, 1);
        ld(bB, row0, col0, 3); st(bA, acc, u, row0, col0, wc, fq, 2);
        st(bB, acc, u, row0, col0, wc, fq, 3);
    }
};
struct EpiGateAcc {
    static constexpr bool PERM = true, AFTER_DRAIN = false;
    const bf16_t* B; int ldb; float* scr; bf16_t* Mg; int ldm; const PG8_LAS float* rtab; int tid, nN3;
    struct Bt { u32x4 b[2]; u32x4 mo[2]; };
#define SCRQ(q) (*(u32x4*)(sb + (size_t)(q) * 8192 + voff))
    template <int SUB>
    __device__ __forceinline__ void ld(Bt& t, const char* bimg, char* sb, unsigned voff, int k) const {
#pragma unroll
        for (int bj = 0; bj < 2; ++bj) { t.b[bj] = *(const u32x4*)(bimg + (size_t)((k * 2 + bj) * 8192) + voff);
            const int q = k * 2 + bj;
            if constexpr (SUB != 0) t.mo[bj] = SCRQ(q); else t.mo[bj] = (u32x4){0u, 0u, 0u, 0u}; }
    }
    template <int SUB>
    __device__ __forceinline__ void st(const Bt& t, const f32x4 (&acc)[2][2][4][2], float r, int row0, int colm, char* sb, unsigned voff, int k) const {
        const int ai = k >> 2, m = k & 3;
        const float rn = -1.4426950408889634f * r;
#pragma unroll
        for (int bj = 0; bj < 2; ++bj) { const f32x4 v0 = acc[ai][bj][m][0] * rn, v1 = acc[ai][bj][m][1] * rn; const u32x4 bb = t.b[bj];
            f32x4 t0, t1; float ee[8];
#pragma unroll
            for (int j = 0; j < 4; ++j) { ee[j] = __builtin_amdgcn_exp2f(v0[j]); ee[4 + j] = __builtin_amdgcn_exp2f(v1[j]); }
#pragma unroll
            for (int j = 0; j < 8; ++j) ee[j] = __builtin_amdgcn_rcpf(1.0f + ee[j]);
            t0[0] = ee[0] * bf_lo(bb.x); t0[1] = ee[1] * bf_hi(bb.x); t0[2] = ee[2] * bf_lo(bb.y); t0[3] = ee[3] * bf_hi(bb.y);
            t1[0] = ee[4] * bf_lo(bb.z); t1[1] = ee[5] * bf_hi(bb.z); t1[2] = ee[6] * bf_lo(bb.w); t1[3] = ee[7] * bf_hi(bb.w);
            if constexpr (SUB != 0) { const u32x4 mm = t.mo[bj];
                t0[0] += bf_lo(mm.x); t0[1] += bf_hi(mm.x); t0[2] += bf_lo(mm.y); t0[3] += bf_hi(mm.y); t1[0] += bf_lo(mm.z); t1[1] += bf_hi(mm.z); t1[2] += bf_lo(mm.w); t1[3] += bf_hi(mm.w); }
            u32x4 w; w.x = cvt_pk_bf16(t0[0], t0[1]); w.y = cvt_pk_bf16(t0[2], t0[3]); w.z = cvt_pk_bf16(t1[0], t1[1]); w.w = cvt_pk_bf16(t1[2], t1[3]);
            if constexpr (SUB != 2) SCRQ(k * 2 + bj) = w;
            else *(u32x4*)(Mg + (size_t)(row0 + ai * HALF + m * 16) * ldm + colm + bj * HALF) = w; }
    }
    template <int SUB>
    __device__ __forceinline__ void run(const f32x4 (&acc)[2][2][4][2], const float (&rs)[2][4], const char* bimg, char* sb, unsigned voff, int row0, int colm) const {
        Bt tA, tB;
        ld<SUB>(tA, bimg, sb, voff, 0);
        ld<SUB>(tB, bimg, sb, voff, 1); st<SUB>(tA, acc, rs[0][0], row0, colm, sb, voff, 0);
        ld<SUB>(tA, bimg, sb, voff, 2); st<SUB>(tB, acc, rs[0][1], row0, colm, sb, voff, 1);
        ld<SUB>(tB, bimg, sb, voff, 3); st<SUB>(tA, acc, rs[0][2], row0, colm, sb, voff, 2);
        ld<SUB>(tA, bimg, sb, voff, 4); st<SUB>(tB, acc, rs[0][3], row0, colm, sb, voff, 3);
        ld<SUB>(tB, bimg, sb, voff, 5); st<SUB>(tA, acc, rs[1][0], row0, colm, sb, voff, 4);
        ld<SUB>(tA, bimg, sb, voff, 6); st<SUB>(tB, acc, rs[1][1], row0, colm, sb, voff, 5);
        ld<SUB>(tB, bimg, sb, voff, 7); st<SUB>(tA, acc, rs[1][2], row0, colm, sb, voff, 6);
        st<SUB>(tB, acc, rs[1][3], row0, colm, sb, voff, 7);
    }
    __device__ __forceinline__ void operator()(const f32x4 (&acc)[2][2][4][2], const Unit& u, int wr, int wc, int fr, int fq) const {
        const int sub = u.pn / nN3, pn3 = u.pn - sub * nN3;
        const int row0 = u.pm * BM + wr * 64 + fr, colm = pn3 * BM + wc * 32 + 8 * fq;
        const char* const bimg = (const char*)B + (size_t)(u.pm * ldb + u.pn) * 131072;
        float rs[2][4]; load_rstd(rtab, u.slot, wr * 64 + fr, rs);
        char* const sb = (char*)scr; unsigned voff = (unsigned)tid * 16u; asm volatile("" : "+v"(voff));
        if (sub == 0) run<0>(acc, rs, bimg, sb, voff, row0, colm); else if (sub == 1) run<1>(acc, rs, bimg, sb, voff, row0, colm); else run<2>(acc, rs, bimg, sb, voff, row0, colm);
    }
#undef SCRQ
};

template <class Epi, class Sched, bool ALIGN_EPI = false, bool SP2 = false>
__device__ __forceinline__ void gemm_phase(PG8_LAS unsigned char* lds, const Gemm g, const Sched& S, const Epi& E, const int tid) {
    const int wid = __builtin_amdgcn_readfirstlane(tid >> 6), lane = tid & 63, wr = wid >> 2, wc = wid & 3, fr = lane & 15, fq = lane >> 4;
    const int K = g.K, nt = K / BK;
    unsigned voffA[2], voffB[2];
#pragma unroll
    for (int i = 0; i < 2; ++i) { int R, C; stage_rc(tid * 16 + i * 8192, R, C); const int Rb = Epi::PERM ? ((R & ~31) + perm32(R & 31)) : R;
        voffA[i] = (unsigned)(R * (g.ablk ? BK : g.lda) + C) * 2u; voffB[i] = (unsigned)(Rb * (g.bblk ? BK : g.ldb) + C) * 2u; }
    const size_t kstepA = g.ablk ? (size_t)(BM * BK * 2) : (size_t)(BK * 2), kstepB = g.bblk ? (size_t)(BM * BK * 2) : (size_t)(BK * 2);
    const size_t hstepA = (size_t)HALF * (g.ablk ? BK : g.lda) * 2, hstepB = (size_t)HALF * (g.bblk ? BK : g.ldb) * 2;
    const size_t tstepA = g.ablk ? (size_t)nt * (BM * BK * 2) : 2 * hstepA, tstepB = g.bblk ? (size_t)nt * (BM * BK * 2) : 2 * hstepB;
    const unsigned ldsw = (unsigned)wid * 1024u;
    const unsigned ldsb = (unsigned)__builtin_amdgcn_readfirstlane((int)(unsigned)(unsigned long long)(lds + ldsw));
    const int aoff = lds_byte(wr * 64 + fr, fq * 8), boff = lds_byte(wc * 32 + fr, fq * 8);
#define PG8_ABASE(u) ((const char*)g.A + (size_t)(u).pm * tstepA + (g.grp ? (size_t)(((u).pn / g.grp) * g.grp_a) * 2 : (size_t)0))
#define PG8_BBASE(u) ((const char*)g.Bt + (size_t)(u).pn * tstepB)
#define PG8_SA(b, h) (((b) * 2 + (h)) * HTB)
#define PG8_SB(b, h) ((4 + (b) * 2 + (h)) * HTB)
#define PG8_STAGE(bufoff, gbase, voff) do { const char* _g = (const char*)(gbase); const unsigned _l = ldsb + (unsigned)(bufoff); unsigned _k; _Pragma("unroll") for (int _i = 0; _i < 2; ++_i) \
        asm volatile("s_mov_b32 %0, m0\n\ts_mov_b32 m0, %3\n\ts_nop 3\n\tglobal_load_lds_dwordx4 %1, %2\n\ts_mov_b32 m0, %0" : "=&s"(_k) : "v"((voff)[_i]), "s"(_g), "s"(_l + _i * 8192u) : "memory"); } while (0)
#define PG8_LDA(dst, b, h) do { _Pragma("unroll") for (int m = 0; m < 4; ++m) _Pragma("unroll") for (int k = 0; k < 2; ++k) dst[m][k] = *(const PG8_LAS bf16x8*)(lds + PG8_SA(b, h) + aoff + m * 2048 + k * 1024); } while (0)
#define PG8_LDB(dst, b, h) do { _Pragma("unroll") for (int n = 0; n < 2; ++n) _Pragma("unroll") for (int k = 0; k < 2; ++k) dst[n][k] = *(const PG8_LAS bf16x8*)(lds + PG8_SB(b, h) + boff + n * 2048 + k * 1024); } while (0)
#define PG8_MMA(ai, bj, At, Bt) do { __builtin_amdgcn_s_setprio(1); _Pragma("unroll") for (int m = 0; m < 4; ++m) _Pragma("unroll") for (int n = 0; n < 2; ++n) _Pragma("unroll") for (int k = 0; k < 2; ++k) \
        acc[ai][bj][m][n] = __builtin_amdgcn_mfma_f32_16x16x32_bf16(Bt[n][k], At[m][k], acc[ai][bj][m][n], 0, 0, 0); __builtin_amdgcn_s_setprio(0); } while (0)
#define PG8_WAIT_V(n) asm volatile("s_waitcnt vmcnt(" #n ")" ::: "memory")
#define PG8_WAIT_L(n) asm volatile("s_waitcnt lgkmcnt(" #n ")" ::: "memory")
#define PG8_BAR __builtin_amdgcn_s_barrier()
#define PG8_SCHED __builtin_amdgcn_sched_barrier(0)
    Unit cur, nxt; int ui = 0;
    if (!S.next(0, cur)) return;
    f32x4 acc[2][2][4][2];
#pragma unroll
    for (int a = 0; a < 2; ++a)
#pragma unroll
        for (int b = 0; b < 2; ++b)
#pragma unroll
            for (int m = 0; m < 4; ++m)
#pragma unroll
                for (int n = 0; n < 2; ++n) acc[a][b][m][n] = (f32x4){0.f, 0.f, 0.f, 0.f};
    bf16x8 At[4][2], B0[2][2], B1[2][2];
    const char* cA = PG8_ABASE(cur); const char* cB = PG8_BBASE(cur);
    S.a_ready(cur);
    if constexpr (SP2) {
        PG8_STAGE(PG8_SB(0, 0), cB, voffB); PG8_STAGE(PG8_SB(0, 1), cB + hstepB, voffB); PG8_STAGE(PG8_SA(0, 0), cA, voffA); PG8_STAGE(PG8_SA(0, 1), cA + hstepA, voffA);
        if (wr == 1) PG8_BAR;
        PG8_WAIT_V(2); PG8_BAR;
        PG8_STAGE(PG8_SB(1, 0), cB + kstepB, voffB); PG8_STAGE(PG8_SA(1, 0), cA + kstepA, voffA); PG8_STAGE(PG8_SB(1, 1), cB + hstepB + kstepB, voffB);
        PG8_WAIT_V(6); PG8_BAR;
    } else {
        PG8_STAGE(PG8_SB(0, 0), cB, voffB); PG8_STAGE(PG8_SA(0, 0), cA, voffA); PG8_STAGE(PG8_SB(0, 1), cB + hstepB, voffB); PG8_STAGE(PG8_SA(0, 1), cA + hstepA, voffA);
        if (wr == 1) PG8_BAR;
        PG8_WAIT_V(4); PG8_BAR;
        PG8_STAGE(PG8_SB(1, 0), cB + kstepB, voffB); PG8_STAGE(PG8_SA(1, 0), cA + kstepA, voffA); PG8_STAGE(PG8_SB(1, 1), cB + hstepB + kstepB, voffB);
        PG8_WAIT_V(6); PG8_BAR;
    }
    for (;;) {
        const bool has_next = S.next(ui + 1, nxt);
        const char* nA = has_next ? PG8_ABASE(nxt) : cA; const char* nB = has_next ? PG8_BBASE(nxt) : cB;
        for (int t = 0; t < nt; t += 2) {
            const bool last = (t == nt - 2);
            const char* a1 = cA + (size_t)(t + 1) * kstepA;
            const char* a2 = last ? nA : cA + (size_t)(t + 2) * kstepA; const char* b2 = last ? nB : cB + (size_t)(t + 2) * kstepB;
            const char* a3 = a2 + kstepA; const char* b3 = b2 + kstepB;
            if (last && has_next) S.a_ready(nxt);
            if constexpr (SP2) {
            PG8_LDB(B0, 0, 0); PG8_LDB(B1, 0, 1); PG8_SCHED; PG8_LDA(At, 0, 0); PG8_STAGE(PG8_SA(1, 1), a1 + hstepA, voffA);
            PG8_WAIT_V(8); PG8_WAIT_L(0); PG8_BAR; PG8_MMA(0, 0, At, B0); PG8_MMA(0, 1, At, B1); PG8_BAR; PG8_SCHED;
            PG8_LDA(At, 0, 1); PG8_STAGE(PG8_SB(0, 0), b2, voffB); PG8_STAGE(PG8_SB(0, 1), b2 + hstepB, voffB); PG8_STAGE(PG8_SA(0, 0), a2, voffA);
            PG8_WAIT_V(8); PG8_WAIT_L(0); PG8_BAR; PG8_MMA(1, 0, At, B0); PG8_MMA(1, 1, At, B1); PG8_BAR; PG8_SCHED;
            PG8_LDB(B0, 1, 0); PG8_LDB(B1, 1, 1); PG8_SCHED; PG8_LDA(At, 1, 0); PG8_STAGE(PG8_SA(0, 1), a2 + hstepA, voffA);
            PG8_WAIT_V(8); PG8_WAIT_L(0); PG8_BAR; PG8_MMA(0, 0, At, B0); PG8_MMA(0, 1, At, B1); PG8_BAR; PG8_SCHED;
            PG8_LDA(At, 1, 1); PG8_STAGE(PG8_SB(1, 0), b3, voffB); PG8_STAGE(PG8_SB(1, 1), b3 + hstepB, voffB); PG8_STAGE(PG8_SA(1, 0), a3, voffA);
            PG8_WAIT_V(8); PG8_WAIT_L(0); PG8_BAR; PG8_MMA(1, 0, At, B0); PG8_MMA(1, 1, At, B1); PG8_BAR; PG8_SCHED;
            } else {
            PG8_LDB(B0, 0, 0); PG8_SCHED; PG8_LDA(At, 0, 0); PG8_STAGE(PG8_SA(1, 1), a1 + hstepA, voffA);
            PG8_WAIT_L(8); PG8_BAR; PG8_WAIT_L(0); PG8_MMA(0, 0, At, B0); PG8_BAR; PG8_SCHED;
            PG8_LDB(B1, 0, 1); PG8_STAGE(PG8_SB(0, 0), b2, voffB);
            PG8_BAR; PG8_WAIT_L(0); PG8_MMA(0, 1, At, B1); PG8_BAR;
            PG8_LDA(At, 0, 1); PG8_STAGE(PG8_SA(0, 0), a2, voffA);
            PG8_BAR; PG8_WAIT_L(0); PG8_MMA(1, 0, At, B0); PG8_BAR; PG8_SCHED;
            PG8_STAGE(PG8_SB(0, 1), b2 + hstepB, voffB);
            PG8_WAIT_V(6); PG8_BAR; PG8_MMA(1, 1, At, B1); PG8_BAR;
            PG8_LDB(B0, 1, 0); PG8_SCHED; PG8_LDA(At, 1, 0); PG8_STAGE(PG8_SA(0, 1), a2 + hstepA, voffA);
            PG8_WAIT_L(8); PG8_BAR; PG8_WAIT_L(0); PG8_MMA(0, 0, At, B0); PG8_BAR; PG8_SCHED;
            PG8_LDB(B1, 1, 1); PG8_STAGE(PG8_SB(1, 0), b3, voffB);
            PG8_BAR; PG8_WAIT_L(0); PG8_MMA(0, 1, At, B1); PG8_BAR;
            PG8_LDA(At, 1, 1); PG8_STAGE(PG8_SA(1, 0), a3, voffA);
            PG8_BAR; PG8_WAIT_L(0); PG8_MMA(1, 0, At, B0); PG8_BAR; PG8_SCHED;
            PG8_STAGE(PG8_SB(1, 1), b3 + hstepB, voffB);
            PG8_WAIT_V(6); PG8_BAR; PG8_MMA(1, 1, At, B1); PG8_BAR;
            }
        }
        if constexpr (ALIGN_EPI) { if (wr == 0) PG8_BAR; }
        if constexpr (!Epi::AFTER_DRAIN) { E(acc, cur, wr, wc, fr, fq); S.done(cur); }
        if (!has_next) break;
#pragma unroll
        for (int a = 0; a < 2; ++a)
#pragma unroll
            for (int b = 0; b < 2; ++b)
#pragma unroll
                for (int m = 0; m < 4; ++m)
#pragma unroll
                    for (int n = 0; n < 2; ++n) acc[a][b][m][n] = (f32x4){0.f, 0.f, 0.f, 0.f};
        cur = nxt; cA = nA; cB = nB; ++ui;
        if constexpr (ALIGN_EPI) { if (wr == 1) PG8_BAR; }
    }
    PG8_WAIT_V(0);
    if constexpr (!ALIGN_EPI) { if (wr == 0) PG8_BAR; }
    PG8_BAR;
#undef PG8_ABASE
#undef PG8_BBASE
#undef PG8_SA
#undef PG8_SB
#undef PG8_STAGE
#undef PG8_LDA
#undef PG8_LDB
#undef PG8_MMA
#undef PG8_WAIT_V
#undef PG8_WAIT_L
#undef PG8_BAR
#undef PG8_SCHED
}
}

namespace att {
using bf16 = unsigned short;
constexpr int D = 128, NW = 8, QBLK = 32, KVBLK = 64;
constexpr float SCALE = 0.088388347648318440f;
constexpr float THR = 8.f;
constexpr float NEG = -1.0e5f;
constexpr int LDQ = 6144, LDK = 6144, LDO = 3072;
constexpr size_t SHM_V = KVBLK * D * 2, SHM_K = KVBLK * D * 2, SHM_ATTN = 2 * SHM_V + 2 * SHM_K + NW * 64 * 4;
constexpr int TBL_OFF = 69632;

using bf16x8 = __attribute__((ext_vector_type(8))) short;
using s16x4  = __attribute__((ext_vector_type(4))) short;
using f32x16 = __attribute__((ext_vector_type(16))) float;
using u32x4  = __attribute__((ext_vector_type(4))) unsigned;
#define KSWZ(row, colB) ((row) * 256 + ((colB) ^ (((row) & 7) << 4)))
#define SBAR() __builtin_amdgcn_sched_barrier(0)
__device__ __forceinline__ int crow(int r, int hi) { return (r & 3) + 8 * (r >> 2) + 4 * hi; }
__device__ __forceinline__ unsigned cvtpk(float lo, float hi) { const pg8::f32x2_t v = {lo, hi}; return __builtin_bit_cast(unsigned, __builtin_convertvector(v, pg8::bf16x2_t)); }

struct Par { int qpos0, kpos0, r0, rows, kr0; float slopeR, sinkR; const float* gq; const float* rope; int qt0; };

__device__ __forceinline__ void partialSM(f32x16& p0, f32x16& p1, float& m_reg, float& mn, float& alpha) {
  constexpr float C = SCALE * 1.4426950408889634f;
  float pmax = p0[0]; for (int r = 1; r < 16; ++r) pmax = fmaxf(pmax, p0[r]); for (int r = 0; r < 16; ++r) pmax = fmaxf(pmax, p1[r]);
  { auto rr = __builtin_amdgcn_permlane32_swap(__float_as_uint(pmax), __float_as_uint(pmax), false, false);
    pmax = fmaxf(__uint_as_float(rr[0]), __uint_as_float(rr[1])); }
  if (__builtin_expect(__all(pmax - m_reg <= THR / SCALE), 1)) { mn = m_reg; alpha = 1.f; }
  else { mn = fmaxf(m_reg, pmax); alpha = __builtin_amdgcn_exp2f((m_reg - mn) * C); m_reg = mn; }
  float mnC = -mn * C;
  for (int r = 0; r < 16; ++r) p0[r] = fmaf(p0[r], C, mnC); for (int r = 0; r < 16; ++r) p1[r] = fmaf(p1[r], C, mnC);
  for (int r = 0; r < 16; ++r) p0[r] = __builtin_amdgcn_exp2f(p0[r]);
}
template <int NEXP = 16>
__device__ __forceinline__ void finishSM(f32x16& p0, f32x16& p1, float alpha, float& l_reg, bf16x8& pa0, bf16x8& pa1, bf16x8& pa2, bf16x8& pa3) {
  for (int r = 16 - NEXP; r < 16; ++r) p1[r] = __builtin_amdgcn_exp2f(p1[r]);
  float ps = 0; for (int r = 0; r < 16; ++r) ps += p0[r]; for (int r = 0; r < 16; ++r) ps += p1[r];
  { auto rr = __builtin_amdgcn_permlane32_swap(__float_as_uint(ps), __float_as_uint(ps), false, false);
    ps = __uint_as_float(rr[0]) + __uint_as_float(rr[1]); }
  l_reg = l_reg * alpha + ps;
#define PK4(P, BASE, OUT) do { unsigned a0 = cvtpk(P[BASE + 0], P[BASE + 1]), a1 = cvtpk(P[BASE + 2], P[BASE + 3]);   \
    unsigned b0 = cvtpk(P[BASE + 4], P[BASE + 5]), b1 = cvtpk(P[BASE + 6], P[BASE + 7]);                              \
    auto r0 = __builtin_amdgcn_permlane32_swap(a0, b0, false, false); auto r1 = __builtin_amdgcn_permlane32_swap(a1, b1, false, false); \
    u32x4 w = {r0[0], r1[0], r0[1], r1[1]}; OUT = *reinterpret_cast<bf16x8*>(&w); } while (0)
  PK4(p0, 0, pa0); PK4(p0, 8, pa1); PK4(p1, 0, pa2); PK4(p1, 8, pa3);
#undef PK4
}
__device__ __forceinline__ void qkt(f32x16& p0, f32x16& p1, const bf16* Ks, const bf16x8* qr, int r32, int hi) {
  p0 = f32x16{}; p1 = f32x16{};
  for (int d0 = 0; d0 < 8; ++d0) { int cb = (d0 * 16 + hi * 8) * 2;
    bf16x8 b0 = *reinterpret_cast<const bf16x8*>((const char*)Ks + KSWZ(r32, cb));
    bf16x8 b1 = *reinterpret_cast<const bf16x8*>((const char*)Ks + KSWZ(32 + r32, cb));
    p0 = __builtin_amdgcn_mfma_f32_32x32x16_bf16(b0, qr[d0], p0, 0, 0, 0);
    p1 = __builtin_amdgcn_mfma_f32_32x32x16_bf16(b1, qr[d0], p1, 0, 0, 0); }
}
__device__ __forceinline__ void qkt_rel(f32x16& p0, f32x16& p1, const bf16* Ks, const bf16x8* qr, int r32, int hi, const f32x16& nm) {
  { bf16x8 b0 = *reinterpret_cast<const bf16x8*>((const char*)Ks + KSWZ(r32, hi * 16)); bf16x8 b1 = *reinterpret_cast<const bf16x8*>((const char*)Ks + KSWZ(32 + r32, hi * 16));
    p0 = __builtin_amdgcn_mfma_f32_32x32x16_bf16(b0, qr[0], nm, 0, 0, 0); p1 = __builtin_amdgcn_mfma_f32_32x32x16_bf16(b1, qr[0], nm, 0, 0, 0); }
  for (int d0 = 1; d0 < 8; ++d0) { int cb = ((d0 & 3) * 16 + hi * 8) * 2;
    bf16x8 b0 = *reinterpret_cast<const bf16x8*>((const char*)Ks + KSWZ(r32, cb) + (d0 >> 2) * 128);
    bf16x8 b1 = *reinterpret_cast<const bf16x8*>((const char*)Ks + KSWZ(32 + r32, cb) + (d0 >> 2) * 128);
    p0 = __builtin_amdgcn_mfma_f32_32x32x16_bf16(b0, qr[d0], p0, 0, 0, 0);
    p1 = __builtin_amdgcn_mfma_f32_32x32x16_bf16(b1, qr[d0], p1, 0, 0, 0); }
}
template <bool FIRST>
__device__ __forceinline__ void partialSM_rel(f32x16& p0, f32x16& p1, float& m_reg, f32x16& nm, float& alpha) {
  float pmax = p0[0]; for (int r = 1; r < 16; ++r) pmax = fmaxf(pmax, p0[r]); for (int r = 0; r < 16; ++r) pmax = fmaxf(pmax, p1[r]);
  { auto rr = __builtin_amdgcn_permlane32_swap(__float_as_uint(pmax), __float_as_uint(pmax), false, false);
    pmax = fmaxf(__uint_as_float(rr[0]), __uint_as_float(rr[1])); }
  if (!FIRST && __builtin_expect(__all(pmax <= THR * 1.4426950408889634f), 1)) { alpha = 1.f; }
  else { const float d = FIRST ? pmax : fmaxf(pmax, 0.f); alpha = FIRST ? 1.f : __builtin_amdgcn_exp2f(-d); m_reg += d;
    for (int r = 0; r < 16; ++r) { p0[r] -= d; p1[r] -= d; }
    for (int r = 0; r < 16; ++r) nm[r] = -m_reg; }
  for (int r = 0; r < 16; ++r) p0[r] = __builtin_amdgcn_exp2f(p0[r]);
  for (int r = 0; r < 8; ++r) p1[r] = __builtin_amdgcn_exp2f(p1[r]);
}
template <int MODE>
__device__ __forceinline__ void modify(f32x16& p0, f32x16& p1, int jt, const Par& P, int wid, int r32, int hi, const float* tbl) {
  if constexpr (MODE == 1) {
    const int qpos = P.qpos0 + wid * 32 + r32, kb = P.kpos0 + 64 * jt;
#pragma unroll
    for (int r = 0; r < 16; ++r) { const int kp = kb + crow(r, hi); int d0 = qpos - kp; d0 = d0 < 0 ? -d0 : d0; int d1 = qpos - (kp + 32); d1 = d1 < 0 ? -d1 : d1;
      p0[r] = (d0 <= 128) ? p0[r] - P.slopeR * (float)d0 : NEG; p1[r] = (d1 <= 128) ? p1[r] - P.slopeR * (float)d1 : NEG; }
  }
  if constexpr (MODE == 2) {
    const int r = P.r0 + (wid >> 1), c = 32 * (wid & 1) + r32;
    int rs = r - 4; rs = rs < 0 ? 0 : rs; rs = rs > P.rows - 8 ? P.rows - 8 : rs;
    int cs = c - 8; cs = cs < 0 ? 0 : cs; cs = cs > 48 ? 48 : cs;
    const int kr = P.kr0 + jt;
    if ((unsigned)(kr - rs) < 8u) {
      const float* tb = tbl + (kr - r + 7) * 32;
      int A = 4 * hi - cs, B = 4 * hi + 15 - c; asm volatile("" : "+v"(A), "+v"(B));
#pragma unroll
      for (int q = 0; q < 16; ++q) { const int kq = (q & 3) + 8 * (q >> 2);
        const int i0 = ((unsigned)(kq + A) < 16u) ? kq + B : 31, i1 = ((unsigned)(kq + 32 + A) < 16u) ? kq + 32 + B : 31;
        p0[q] += tb[i0]; p1[q] += tb[i1];
        if ((q & 3) == 3) asm volatile("" ::: "memory"); }
    } else {
#pragma unroll
      for (int q = 0; q < 16; ++q) { p0[q] = NEG; p1[q] = NEG; }
    }
  }
}
template <bool ROPE>
__device__ __forceinline__ void load_q(bf16x8 (&qr)[8], const char* Qp, const Par& P, int qrow, int hi) {
  float x[8][8]; float ss = 0.f;
#pragma unroll
  for (int d0 = 0; d0 < 8; ++d0) { const bf16x8 raw = *reinterpret_cast<const bf16x8*>(Qp + d0 * 32);
#pragma unroll
    for (int e = 0; e < 8; ++e) { x[d0][e] = __uint_as_float(((unsigned)(unsigned short)raw[e]) << 16); ss += x[d0][e] * x[d0][e]; } }
  { auto rr = __builtin_amdgcn_permlane32_swap(__float_as_uint(ss), __float_as_uint(ss), false, false); ss = __uint_as_float(rr[0]) + __uint_as_float(rr[1]); }
  const float rstd = __builtin_amdgcn_rsqf(ss * (1.0f / 128.0f) + 1e-6f) * (ROPE ? SCALE * 1.4426950408889634f : 1.0f);
#pragma unroll
  for (int d0 = 0; d0 < 8; ++d0) { const float* gp = P.gq + d0 * 16 + hi * 8;
#pragma unroll
    for (int e = 0; e < 8; ++e) x[d0][e] *= rstd * gp[e]; }
  if constexpr (ROPE) {
    const int t = P.qt0 + qrow; int hiR = hi; asm volatile("" : "+v"(hiR));
#pragma unroll
    for (int hb = 0; hb < 2; ++hb) { const int pos = hb ? (t & 63) : (t >> 6);
#pragma unroll
      for (int dd = 0; dd < 2; ++dd) { const float* cs = P.rope + ((size_t)pos * 32 + dd * 16 + hiR * 8) * 2; const int da = 4 * hb + dd, db = da + 2;
#pragma unroll
        for (int e = 0; e < 8; ++e) { const float c = cs[2 * e], s = cs[2 * e + 1], a = x[da][e], b = x[db][e]; x[da][e] = a * c - b * s; x[db][e] = b * c + a * s; } } }
  }
#pragma unroll
  for (int d0 = 0; d0 < 8; ++d0) { u32x4 w = {cvtpk(x[d0][0], x[d0][1]), cvtpk(x[d0][2], x[d0][3]), cvtpk(x[d0][4], x[d0][5]), cvtpk(x[d0][6], x[d0][7])}; qr[d0] = *reinterpret_cast<bf16x8*>(&w); }
}
__device__ __forceinline__ int v_st(int k, int c) { const int kk = (k & ~0xC) | ((k & 4) << 1) | ((k & 8) >> 1); return ((kk >> 3) * 4 + (c >> 5)) * 512 + ((kk & 7) * 32 + (c & 31)) * 2; }
__device__ __forceinline__ int v_rd_base(int lane) { return ((lane & 3) << 3) | (((lane >> 2) & 3) << 6) | (((lane >> 4) & 1) << 5) | (((lane >> 5) & 1) << 8); }
constexpr int v_rd_off(int d0, int ks, int half) { return d0 * 512 + ks * 4096 + half * 2048; }
template <int OFF> __device__ __forceinline__ s16x4 tr_read(int vb) {
  s16x4 r; asm volatile("ds_read_b64_tr_b16 %0, %1 offset:%2" : "=&v"(r) : "v"(vb), "i"(OFF) : "memory"); return r;
}
template <int D0> __device__ __forceinline__ void pv_one(f32x16& od, int vb, bf16x8 pa0, bf16x8 pa1, bf16x8 pa2, bf16x8 pa3) {
  const s16x4 l0 = tr_read<v_rd_off(D0, 0, 0)>(vb), h0 = tr_read<v_rd_off(D0, 0, 1)>(vb), l1 = tr_read<v_rd_off(D0, 1, 0)>(vb), h1 = tr_read<v_rd_off(D0, 1, 1)>(vb);
  const s16x4 l2 = tr_read<v_rd_off(D0, 2, 0)>(vb), h2 = tr_read<v_rd_off(D0, 2, 1)>(vb), l3 = tr_read<v_rd_off(D0, 3, 0)>(vb), h3 = tr_read<v_rd_off(D0, 3, 1)>(vb);
  asm volatile("s_waitcnt lgkmcnt(0)" ::: "memory"); SBAR();
#define PK(L, H) (bf16x8){L[0], L[1], L[2], L[3], H[0], H[1], H[2], H[3]}
  od = __builtin_amdgcn_mfma_f32_32x32x16_bf16(pa0, PK(l0, h0), od, 0, 0, 0);
  od = __builtin_amdgcn_mfma_f32_32x32x16_bf16(pa1, PK(l1, h1), od, 0, 0, 0);
  od = __builtin_amdgcn_mfma_f32_32x32x16_bf16(pa2, PK(l2, h2), od, 0, 0, 0);
  od = __builtin_amdgcn_mfma_f32_32x32x16_bf16(pa3, PK(l3, h3), od, 0, 0, 0);
#undef PK
}
__device__ __forceinline__ void pv_d0(f32x16* o, int vb, bf16x8 pa0, bf16x8 pa1, bf16x8 pa2, bf16x8 pa3) {
  pv_one<0>(o[0], vb, pa0, pa1, pa2, pa3); pv_one<1>(o[1], vb, pa0, pa1, pa2, pa3); pv_one<2>(o[2], vb, pa0, pa1, pa2, pa3); pv_one<3>(o[3], vb, pa0, pa1, pa2, pa3);
}

constexpr int GA_SLOT = 16384, GA_K = 0, GA_V = 4 * GA_SLOT, GA_WS = 134144;
__device__ __forceinline__ void glds16(const char* gbase, unsigned voff, unsigned ldsaddr) {
  unsigned sv; asm volatile("s_mov_b32 %0, m0\n\ts_mov_b32 m0, %3\n\ts_nop 3\n\tglobal_load_lds_dwordx4 %1, %2\n\ts_mov_b32 m0, %0" : "=&s"(sv) : "v"(voff), "s"(gbase), "s"(ldsaddr) : "memory"); }
typedef short v4i16_t __attribute__((ext_vector_type(4)));
typedef __attribute__((address_space(3))) char* lds_ptr;
template <int OFF> __device__ __forceinline__ s16x4 vtr(lds_ptr vb) {
  return __builtin_bit_cast(s16x4, __builtin_amdgcn_ds_read_tr16_b64_v4i16((__attribute__((address_space(3))) v4i16_t*)(vb + OFF))); }
template <int D0, int BASE> __device__ __forceinline__ void pv_oneB(f32x16& od, lds_ptr vb, bf16x8 pa0, bf16x8 pa1, bf16x8 pa2, bf16x8 pa3) {
  const s16x4 l0 = vtr<BASE + v_rd_off(D0, 0, 0)>(vb), h0 = vtr<BASE + v_rd_off(D0, 0, 1)>(vb), l1 = vtr<BASE + v_rd_off(D0, 1, 0)>(vb), h1 = vtr<BASE + v_rd_off(D0, 1, 1)>(vb);
  const s16x4 l2 = vtr<BASE + v_rd_off(D0, 2, 0)>(vb), h2 = vtr<BASE + v_rd_off(D0, 2, 1)>(vb), l3 = vtr<BASE + v_rd_off(D0, 3, 0)>(vb), h3 = vtr<BASE + v_rd_off(D0, 3, 1)>(vb);
#define PK(L, H) (bf16x8){L[0], L[1], L[2], L[3], H[0], H[1], H[2], H[3]}
  od = __builtin_amdgcn_mfma_f32_32x32x16_bf16(pa0, PK(l0, h0), od, 0, 0, 0);
  od = __builtin_amdgcn_mfma_f32_32x32x16_bf16(pa1, PK(l1, h1), od, 0, 0, 0);
  od = __builtin_amdgcn_mfma_f32_32x32x16_bf16(pa2, PK(l2, h2), od, 0, 0, 0);
  od = __builtin_amdgcn_mfma_f32_32x32x16_bf16(pa3, PK(l3, h3), od, 0, 0, 0);
#undef PK
}
template <int BASE> __device__ __forceinline__ void pv_d0B(f32x16* o, lds_ptr vb, bf16x8 pa0, bf16x8 pa1, bf16x8 pa2, bf16x8 pa3) {
  pv_oneB<0, BASE>(o[0], vb, pa0, pa1, pa2, pa3); pv_oneB<1, BASE>(o[1], vb, pa0, pa1, pa2, pa3); pv_oneB<2, BASE>(o[2], vb, pa0, pa1, pa2, pa3); pv_oneB<3, BASE>(o[3], vb, pa0, pa1, pa2, pa3);
}
struct KF { bf16x8 a, b; };
template <int OFF> __device__ __forceinline__ bf16x8 kld(lds_ptr p) { return *(const __attribute__((address_space(3))) bf16x8*)(p + OFF); }
#define KLDP(F, SLOT, d0) do { F.a = kld<(SLOT) * GA_SLOT + ((d0) >> 2) * 128>(kq[(d0) & 3]); F.b = kld<(SLOT) * GA_SLOT + ((d0) >> 2) * 128 + 8192>(kq[(d0) & 3]); } while (0)
#define PIN(x) asm volatile("" : "+v"(x))
#define MFMA32(a, b, c) __builtin_amdgcn_mfma_f32_32x32x16_bf16(a, b, c, 0, 0, 0)
template <int KS>
__device__ __forceinline__ void qk_softmax(f32x16& C0, f32x16& C1, KF& ka, KF& kb, const lds_ptr (&kq)[4], const bf16x8 (&qr)[8], const f32x16& nm,
                                           f32x16& P0, f32x16& P1, float alpha, float& l_reg, bf16x8& pa0, bf16x8& pa1, bf16x8& pa2, bf16x8& pa3) {
  float sacc; unsigned a0, a1, b0, b1;
#define EXP1(i) P1[i] = __builtin_amdgcn_exp2f(P1[i]); PIN(P1)
#define SWZ(OUT) do { auto r0_ = __builtin_amdgcn_permlane32_swap(a0, b0, false, false); auto r1_ = __builtin_amdgcn_permlane32_swap(a1, b1, false, false); \
    u32x4 w_ = {r0_[0], r1_[0], r0_[1], r1_[1]}; OUT = *reinterpret_cast<bf16x8*>(&w_); PIN(OUT); } while (0)
  C0 = MFMA32(ka.a, qr[0], nm); EXP1(8);  sacc = P0[0] + P0[1];            a0 = cvtpk(P0[0], P0[1]);   PIN(sacc); PIN(a0); SBAR();
  C1 = MFMA32(ka.b, qr[0], nm); EXP1(9);  sacc += P0[2]; sacc += P0[3];    a1 = cvtpk(P0[2], P0[3]);   PIN(sacc); PIN(a1); SBAR();
  KLDP(ka, KS, 2); SBAR();
  C0 = MFMA32(kb.a, qr[1], C0); EXP1(10); sacc += P0[4]; sacc += P0[5];    b0 = cvtpk(P0[4], P0[5]);   PIN(sacc); PIN(b0); SBAR();
  C1 = MFMA32(kb.b, qr[1], C1); EXP1(11); sacc += P0[6]; sacc += P0[7];    b1 = cvtpk(P0[6], P0[7]);   PIN(sacc); SWZ(pa0); SBAR();
  KLDP(kb, KS, 3); SBAR();
  C0 = MFMA32(ka.a, qr[2], C0); EXP1(12); sacc += P0[8]; sacc += P0[9];    a0 = cvtpk(P0[8], P0[9]);   PIN(sacc); PIN(a0); SBAR();
  C1 = MFMA32(ka.b, qr[2], C1); EXP1(13); sacc += P0[10]; sacc += P0[11];  a1 = cvtpk(P0[10], P0[11]); PIN(sacc); PIN(a1); SBAR();
  KLDP(ka, KS, 4); SBAR();
  C0 = MFMA32(kb.a, qr[3], C0); EXP1(14); sacc += P0[12]; sacc += P0[13];  b0 = cvtpk(P0[12], P0[13]); PIN(sacc); PIN(b0); SBAR();
  C1 = MFMA32(kb.b, qr[3], C1); EXP1(15); sacc += P0[14]; sacc += P0[15];  b1 = cvtpk(P0[14], P0[15]); PIN(sacc); SWZ(pa1); SBAR();
  KLDP(kb, KS, 5); SBAR();
  C0 = MFMA32(ka.a, qr[4], C0); sacc += P1[0]; sacc += P1[1];    a0 = cvtpk(P1[0], P1[1]);   PIN(sacc); PIN(a0); SBAR();
  C1 = MFMA32(ka.b, qr[4], C1); sacc += P1[2]; sacc += P1[3];    a1 = cvtpk(P1[2], P1[3]);   PIN(sacc); PIN(a1); SBAR();
  KLDP(ka, KS, 6); SBAR();
  C0 = MFMA32(kb.a, qr[5], C0); sacc += P1[4]; sacc += P1[5];    b0 = cvtpk(P1[4], P1[5]);   PIN(sacc); PIN(b0); SBAR();
  C1 = MFMA32(kb.b, qr[5], C1); sacc += P1[6]; sacc += P1[7];    b1 = cvtpk(P1[6], P1[7]);   PIN(sacc); SWZ(pa2); SBAR();
  KLDP(kb, KS, 7); SBAR();
  C0 = MFMA32(ka.a, qr[6], C0); sacc += P1[8]; sacc += P1[9];    a0 = cvtpk(P1[8], P1[9]);   PIN(sacc); PIN(a0); SBAR();
  C1 = MFMA32(ka.b, qr[6], C1); sacc += P1[10]; sacc += P1[11];  a1 = cvtpk(P1[10], P1[11]); PIN(sacc); PIN(a1); SBAR();
  C0 = MFMA32(kb.a, qr[7], C0); sacc += P1[12]; sacc += P1[13];  b0 = cvtpk(P1[12], P1[13]); PIN(sacc); PIN(b0); SBAR();
  C1 = MFMA32(kb.b, qr[7], C1); sacc += P1[14]; sacc += P1[15];  b1 = cvtpk(P1[14], P1[15]); PIN(sacc); SWZ(pa3);
  { auto rr = __builtin_amdgcn_permlane32_swap(__float_as_uint(sacc), __float_as_uint(sacc), false, false); sacc = __uint_as_float(rr[0]) + __uint_as_float(rr[1]); }
  l_reg = l_reg * alpha + sacc; SBAR();
#undef EXP1
#undef SWZ
}
struct VF { s16x4 l0, h0, l1, h1, l2, h2, l3, h3; };
template <int BASE, int D0> __device__ __forceinline__ void rdg(VF& f, lds_ptr vb) {
  f.l0 = vtr<BASE + v_rd_off(D0, 0, 0)>(vb); f.h0 = vtr<BASE + v_rd_off(D0, 0, 1)>(vb); f.l1 = vtr<BASE + v_rd_off(D0, 1, 0)>(vb); f.h1 = vtr<BASE + v_rd_off(D0, 1, 1)>(vb);
  f.l2 = vtr<BASE + v_rd_off(D0, 2, 0)>(vb); f.h2 = vtr<BASE + v_rd_off(D0, 2, 1)>(vb); f.l3 = vtr<BASE + v_rd_off(D0, 3, 0)>(vb); f.h3 = vtr<BASE + v_rd_off(D0, 3, 1)>(vb); }
#define MX3(a, b, c) fmaxf(fmaxf((a), (b)), (c))
#define PKF(L, H) (bf16x8){L[0], L[1], L[2], L[3], H[0], H[1], H[2], H[3]}
template <int BASE, int KSN>
__device__ __forceinline__ void pv_softmax(f32x16* o, lds_ptr vb, bf16x8 pa0, bf16x8 pa1, bf16x8 pa2, bf16x8 pa3, f32x16& C0, f32x16& C1, float& m_reg, f32x16& nm, float& alpha, KF& ka, KF& kb, const lds_ptr (&kq)[4]) {
  VF fa, fb; float mx0, mx1;
  rdg<BASE, 0>(fa, vb); rdg<BASE, 1>(fb, vb); SBAR();
  o[0] = MFMA32(pa0, PKF(fa.l0, fa.h0), o[0]); mx0 = MX3(C0[0], C0[1], C0[2]);    mx1 = MX3(C0[3], C0[4], C0[5]);    mx0 = MX3(mx0, C0[6], C0[7]);   mx1 = MX3(mx1, C0[8], C0[9]);   PIN(mx0); PIN(mx1); SBAR();
  o[0] = MFMA32(pa1, PKF(fa.l1, fa.h1), o[0]); mx0 = MX3(mx0, C0[10], C0[11]);    mx1 = MX3(mx1, C0[12], C0[13]);    mx0 = MX3(mx0, C0[14], C0[15]); mx1 = MX3(mx1, C1[0], C1[1]);   PIN(mx0); PIN(mx1); SBAR();
  o[0] = MFMA32(pa2, PKF(fa.l2, fa.h2), o[0]); mx0 = MX3(mx0, C1[2], C1[3]);      mx1 = MX3(mx1, C1[4], C1[5]);      mx0 = MX3(mx0, C1[6], C1[7]);   mx1 = MX3(mx1, C1[8], C1[9]);   PIN(mx0); PIN(mx1); SBAR();
  o[0] = MFMA32(pa3, PKF(fa.l3, fa.h3), o[0]); mx0 = MX3(mx0, C1[10], C1[11]);    mx1 = MX3(mx1, C1[12], C1[13]);    mx0 = MX3(mx0, C1[14], C1[15]); float pmax = fmaxf(mx0, mx1);
  { auto rr = __builtin_amdgcn_permlane32_swap(__float_as_uint(pmax), __float_as_uint(pmax), false, false); pmax = fmaxf(__uint_as_float(rr[0]), __uint_as_float(rr[1])); } PIN(pmax); SBAR();
  rdg<BASE, 2>(fa, vb); SBAR();
  if (__builtin_expect(__all(pmax <= THR * 1.4426950408889634f), 1)) { alpha = 1.f; }
  else { const float d = fmaxf(pmax, 0.f); alpha = __builtin_amdgcn_exp2f(-d); m_reg += d;
    for (int r = 0; r < 16; ++r) { C0[r] -= d; C1[r] -= d; }
    for (int r = 0; r < 16; ++r) nm[r] = -m_reg; }
  SBAR();
#define EX2(C, i) C[i] = __builtin_amdgcn_exp2f(C[i]); C[i + 1] = __builtin_amdgcn_exp2f(C[i + 1]); PIN(C); SBAR()
  o[1] = MFMA32(pa0, PKF(fb.l0, fb.h0), o[1]); EX2(C0, 0);
  o[1] = MFMA32(pa1, PKF(fb.l1, fb.h1), o[1]); EX2(C0, 2);
  o[1] = MFMA32(pa2, PKF(fb.l2, fb.h2), o[1]); EX2(C0, 4);
  o[1] = MFMA32(pa3, PKF(fb.l3, fb.h3), o[1]); EX2(C0, 6);
  rdg<BASE, 3>(fb, vb); KLDP(ka, KSN, 0); KLDP(kb, KSN, 1); SBAR();
  o[2] = MFMA32(pa0, PKF(fa.l0, fa.h0), o[2]); EX2(C0, 8);
  o[2] = MFMA32(pa1, PKF(fa.l1, fa.h1), o[2]); EX2(C0, 10);
  o[2] = MFMA32(pa2, PKF(fa.l2, fa.h2), o[2]); EX2(C0, 12);
  o[2] = MFMA32(pa3, PKF(fa.l3, fa.h3), o[2]); EX2(C0, 14);
  o[3] = MFMA32(pa0, PKF(fb.l0, fb.h0), o[3]); EX2(C1, 0);
  o[3] = MFMA32(pa1, PKF(fb.l1, fb.h1), o[3]); EX2(C1, 2);
  o[3] = MFMA32(pa2, PKF(fb.l2, fb.h2), o[3]); EX2(C1, 4);
  o[3] = MFMA32(pa3, PKF(fb.l3, fb.h3), o[3]); EX2(C1, 6);
#undef EX2
}
template <int MODE>
__device__ __forceinline__ void attn_body(const bf16* __restrict__ Qb, const bf16* __restrict__ Kh, const bf16* __restrict__ Vh, bf16* __restrict__ Ob, int NT, char* lds, const Par P, const int tid) {
  static_assert(MODE == 0, "dense only");
  const int wid = __builtin_amdgcn_readfirstlane(tid >> 6), lane = tid & 63, r32 = lane & 31, hi = lane >> 5;
  float* ws = (float*)(lds + GA_WS) + wid * 64; float* li_l = ws; float* al_l = ws + 32;
  float m_reg = 0.f, l_reg = 0; f32x16 nm = {}; f32x16 o[4] = {}; bf16x8 qr[8];
  unsigned kof0, kof1, vof0, vof1;
  { const int rw0 = wid * 8 + (lane >> 4), rw1 = rw0 + 4; kof0 = (unsigned)(rw0 * LDK * 2 + (((lane & 15) ^ (rw0 & 7)) << 4)); kof1 = (unsigned)(rw1 * LDK * 2 + (((lane & 15) ^ (rw1 & 7)) << 4));
    const int s0 = wid * 4 + (lane >> 5), s1 = s0 + 2, kl = (lane & 31) >> 2, cl = (lane & 3) * 8;
    const int kk0 = (s0 >> 2) * 8 + kl, kk1 = (s1 >> 2) * 8 + kl, k0 = (kk0 & ~0xC) | ((kk0 & 4) << 1) | ((kk0 & 8) >> 1), k1 = (kk1 & ~0xC) | ((kk1 & 4) << 1) | ((kk1 & 8) >> 1);
    vof0 = (unsigned)(k0 * LDK * 2 + ((s0 & 3) * 32 + cl) * 2); vof1 = (unsigned)(k1 * LDK * 2 + ((s1 & 3) * 32 + cl) * 2); }
  const unsigned lds0 = (unsigned)(uintptr_t)lds;
  const unsigned kdst = (unsigned)__builtin_amdgcn_readfirstlane((int)(lds0 + GA_K + wid * 2048)), vdst = (unsigned)__builtin_amdgcn_readfirstlane((int)(lds0 + GA_V + wid * 2048));
#define DMA_K(t, slot) do { const char* g_ = (const char*)Kh + (size_t)(t) * (KVBLK * LDK * 2); glds16(g_, kof0, kdst + (slot) * GA_SLOT); glds16(g_, kof1, kdst + (slot) * GA_SLOT + 1024); } while (0)
#define DMA_V(t, slot) do { const char* g_ = (const char*)Vh + (size_t)(t) * (KVBLK * LDK * 2); glds16(g_, vof0, vdst + (slot) * GA_SLOT); glds16(g_, vof1, vdst + (slot) * GA_SLOT + 1024); } while (0)
#define WAIT_BAR(N) asm volatile("s_waitcnt vmcnt(" #N ") lgkmcnt(0)\n\ts_barrier" ::: "memory")
  DMA_K(0, 0); DMA_V(0, 0); DMA_K(1, 1); DMA_K(2, 2); DMA_V(1, 1); DMA_K(3, 3); DMA_V(2, 2);
  const unsigned qoff = (unsigned)((wid * QBLK + r32) * LDQ + hi * 8) * 2u;
  load_q<true>(qr, (const char*)Qb + qoff, P, wid * QBLK + r32, hi);
  const lds_ptr vb0 = (lds_ptr)(lds + GA_V) + v_rd_base(lane);
  lds_ptr kq[4];
#pragma unroll
  for (int i = 0; i < 4; ++i) kq[i] = (lds_ptr)(lds + GA_K) + KSWZ(r32, i * 32 + hi * 16);
  KF ka, kb;
#define RESC(a) do { if (__any((a) < 1.f)) { if (hi == 0) al_l[r32] = (a); asm volatile("s_waitcnt lgkmcnt(0)" ::: "memory"); \
    for (int d = 0; d < 4; ++d) for (int r = 0; r < 16; ++r) o[d][r] *= al_l[crow(r, hi)]; } } while (0)
  f32x16 pA0, pA1, pB0, pB1; float alA, alB; bf16x8 pa0, pa1, pa2, pa3;
#define STEP(C0, C1, AC, P0, P1, AP, j, KS, VS, DK, DV, CLAMP) do { \
    SBAR(); qk_softmax<KS>(C0, C1, ka, kb, kq, qr, nm, P0, P1, AP, l_reg, pa0, pa1, pa2, pa3); \
    { int tk = (j) + 3, tv = (j) + 2; if (CLAMP) { tk = tk < NT - 1 ? tk : NT - 1; tv = tv < NT - 1 ? tv : NT - 1; } DMA_K(tk, DK); DMA_V(tv, DV); } SBAR(); \
    pv_softmax<(VS) * GA_SLOT, ((KS) + 1) & 3>(o, vb0, pa0, pa1, pa2, pa3, C0, C1, m_reg, nm, AC, ka, kb, kq); \
    RESC(AC); WAIT_BAR(6); } while (0)
  WAIT_BAR(0);
  qkt_rel(pA0, pA1, (const bf16*)(lds + GA_K), qr, r32, hi, nm); partialSM_rel<true>(pA0, pA1, m_reg, nm, alA);
  KLDP(ka, 1, 0); KLDP(kb, 1, 1);
  WAIT_BAR(6);
  int j = 1;
  for (; j + 6 < NT; j += 4) {
    STEP(pB0, pB1, alB, pA0, pA1, alA, j,     1, 0, 0, 3, false);
    STEP(pA0, pA1, alA, pB0, pB1, alB, j + 1, 2, 1, 1, 0, false);
    STEP(pB0, pB1, alB, pA0, pA1, alA, j + 2, 3, 2, 2, 1, false);
    STEP(pA0, pA1, alA, pB0, pB1, alB, j + 3, 0, 3, 3, 2, false);
  }
  STEP(pB0, pB1, alB, pA0, pA1, alA, j,     1, 0, 0, 3, true);
  STEP(pA0, pA1, alA, pB0, pB1, alB, j + 1, 2, 1, 1, 0, true);
  STEP(pB0, pB1, alB, pA0, pA1, alA, j + 2, 3, 2, 2, 1, true);
  finishSM<8>(pB0, pB1, alB, l_reg, pa0, pa1, pa2, pa3); SBAR();
  pv_d0B<3 * GA_SLOT>(o, vb0, pa0, pa1, pa2, pa3);
  asm volatile("s_waitcnt vmcnt(0)" ::: "memory");
  if (hi == 0) li_l[r32] = l_reg; asm volatile("s_waitcnt lgkmcnt(0)" ::: "memory");
  float rli[16];
#pragma unroll
  for (int r = 0; r < 16; ++r) rli[r] = __builtin_amdgcn_rcpf(li_l[crow(r, hi)]);
  const unsigned ooff = (unsigned)((wid * QBLK + 4 * hi) * LDO + r32) * 2u;
#pragma unroll
  for (int r = 0; r < 16; ++r) { const int orow0 = (r & 3) + 8 * (r >> 2);
#pragma unroll
    for (int d0 = 0; d0 < 4; ++d0) *reinterpret_cast<bf16*>((char*)Ob + ooff + (unsigned)(orow0 * LDO + d0 * 32) * 2u) = (bf16)(cvtpk(o[d0][r] * rli[r], 0.f) & 0xffffu); }
  asm volatile("s_waitcnt lgkmcnt(0)\n\ts_barrier" ::: "memory");
#undef DMA_K
#undef DMA_V
#undef WAIT_BAR
#undef RESC
#undef STEP
}
template <int MODE>
__device__ __forceinline__ void attn_body_simple(const bf16* __restrict__ Qb, const bf16* __restrict__ Kh, const bf16* __restrict__ Vh, bf16* __restrict__ Ob, int NT, char* lds, const Par P, const int tid) {
  const int wid = __builtin_amdgcn_readfirstlane(tid >> 6), lane = tid & 63, r32 = lane & 31, hi = lane >> 5;
  char* V_lds = lds; char* K_lds = lds + 2 * SHM_V;
  float* ws = (float*)(lds + 2 * SHM_V + 2 * SHM_K) + wid * 64; float* li_l = ws; float* al_l = ws + 32;
  const float* tbl = (const float*)(lds + TBL_OFF);
  float m_reg = NEG, l_reg = 0; f32x16 o[4] = {}; bf16x8 qr[8];
  const unsigned qoff = (unsigned)((wid * QBLK + r32) * LDQ + hi * 8) * 2u;
  load_q<false>(qr, (const char*)Qb + qoff, P, wid * QBLK + r32, hi);
  const int sr = tid >> 4, sc = (tid & 15) * 8, vst0 = v_st(sr, sc), vst1 = v_st(32 + sr, sc), kst0 = KSWZ(sr, sc * 2), kst1 = KSWZ(32 + sr, sc * 2);
  const unsigned kvo0 = (unsigned)(sr * LDK + sc) * 2u, kvo1 = kvo0 + (unsigned)(32 * LDK * 2);
  const int vb0 = (int)(uintptr_t)V_lds + v_rd_base(lane);
  bf16x8 vs0, vs1, ks0, ks1;
#define SLD(k0) do { const char* vp_ = (const char*)Vh + (size_t)(k0) * (LDK * 2); const char* kp_ = (const char*)Kh + (size_t)(k0) * (LDK * 2); \
    vs0 = *reinterpret_cast<const bf16x8*>(vp_ + kvo0); vs1 = *reinterpret_cast<const bf16x8*>(vp_ + kvo1); ks0 = *reinterpret_cast<const bf16x8*>(kp_ + kvo0); ks1 = *reinterpret_cast<const bf16x8*>(kp_ + kvo1); } while (0)
  SLD(0);
  for (int jt = 0; jt < NT; ++jt) {
    const int b = jt & 1; char* Vb = V_lds + b * SHM_V; char* Kb = K_lds + b * SHM_K;
    *(bf16x8*)(Vb + vst0) = vs0; *(bf16x8*)(Vb + vst1) = vs1; *(bf16x8*)(Kb + kst0) = ks0; *(bf16x8*)(Kb + kst1) = ks1;
    if (jt + 1 < NT) SLD((jt + 1) * KVBLK);
    __syncthreads();
    bool need;
    if constexpr (MODE == 1) { const int kb = P.kpos0 + 64 * jt, qlo = P.qpos0 + wid * 32; need = (kb + 63 >= qlo - 128) && (kb <= qlo + 31 + 128); }
    else { const int r = P.r0 + (wid >> 1); int rs = r - 4; rs = rs < 0 ? 0 : rs; rs = rs > P.rows - 8 ? P.rows - 8 : rs; need = (unsigned)(P.kr0 + jt - rs) < 8u; }
    if (!need) continue;
    f32x16 p0, p1; float mn, alpha; bf16x8 pa0, pa1, pa2, pa3;
    qkt(p0, p1, (const bf16*)Kb, qr, r32, hi); modify<MODE>(p0, p1, jt, P, wid, r32, hi, tbl);
    partialSM(p0, p1, m_reg, mn, alpha);
    if (__any(alpha < 1.f)) { if (hi == 0) al_l[r32] = alpha; asm volatile("s_waitcnt lgkmcnt(0)" ::: "memory");
      for (int d = 0; d < 4; ++d) for (int r = 0; r < 16; ++r) o[d][r] *= al_l[crow(r, hi)]; }
    finishSM(p0, p1, alpha, l_reg, pa0, pa1, pa2, pa3);
    pv_d0(o, vb0 + b * (int)SHM_V, pa0, pa1, pa2, pa3);
  }
  if constexpr (MODE == 1) l_reg += __builtin_amdgcn_exp2f((P.sinkR - m_reg) * (SCALE * 1.4426950408889634f));
  if (hi == 0) li_l[r32] = l_reg; asm volatile("s_waitcnt lgkmcnt(0)" ::: "memory");
  float rli[16];
#pragma unroll
  for (int r = 0; r < 16; ++r) rli[r] = __builtin_amdgcn_rcpf(li_l[crow(r, hi)]);
  const unsigned ooff = (unsigned)((wid * QBLK + 4 * hi) * LDO + r32) * 2u;
#pragma unroll
  for (int r = 0; r < 16; ++r) { const int orow0 = (r & 3) + 8 * (r >> 2);
#pragma unroll
    for (int d0 = 0; d0 < 4; ++d0) *reinterpret_cast<bf16*>((char*)Ob + ooff + (unsigned)(orow0 * LDO + d0 * 32) * 2u) = (bf16)(cvtpk(o[d0][r] * rli[r], 0.f) & 0xffffu); }
  __syncthreads();
#undef SLD
}
#undef KSWZ
#undef SBAR
#undef MX3
#undef PIN
#undef PKF
#undef MFMA32
#undef KLDP
}

constexpr int NWAVES = 8;
constexpr int DM = 2048, DFF = 5632, DIN = 6144, HD = 128, NLAYER = 2;
constexpr int MTOT = 65536, MC = 32768, NCHUNK = 2;
constexpr float EPS = 1e-6f;
constexpr int C_QA = 0, C_KA = 1024, C_VA = 2048, C_QB = 3072, C_KB = 4096, C_VB = 4352, C_QC = 4608, C_KC = 5632, C_VC = 5888;
constexpr size_t MiB = 1u << 20;
constexpr size_t WS_CTL = 0, CTL_ZERO_BYTES = 1 * MiB;
constexpr size_t WS_ROPE = 1 * MiB;
constexpr size_t WS_W = 2 * MiB;
constexpr size_t W13_BYTES = (size_t)2 * DFF * DM * 2, WD_BYTES = (size_t)DM * DFF * 2, WIN_BYTES = (size_t)DIN * DM * 2, WGATE_BYTES = (size_t)3 * DM * DM * 2,
                 WBR_BYTES = (size_t)3 * DM * 1024 * 2, WOUT3_BYTES = (size_t)DM * DM * 2;
constexpr size_t LW_W13_1 = 0, LW_WD_1 = LW_W13_1 + W13_BYTES, LW_WIN = LW_WD_1 + WD_BYTES, LW_WGATE = LW_WIN + WIN_BYTES, LW_WBR = LW_WGATE + WGATE_BYTES,
                 LW_WOUT3 = LW_WBR + WBR_BYTES, LW_W13_2 = LW_WOUT3 + WOUT3_BYTES, LW_WD_2 = LW_W13_2 + W13_BYTES, LAYER_W_BYTES = LW_WD_2 + WD_BYTES;
constexpr size_t WS_H = WS_W + NLAYER * LAYER_W_BYTES;
constexpr size_t WS_QKV = WS_H + (size_t)MC * DM * 2;
constexpr size_t WS_BB = WS_QKV;
constexpr size_t WS_O = WS_QKV + (size_t)MC * DIN * 2;
constexpr size_t WS_MRG = WS_O;
constexpr size_t WS_SSQ = WS_O + (size_t)MC * 3072 * 2;
constexpr size_t WS_SCR = WS_SSQ + (size_t)MC * 32 * 4;
constexpr size_t WS_END = WS_SCR + (size_t)304 * 262144;
static_assert(LAYER_W_BYTES % 256 == 0 && WS_H % 256 == 0, "ws map alignment");
constexpr int CW_BAR = 4096;
constexpr int RING_OFF = 0, RING_BYTES = 131072;
constexpr int LDSCTL_OFF = RING_BYTES, MISC_OFF = LDSCTL_OFF + 320, RTAB_OFF = LDSCTL_OFF + 1024;
constexpr int LDS_BYTES = 147456;
static_assert(RING_OFF == 0 && att::GA_WS >= RTAB_OFF + 2048 && att::GA_WS + att::NW * 256 <= LDS_BYTES && att::GA_V + 4 * att::GA_SLOT <= RING_BYTES, "the dense attention rings fill the stage ring; its per-wave scratch sits behind the row-scale tables");

#define GAS __attribute__((address_space(1)))
#define LAS __attribute__((address_space(3)))
typedef unsigned short bf16;
typedef unsigned v4u __attribute__((ext_vector_type(4)));
typedef unsigned v2u __attribute__((ext_vector_type(2)));
typedef float f32x4 __attribute__((ext_vector_type(4)));
typedef GAS unsigned gu32;
#define LDS_WAIT() asm volatile("s_waitcnt lgkmcnt(0)" ::: "memory")
#define VM_WAIT() asm volatile("s_waitcnt vmcnt(0)" ::: "memory")
__device__ __forceinline__ unsigned f2bf(float f) { unsigned u = __builtin_bit_cast(unsigned, f); return (u + 0x7fffu + ((u >> 16) & 1u)) >> 16; }
__device__ __forceinline__ unsigned pk2(float lo, float hi) { return f2bf(lo) | (f2bf(hi) << 16); }

__device__ __forceinline__ int launder_s(int x) { asm volatile("" : "+s"(x)); return x; }
__device__ __forceinline__ int launder_v(int x) { asm volatile("" : "+v"(x)); return x; }
__device__ __forceinline__ int lane_id_local() { unsigned m = ~0u; asm volatile("" : "+s"(m)); return (int)__builtin_amdgcn_mbcnt_hi(m, __builtin_amdgcn_mbcnt_lo(m, 0u)); }

#define XB_TMO      128
#define XB_XCNT(j)  (256  + 64 * (j))
#define XB_XSUB(j)  (1280 + 64 * (j))
#define XB_XGEN(j)  (2304 + 64 * (j))
#define XB_TOP      3328
#define XB_TOPGEN   3392
#define XCD_BAR_WORDS 3456
#define XB_SPIN_CAP (1u << 22)

__device__ __forceinline__ unsigned xb_ld(unsigned* p)              { return __hip_atomic_load(p, __ATOMIC_RELAXED, __HIP_MEMORY_SCOPE_AGENT); }
__device__ __forceinline__ unsigned xb_add(unsigned* p, unsigned v) { return __hip_atomic_fetch_add(p, v, __ATOMIC_RELAXED, __HIP_MEMORY_SCOPE_AGENT); }
__device__ __forceinline__ unsigned xb_xcc_id() { return (unsigned)__builtin_amdgcn_s_getreg((3 << 11) | 20) & 0xFu; }
#define XB_SPIN(cond, bar) do { unsigned _sp = 0; while (cond) { __builtin_amdgcn_s_sleep(1); \
    if ((++_sp & 255u) == 0u) { if (xb_ld(&(bar)[XB_TMO])) break; if (_sp > XB_SPIN_CAP) { atomicAdd(&(bar)[XB_TMO], 1u); break; } } } } while (0)

struct XcdBarrier { unsigned* bar; unsigned x; volatile LAS unsigned* st; };

__device__ __forceinline__ XcdBarrier xcd_barrier_post(unsigned* bar, volatile LAS unsigned* st) {
    XcdBarrier b; b.bar = bar; b.x = xb_xcc_id(); b.st = st;
    if (threadIdx.x == 0) (void)xb_add(&bar[XB_XCNT(b.x)], 1u);
    return b;
}
__device__ __forceinline__ void xcd_barrier_complete(unsigned* bar, unsigned x, unsigned& nloc, unsigned& nx) {
    const unsigned G = gridDim.x * gridDim.y * gridDim.z;
    unsigned sum, cnt, mine, sp = 0u;
    for (;;) {
        sum = 0u; cnt = 0u; mine = 0u;
#pragma unroll
        for (unsigned j = 0; j < 16; ++j) { const unsigned c = xb_ld(&bar[XB_XCNT(j)]); sum += c; cnt += (c > 0u) ? 1u : 0u; mine = (j == x) ? c : mine; }
        if (sum == G) break;
        __builtin_amdgcn_s_sleep(1);
        if ((++sp & 255u) == 0u) { if (xb_ld(&bar[XB_TMO])) break; if (sp > XB_SPIN_CAP) { atomicAdd(&bar[XB_TMO], 1u); break; } }
    }
    nloc = mine > 0u ? mine : 1u; nx = cnt > 0u ? cnt : 1u;
}
__device__ __forceinline__ void xcd_barrier(const XcdBarrier& b, const int wave_s) {
    asm volatile("s_waitcnt vmcnt(0)" ::: "memory");
    __syncthreads();
    if (launder_s(wave_s) == 0 && lane_id_local() == 0) {
        unsigned* bar = b.bar; unsigned bx_ = b.x; asm volatile("" : "+s"(bar), "+s"(bx_));
        __builtin_amdgcn_s_waitcnt(0);
        unsigned nloc = b.st[0], nx = b.st[1];
        if (nloc == 0u) { xcd_barrier_complete(bar, bx_, nloc, nx); b.st[0] = nloc; b.st[1] = nx; }
        const unsigned old = xb_add(&bar[XB_XSUB(bx_)], 1u);
        const unsigned gen = old / nloc;
        if (old + 1u == (gen + 1u) * nloc) {
            __builtin_amdgcn_fence(__ATOMIC_RELEASE, "agent");
            asm volatile("s_waitcnt vmcnt(0)" ::: "memory");
            const unsigned og = xb_add(&bar[XB_TOP], 1u);
            const unsigned tg = og / nx;
            if (og + 1u == (tg + 1u) * nx) xb_add(&bar[XB_TOPGEN], 1u);
            else XB_SPIN(xb_ld(&bar[XB_TOPGEN]) == tg, bar);
            __builtin_amdgcn_fence(__ATOMIC_ACQUIRE, "agent");
            xb_add(&bar[XB_XGEN(bx_)], 1u);
            asm volatile("s_waitcnt vmcnt(0)" ::: "memory");
        } else {
            XB_SPIN(xb_ld(&bar[XB_XGEN(bx_)]) == gen, bar);
            __builtin_amdgcn_fence(__ATOMIC_ACQUIRE, "agent");
            asm volatile("s_waitcnt vmcnt(0)" ::: "memory");
        }
    }
    __syncthreads();
}

using pg8::shx;
__device__ __forceinline__ float wave_sum(float v, int lane) {
#pragma unroll
    for (int o = 1; o < 64; o <<= 1) v += shx(v, o, lane);
    return v;
}
__device__ __forceinline__ void row_to_xb(const float* xrow, bf16* orow, float* ssqrow, int lane) {
    const GAS f32x4* xr = (const GAS f32x4*)xrow + lane;
    f32x4 v[8]; float s = 0.f;
#pragma unroll
    for (int j = 0; j < 8; ++j) { v[j] = xr[64 * j]; s += (v[j].x * v[j].x + v[j].y * v[j].y) + (v[j].z * v[j].z + v[j].w * v[j].w); }
    s = wave_sum(s, lane);
    GAS v2u* o8 = (GAS v2u*)orow + lane;
#pragma unroll
    for (int j = 0; j < 8; ++j) { v2u w; w.x = pk2(v[j].x, v[j].y); w.y = pk2(v[j].z, v[j].w); o8[64 * j] = w; }
    if (lane < pg8::NSSQ) ssqrow[lane] = lane == 0 ? s : 0.f;
}

__device__ __forceinline__ void convert_item(const float* W, int K, int N, bf16* dst, int ldd, int mode, const float* gain, int item, int lane) {
    const int nb = N >> 8, kb = item / nb, n0 = ((item - kb * nb) << 8) + 4 * lane, k0 = 32 * kb;
    bf16* dp;
    if (mode == 2) dp = dst + (((size_t)(n0 >> 8) * (K >> 6) + (k0 >> 6)) * 256 + (n0 & 255)) * 64 + (k0 & 63);
    else dp = dst + (size_t)(mode ? ((n0 >> 7) * 256 + (n0 & 127)) : n0) * ldd + k0;
    const int rp = (mode == 2) ? 64 : ldd;
#pragma unroll 1
    for (int t8 = 0; t8 < 4; ++t8) {
        f32x4 v[8];
#pragma unroll
        for (int t = 0; t < 8; ++t) { const int k = k0 + 8 * t8 + t; const float gk = gain ? gain[k] : 1.0f; v[t] = *(const GAS f32x4*)(W + (size_t)k * N + n0) * gk; }
#pragma unroll
        for (int e = 0; e < 4; ++e) { v4u o; o.x = pk2(v[0][e], v[1][e]); o.y = pk2(v[2][e], v[3][e]); o.z = pk2(v[4][e], v[5][e]); o.w = pk2(v[6][e], v[7][e]);
            *(GAS v4u*)(dp + (size_t)e * rp + 8 * t8) = o; }
    }
}

struct Args { const float* in[23]; float* out; unsigned char* ws; int ph_lo, ph_hi, pad0, pad1; };
constexpr int NPH_PER = 13, NPHASE = 1 + NCHUNK * NLAYER * NPH_PER;
typedef const __attribute__((address_space(4))) Args* KArgs;
__device__ __forceinline__ KArgs kargs() { unsigned long long p = (unsigned long long)__builtin_amdgcn_kernarg_segment_ptr(); asm volatile("" : "+s"(p)); return (KArgs)p; }

__device__ __forceinline__ void convert_flat(KArgs ap, unsigned char* ws, int g, int lane) {
    const int l = g / 12800; int r = g - l * 12800;
    unsigned char* wl = ws + WS_W + (size_t)l * LAYER_W_BYTES;
    const float* g1 = ap->in[2] + l * DM; const float* gm = ap->in[6] + l * DM; const float* g2 = ap->in[19] + l * DM;
    if (r < 1408) { convert_item(ap->in[3] + (size_t)l * DM * DFF, DM, DFF, (bf16*)(wl + LW_W13_1), DM, 1, g1, r, lane); return; } r -= 1408;
    if (r < 1408) { convert_item(ap->in[4] + (size_t)l * DM * DFF, DM, DFF, (bf16*)(wl + LW_W13_1) + (size_t)128 * DM, DM, 1, g1, r, lane); return; } r -= 1408;
    if (r < 1408) { convert_item(ap->in[5] + (size_t)l * DFF * DM, DFF, DM, (bf16*)(wl + LW_WD_1), DFF, 2, nullptr, r, lane); return; } r -= 1408;
    if (r < 1536) { convert_item(ap->in[7] + (size_t)l * DM * DIN, DM, DIN, (bf16*)(wl + LW_WIN), DM, 0, gm, r, lane); return; } r -= 1536;
    if (r < 1536) { const int i = r / 512; convert_item(ap->in[8] + (size_t)(l * 3 + i) * DM * DM, DM, DM, (bf16*)(wl + LW_WGATE) + (size_t)i * DM * DM, DM, 0, gm, r - 512 * i, lane); return; } r -= 1536;
    if (r < 768) { const int i = r / 256; convert_item(ap->in[17] + (size_t)(l * 3 + i) * 1024 * DM, 1024, DM, (bf16*)(wl + LW_WBR) + (size_t)i * DM * 1024, 1024, 0, nullptr, r - 256 * i, lane); return; } r -= 768;
    if (r < 512) { convert_item(ap->in[18] + (size_t)l * DM * DM, DM, DM, (bf16*)(wl + LW_WOUT3), DM, 0, nullptr, r, lane); return; } r -= 512;
    if (r < 1408) { convert_item(ap->in[20] + (size_t)l * DM * DFF, DM, DFF, (bf16*)(wl + LW_W13_2), DM, 1, g2, r, lane); return; } r -= 1408;
    if (r < 1408) { convert_item(ap->in[21] + (size_t)l * DM * DFF, DM, DFF, (bf16*)(wl + LW_W13_2) + (size_t)128 * DM, DM, 1, g2, r, lane); return; } r -= 1408;
    convert_item(ap->in[22] + (size_t)l * DFF * DM, DFF, DM, (bf16*)(wl + LW_WD_2), DFF, 2, nullptr, r, lane);
}
#define PH_PRE \
    const int wave = launder_s(wave_s); const int lane = lane_id_local(); const int tid = wave * 64 + lane; (void)lane; (void)wave; \
    const KArgs ap = kargs(); const int bx = launder_s((int)blockIdx.x), G = launder_s((int)gridDim.x); \
    const int vcu = (G % 8 == 0) ? (bx % 8) * (G / 8) + bx / 8 : bx; const int gw = vcu * NWAVES + wave, NGW = G * NWAVES; (void)gw; (void)NGW; \
    unsigned char* const ws = ap->ws; (void)ws;
#define PH_PRE_CL \
    PH_PRE \
    const int c2 = launder_s(cl); const int chunk = c2 >> 1, layer = c2 & 1; (void)chunk; (void)layer; \
    const int S = chunk < 1 ? 8192 : 4096; (void)S; \
    float* const xo = ap->out + (size_t)chunk * MC * DM; (void)xo; \
    unsigned char* const wl = ws + WS_W + (size_t)layer * LAYER_W_BYTES; (void)wl; \
    float* const SSQ = (float*)(ws + WS_SSQ); (void)SSQ; bf16* const Hb = (bf16*)(ws + WS_H); bf16* const QKV = (bf16*)(ws + WS_QKV); bf16* const BB = (bf16*)(ws + WS_BB); bf16* const Ob = (bf16*)(ws + WS_O); (void)Hb; (void)QKV; (void)BB; (void)Ob;
#define XIN_PTR (chunk < 1 ? ap->in[0] : ap->in[1])

__global__ void __launch_bounds__(NWAVES * 64, 2) mk_fwd(Args args) {
    extern __shared__ __attribute__((aligned(16))) unsigned char lds[];
    LAS unsigned char* const ldsL = (LAS unsigned char*)lds;
    volatile LAS unsigned* const MISC = (volatile LAS unsigned*)(ldsL + MISC_OFF);
    const int wave_s = __builtin_amdgcn_readfirstlane((int)threadIdx.x >> 6);
    for (int u = threadIdx.x; u < (LDS_BYTES - LDSCTL_OFF) / 4; u += NWAVES * 64) ((LAS unsigned*)(ldsL + LDSCTL_OFF))[u] = 0u;
    __syncthreads();
    XcdBarrier bar = xcd_barrier_post((unsigned*)((gu32*)(args.ws + WS_CTL) + CW_BAR), MISC + 8);
    const int lo = args.ph_lo, hi = args.ph_hi;
#define IN(k) (lo <= (k) && (k) < hi)
#define SEAM(k) do { if (IN(k) && IN((k) + 1)) xcd_barrier(bar, wave_s); } while (0)

    if (IN(0)) {
        PH_PRE
        for (int g = gw; g < NLAYER * 12800; g += NGW) convert_flat(ap, ws, g, lane);
        { float* rope = (float*)(ws + WS_ROPE); const int gt = bx * (NWAVES * 64) + tid;
          if (gt < 128 * 32) { const int pos = gt >> 5, j = gt & 31;
              double f = 1.0; for (int q = 0; q < j; ++q) f *= 0.74989420933245582730;
              const double x2 = f * f; double c = 1.0, s = f, tc = 1.0, ts = f;
              for (int n = 1; n <= 12; ++n) { tc *= -x2 / (double)((2 * n - 1) * (2 * n)); c += tc; ts *= -x2 / (double)((2 * n) * (2 * n + 1)); s += ts; }
              double cr = 1.0, si = 0.0; for (int q = 0; q < pos; ++q) { const double t = cr * c - si * s; si = cr * s + si * c; cr = t; }
              rope[2 * gt] = (float)cr; rope[2 * gt + 1] = (float)si; } }
    }
    SEAM(0);

    for (int cl = 0; cl < NCHUNK * NLAYER; ++cl) {
        const int pb = 1 + cl * NPH_PER;
        if (hi <= pb || lo >= pb + NPH_PER) continue;

        if (IN(pb + 0) && (cl & 1) == 0) { PH_PRE_CL const float* x0 = XIN_PTR;
            for (int m = gw; m < MC; m += NGW) row_to_xb(x0 + (size_t)m * DM, Hb + (size_t)m * DM, SSQ + (size_t)m * pg8::NSSQ, lane); }
        if ((cl & 1) == 0) SEAM(pb + 0);
        if (IN(pb + 1)) { PH_PRE_CL pg8::Gemm g{Hb, (const bf16*)(wl + LW_W13_1), MC, 2 * DFF, DM, DM, DM, 0, 0, 0, 0}; pg8::RsOrder So; So.init(MC, 2 * DFF, G, bx); So.ssq = SSQ; So.tab = (LAS float*)(ldsL + RTAB_OFF); So.inv_ncol = 1.0f / DM; So.eps = EPS; So.tid = tid;
            pg8::EpiSwiglu E{QKV, DFF, (const LAS float*)(ldsL + RTAB_OFF)}; pg8::gemm_phase<pg8::EpiSwiglu, pg8::RsOrder, true, true>(ldsL + RING_OFF, g, So, E, tid); }
        SEAM(pb + 1);
        if (IN(pb + 2)) { PH_PRE_CL
            pg8::Gemm g{QKV, (const bf16*)(wl + LW_WD_1), MC, DM, DFF, DFF, DFF, 0, 0, 1, 1}; pg8::StaticOrder So; So.init(MC, DM, G, bx);
            pg8::EpiResidX E{Hb, nullptr, SSQ, DM, 0.5f}; pg8::gemm_phase<pg8::EpiResidX, pg8::StaticOrder, true, true>(ldsL + RING_OFF, g, So, E, tid); }
        SEAM(pb + 2);
        if (IN(pb + 4)) { PH_PRE_CL pg8::Gemm g{Hb, (const bf16*)(wl + LW_WIN), MC, DIN, DM, DM, DM, 0, 0, 0, 0}; pg8::RsOrder So; So.init(MC, DIN, G, bx); So.ssq = SSQ; So.tab = (LAS float*)(ldsL + RTAB_OFF); So.inv_ncol = 1.0f / DM; So.eps = EPS; So.tid = tid;
            pg8::EpiBf16 E{QKV, DIN, (const LAS float*)(ldsL + RTAB_OFF)}; pg8::gemm_phase<pg8::EpiBf16, pg8::RsOrder, true, true>(ldsL + RING_OFF, g, So, E, tid); }
        SEAM(pb + 4);
        if (IN(pb + 5)) { PH_PRE_CL
            const float* rope = (const float*)(ws + WS_ROPE);
            const int sub = lane >> 4, t16 = lane & 15;
            for (int task = gw; task < MC * 3; task += NGW) {
                const int m = task / 3, hidx = (task % 3) * 4 + sub;
                int cb; const float* gp; bool rp = false;
                if (hidx < 2) { cb = 32 + hidx; gp = ap->in[13]; rp = true; } else if (hidx < 10) { cb = 8 + (hidx - 2); gp = ap->in[10]; } else { cb = 44 + (hidx - 10); gp = ap->in[15]; }
                const bool task_rope = (task % 3) == 0;
                gp += layer * HD + 8 * t16;
                GAS v4u* p = (GAS v4u*)(QKV + (size_t)m * DIN + cb * 128 + 8 * t16);
                const v4u raw = *p;
                float x[8] = {pg8::bf_lo(raw.x), pg8::bf_hi(raw.x), pg8::bf_lo(raw.y), pg8::bf_hi(raw.y), pg8::bf_lo(raw.z), pg8::bf_hi(raw.z), pg8::bf_lo(raw.w), pg8::bf_hi(raw.w)};
                float ss = 0.f;
#pragma unroll
                for (int i = 0; i < 8; ++i) ss += x[i] * x[i];
                ss += shx(ss, 1, lane); ss += shx(ss, 2, lane); ss += shx(ss, 4, lane); ss += shx(ss, 8, lane);
                const float rstd = __builtin_amdgcn_rsqf(ss * (1.f / HD) + EPS);
                const f32x4 g0 = *(const GAS f32x4*)gp, g1 = *(const GAS f32x4*)(gp + 4);
                x[0] *= rstd * g0.x; x[1] *= rstd * g0.y; x[2] *= rstd * g0.z; x[3] *= rstd * g0.w; x[4] *= rstd * g1.x; x[5] *= rstd * g1.y; x[6] *= rstd * g1.z; x[7] *= rstd * g1.w;
                float y[8];
#pragma unroll
                for (int i = 0; i < 8; ++i) y[i] = x[i];
                if (task_rope) {
                    const int tpos = m % S, pos = (t16 & 8) ? (tpos & 63) : (tpos >> 6);
                    const bool first = (t16 & 4) == 0; const int j0 = 8 * (t16 & 3);
                    const GAS f32x4* rt = (const GAS f32x4*)(rope + ((size_t)pos * 32 + j0) * 2);
                    const f32x4 cs0 = rt[0], cs1 = rt[1], cs2 = rt[2], cs3 = rt[3];
                    const float cc[8] = {cs0.x, cs0.z, cs1.x, cs1.z, cs2.x, cs2.z, cs3.x, cs3.z}, sn[8] = {cs0.y, cs0.w, cs1.y, cs1.w, cs2.y, cs2.w, cs3.y, cs3.w};
#pragma unroll
                    for (int i = 0; i < 8; ++i) { const float other = shx(x[i], 4, lane); if (rp) y[i] = x[i] * cc[i] + (first ? -other : other) * sn[i]; }
                }
                v4u w; w.x = pk2(y[0], y[1]); w.y = pk2(y[2], y[3]); w.z = pk2(y[4], y[5]); w.w = pk2(y[6], y[7]);
                *p = w;
            }
        }
        SEAM(pb + 5);
        if (IN(pb + 6)) {
          { PH_PRE_CL
            const int nqb = S / 256, nunit = MC / 256 * 8;
            for (int u = vcu; u < nunit; u += G) {
                const int qb = u % nqb, h = (u / nqb) % 8, sq = u / (nqb * 8); const int kvh = h >> 2;
                const size_t row0 = (size_t)sq * S;
                att::Par P{0, 0, 0, 0, 0, 0.f, 0.f, ap->in[12] + layer * HD, (const float*)(ws + WS_ROPE), qb * 256};
                att::attn_body<0>(QKV + (row0 + (size_t)qb * 256) * DIN + C_QB + h * 128, QKV + row0 * DIN + C_KB + kvh * 128, QKV + row0 * DIN + C_VB + kvh * 128,
                                  Ob + (row0 + (size_t)qb * 256) * 3072 + 1024 + h * 128, S / 64, (char*)lds + RING_OFF, P, launder_s(wave_s) * 64 + lane_id_local());
            } }
          { PH_PRE_CL
            const int rows = S / 64, nqb = S / 256, nunit = MC / 256 * 8;
            for (int u = vcu; u < nunit; u += G) {
                const int qb = u % nqb, h = (u / nqb) % 8, sq = u / (nqb * 8);
                const size_t row0 = (size_t)sq * S;
                int kr0 = qb * 4 - 4; kr0 = kr0 < 0 ? 0 : kr0; kr0 = kr0 > rows - 12 ? rows - 12 : kr0;
                { const float* rb = ap->in[11] + (size_t)(layer * 8 + h) * 465; float* tb = (float*)((char*)lds + RING_OFF + att::TBL_OFF);
                  if (tid < 480) { const int rr = tid >> 5, cc = tid & 31; tb[tid] = (cc < 31) ? rb[rr * 31 + cc] * (1.0f / att::SCALE) : att::NEG; } }
                att::Par P{0, 0, qb * 4, rows, kr0, 0.f, 0.f, ap->in[9] + layer * HD, nullptr, qb * 256};
                att::attn_body_simple<2>(QKV + (row0 + (size_t)qb * 256) * DIN + C_QA + h * 128, QKV + (row0 + (size_t)kr0 * 64) * DIN + C_KA + h * 128, QKV + (row0 + (size_t)kr0 * 64) * DIN + C_VA + h * 128,
                                  Ob + (row0 + (size_t)qb * 256) * 3072 + h * 128, 12, (char*)lds + RING_OFF, P, tid);
            } }
          { PH_PRE_CL
            const int nqb = S / 256, nunit = MC / 256 * 8;
            for (int u = vcu; u < nunit; u += G) {
                const int qb = u % nqb, h = (u / nqb) % 8, sq = u / (nqb * 8); const int kvh = h >> 2;
                const size_t row0 = (size_t)sq * S;
                int ks = qb * 256 - 128; ks = ks < 0 ? 0 : ks; ks = ks > S - 512 ? S - 512 : ks;
                const float slope = exp2f(-(float)(h + 1)), sink = ap->in[16][layer * 8 + h];
                att::Par P{qb * 256, ks, 0, 0, 0, slope * (1.0f / att::SCALE), sink * (1.0f / att::SCALE), ap->in[14] + layer * HD, nullptr, qb * 256};
                att::attn_body_simple<1>(QKV + (row0 + (size_t)qb * 256) * DIN + C_QC + h * 128, QKV + (row0 + (size_t)ks) * DIN + C_KC + kvh * 128, QKV + (row0 + (size_t)ks) * DIN + C_VC + kvh * 128,
                                  Ob + (row0 + (size_t)qb * 256) * 3072 + 2048 + h * 128, 8, (char*)lds + RING_OFF, P, tid);
            } }
        }
        SEAM(pb + 6);
        if (IN(pb + 7)) { PH_PRE_CL pg8::Gemm g{Ob, (const bf16*)(wl + LW_WBR), MC, DIN, 1024, 3072, 1024, 8, 1024, 0, 0}; pg8::StaticOrder So; So.init(MC, DIN, G, bx);
            pg8::EpiTileImg E{BB, DIN / 256, tid}; pg8::gemm_phase<pg8::EpiTileImg, pg8::StaticOrder, true, true>(ldsL + RING_OFF, g, So, E, tid); }
        SEAM(pb + 7);
        if (IN(pb + 8)) { PH_PRE_CL pg8::Gemm g{Hb, (const bf16*)(wl + LW_WGATE), MC, DIN, DM, DM, DM, 0, 0, 0, 0}; pg8::TriOrder So; So.init3(MC, DM, G, bx); So.ssq = SSQ; So.tab = (LAS float*)(ldsL + RTAB_OFF); So.inv_ncol = 1.0f / DM; So.eps = EPS; So.tid = tid;
            pg8::EpiGateAcc E{BB, DIN / 256, (float*)(ws + WS_SCR) + (size_t)bx * 65536, (bf16*)(ws + WS_MRG), DM, (const LAS float*)(ldsL + RTAB_OFF), tid, DM / 256};
            pg8::gemm_phase<pg8::EpiGateAcc, pg8::TriOrder, true, true>(ldsL + RING_OFF, g, So, E, tid); }
        SEAM(pb + 8);
        if (IN(pb + 9)) { PH_PRE_CL pg8::Gemm g{(const bf16*)(ws + WS_MRG), (const bf16*)(wl + LW_WOUT3), MC, DM, DM, DM, DM, 0, 0, 0, 0}; pg8::StaticOrder So; So.init(MC, DM, G, bx);
            pg8::EpiResidX E{Hb, nullptr, SSQ, DM, 1.0f}; pg8::gemm_phase<pg8::EpiResidX, pg8::StaticOrder, true, true>(ldsL + RING_OFF, g, So, E, tid); }
        SEAM(pb + 9);
        if (IN(pb + 11)) { PH_PRE_CL pg8::Gemm g{Hb, (const bf16*)(wl + LW_W13_2), MC, 2 * DFF, DM, DM, DM, 0, 0, 0, 0}; pg8::RsOrder So; So.init(MC, 2 * DFF, G, bx); So.ssq = SSQ; So.tab = (LAS float*)(ldsL + RTAB_OFF); So.inv_ncol = 1.0f / DM; So.eps = EPS; So.tid = tid;
            pg8::EpiSwiglu E{QKV, DFF, (const LAS float*)(ldsL + RTAB_OFF)}; pg8::gemm_phase<pg8::EpiSwiglu, pg8::RsOrder, true, true>(ldsL + RING_OFF, g, So, E, tid); }
        SEAM(pb + 11);
        if (IN(pb + 12)) { PH_PRE_CL pg8::Gemm g{QKV, (const bf16*)(wl + LW_WD_2), MC, DM, DFF, DFF, DFF, 0, 0, 1, 1}; pg8::StaticOrder So; So.init(MC, DM, G, bx);
            pg8::EpiResidX E{Hb, (layer == NLAYER - 1) ? xo : nullptr, SSQ, DM, 0.5f}; pg8::gemm_phase<pg8::EpiResidX, pg8::StaticOrder, true, true>(ldsL + RING_OFF, g, So, E, tid); }
        SEAM(pb + 12);
    }
#undef IN
#undef SEAM
}

extern "C" void kernel_launch(void* const* d_in, const int* in_sizes, int n_in, void* d_out, int out_size, void* d_ws, size_t ws_size, hipStream_t stream) {
    static int grid = 0;
    if (grid == 0) {
        if (n_in != 23 || out_size != MTOT * DM || ws_size < WS_END) { fprintf(stderr, "kernel_launch: unexpected shapes: n_in %d out %d ws %zu (need %zu)\n", n_in, out_size, ws_size, (size_t)WS_END); grid = -1; return; }
        int dev = 0, cus = 0, per_cu = 0;
        if (hipGetDevice(&dev) != hipSuccess || hipDeviceGetAttribute(&cus, hipDeviceAttributeMultiprocessorCount, dev) != hipSuccess) { grid = -1; return; }
        if (hipFuncSetAttribute((const void*)mk_fwd, hipFuncAttributeMaxDynamicSharedMemorySize, LDS_BYTES) != hipSuccess) { fprintf(stderr, "kernel_launch: hipFuncSetAttribute failed\n"); grid = -1; return; }
        if (hipOccupancyMaxActiveBlocksPerMultiprocessor(&per_cu, (const void*)mk_fwd, NWAVES * 64, LDS_BYTES) != hipSuccess || per_cu < 1)
            fprintf(stderr, "kernel_launch: occupancy query reports %d workgroups per CU\n", per_cu);
        (void)hipGetLastError();
        grid = cus > 304 ? 304 : cus;
    }
    if (grid < 0) return;
    if (hipMemsetAsync((char*)d_ws + WS_CTL, 0, CTL_ZERO_BYTES, stream) != hipSuccess) return;
    Args a{};
    for (int i = 0; i < 23; ++i) a.in[i] = (const float*)d_in[i];
    a.out = (float*)d_out; a.ws = (unsigned char*)d_ws;
#if MK_ONE_LAUNCH
    a.ph_lo = 0; a.ph_hi = NPHASE;
    hipLaunchKernelGGL(mk_fwd, dim3(grid), dim3(NWAVES * 64), LDS_BYTES, stream, a);
#else
    for (int p = 0; p < NPHASE; ++p) { a.ph_lo = p; a.ph_hi = p + 1; hipLaunchKernelGGL(mk_fwd, dim3(grid), dim3(NWAVES * 64), LDS_BYTES, stream, a); }
#endif
    const hipError_t le = hipPeekAtLastError();
    if (le != hipSuccess) fprintf(stderr, "kernel_launch: launch failed: %s\n", hipGetErrorName(le));
}
```

```cpp
#include <hip/hip_runtime.h>
#include <cstdio>
#include <cstdint>

#ifndef MK_ONE_LAUNCH
#define MK_ONE_LAUNCH 1
#endif

namespace pg8 {
#define PG8_LAS __attribute__((address_space(3)))
typedef unsigned short bf16_t;
typedef short bf16x8 __attribute__((ext_vector_type(8)));
typedef float f32x4 __attribute__((ext_vector_type(4)));
typedef unsigned u32x4 __attribute__((ext_vector_type(4)));
constexpr int BM = 256, BK = 64, HALF = 128, HTB = HALF * BK * 2  , STAGE_BYTES = 8 * HTB, NXCD = 8, WGM = 4;

__host__ __device__ __forceinline__ int lds_byte(int r, int c) { const int st = (r >> 4) * 2 + (c >> 5), rr = r & 15, cc = c & 31, ob = rr * 64 + cc * 2; return st * 1024 + (ob ^ (((ob >> 9) & 1) << 5)); }
__host__ __device__ __forceinline__ void stage_rc(int b, int& R, int& C) { const int st = b / 1024, sb = b % 1024, swz = sb ^ (((sb >> 9) & 1) << 5); R = (st >> 1) * 16 + swz / 64; C = (st & 1) * 32 + (swz % 64) / 2; }
__host__ __device__ __forceinline__ int perm32(int rho) { const int n = rho >> 4, i = rho & 15; return 8 * (i >> 2) + 4 * n + (i & 3); }

struct Unit { int pm, pn, slot, fill; };
struct Gemm { const bf16_t* A; const bf16_t* Bt; int M, N, K, lda, ldb, grp, grp_a, ablk, bblk; };

struct StaticOrder {
    int nM, nN, nwg, G, c;
    __host__ __device__ void init(int M, int N, int G_, int c_) { nM = M / BM; nN = N / BM; nwg = nM * nN; G = G_; c = c_; }
    __host__ __device__ bool next(int i, Unit& u) const {
        const long L = (long)i * G + c; if (L >= nwg) return false;
        int wgid = (int)L; { const int q = nwg / NXCD, r = nwg % NXCD, xcd = wgid % NXCD, off = wgid / NXCD; wgid = (xcd < r ? xcd * (q + 1) : r * (q + 1) + (xcd - r) * q) + off; }
        const int nig = WGM * nN, gid = wgid / nig, fm = gid * WGM, gsz = (nM - fm) < WGM ? (nM - fm) : WGM;
        u.pm = fm + ((wgid % nig) % gsz); u.pn = (wgid % nig) / gsz;
        int pg = -1; if (i > 0) { int w2 = (int)(L - G); { const int q = nwg / NXCD, r = nwg % NXCD, xcd = w2 % NXCD, off = w2 / NXCD; w2 = (xcd < r ? xcd * (q + 1) : r * (q + 1) + (xcd - r) * q) + off; } pg = w2 / nig; }
        u.slot = gid & 1; u.fill = (pg != gid) ? 1 : 0; return true;
    }
    __device__ __forceinline__ void a_ready(const Unit&) const {}
    __device__ __forceinline__ void done(const Unit&) const {}
};

struct RsOrder : StaticOrder {
    const float* ssq; PG8_LAS float* tab; float inv_ncol, eps; int tid;
    __device__ __forceinline__ void a_ready(const Unit& u) const {
        if (u.fill && tid < 256) {
            const f32x4* p = (const f32x4*)(ssq + (size_t)(u.pm * BM + tid) * 32); float s = 0.f;
#pragma unroll
            for (int j = 0; j < 8; ++j) { const f32x4 a = p[j]; s += (a[0] + a[1]) + (a[2] + a[3]); }
            tab[u.slot * 256 + tid] = __builtin_amdgcn_rsqf(s * inv_ncol + eps);
        }
    }
};
struct TriOrder : RsOrder {
    int nN3;
    __host__ __device__ void init3(int M, int N3, int G_, int c_) { init(M, N3, G_, c_); nN3 = N3 / BM; }
    __host__ __device__ bool next(int i, Unit& u) const {
        const int t = i / 3, sub = i - 3 * t;
        if (!StaticOrder::next(t, u)) return false;
        u.pn += nN3 * sub; if (sub) u.fill = 0; return true;
    }
};
typedef float f32x2_t __attribute__((ext_vector_type(2))); typedef __bf16 bf16x2_t __attribute__((ext_vector_type(2)));
__device__ __forceinline__ unsigned cvt_pk_bf16(float lo, float hi) { const f32x2_t v = {lo, hi}; return __builtin_bit_cast(unsigned, __builtin_convertvector(v, bf16x2_t)); }
__device__ __forceinline__ float bf_lo(unsigned w) { return __uint_as_float(w << 16); }
__device__ __forceinline__ float bf_hi(unsigned w) { return __uint_as_float(w & 0xffff0000u); }
__device__ __forceinline__ float sigmoid_f(float x) { return __builtin_amdgcn_rcpf(1.0f + __builtin_amdgcn_exp2f(-1.4426950408889634f * x)); }

__device__ __forceinline__ float shx(float v, int mask, int lane) { return __builtin_bit_cast(float, __builtin_amdgcn_ds_bpermute((lane ^ mask) << 2, __builtin_bit_cast(int, v))); }
__device__ __forceinline__ float sum_x16(float v) { const auto r = __builtin_amdgcn_permlane16_swap(__float_as_uint(v), __float_as_uint(v), false, false); return __uint_as_float(r[0]) + __uint_as_float(r[1]); }
__device__ __forceinline__ float sum_x32(float v) { const auto r = __builtin_amdgcn_permlane32_swap(__float_as_uint(v), __float_as_uint(v), false, false); return __uint_as_float(r[0]) + __uint_as_float(r[1]); }
constexpr int NSSQ = 32;
__device__ __forceinline__ void load_rstd(const PG8_LAS float* rtab, int slot, int lrow0, float (&rs)[2][4]) {
#pragma unroll
    for (int ai = 0; ai < 2; ++ai)
#pragma unroll
        for (int m = 0; m < 4; ++m) rs[ai][m] = rtab ? rtab[slot * 256 + lrow0 + ai * HALF + m * 16] : 1.0f;
}
struct EpiBf16 {
    static constexpr bool PERM = true, AFTER_DRAIN = false;
    bf16_t* O; int ldc; const PG8_LAS float* rtab;
    __device__ __forceinline__ void operator()(const f32x4 (&acc)[2][2][4][2], const Unit& u, int wr, int wc, int fr, int fq) const {
        const int row0 = u.pm * BM + wr * 64 + fr, col0 = u.pn * BM + wc * 32 + 8 * fq;
        float rs[2][4]; load_rstd(rtab, u.slot, wr * 64 + fr, rs);
#pragma unroll
        for (int ai = 0; ai < 2; ++ai)
#pragma unroll
            for (int m = 0; m < 4; ++m) { bf16_t* rowp = O + (size_t)(row0 + ai * HALF + m * 16) * ldc + col0; const float r = rs[ai][m];
#pragma unroll
                for (int bj = 0; bj < 2; ++bj) { const f32x4 v0 = acc[ai][bj][m][0] * r, v1 = acc[ai][bj][m][1] * r;
                    u32x4 w; w.x = cvt_pk_bf16(v0[0], v0[1]); w.y = cvt_pk_bf16(v0[2], v0[3]); w.z = cvt_pk_bf16(v1[0], v1[1]); w.w = cvt_pk_bf16(v1[2], v1[3]);
                    *(u32x4*)(rowp + bj * HALF) = w; } }
    }
};
struct EpiTileImg {
    static constexpr bool PERM = true, AFTER_DRAIN = false;
    bf16_t* T; int ntn, tid;
    __device__ __forceinline__ void operator()(const f32x4 (&acc)[2][2][4][2], const Unit& u, int wr, int wc, int fr, int fq) const {
        char* const tb = (char*)T + (size_t)(u.pm * ntn + u.pn) * 131072; unsigned voff = (unsigned)tid * 16u; asm volatile("" : "+v"(voff));
#pragma unroll
        for (int ai = 0; ai < 2; ++ai)
#pragma unroll
            for (int m = 0; m < 4; ++m)
#pragma unroll
                for (int bj = 0; bj < 2; ++bj) { const f32x4 v0 = acc[ai][bj][m][0], v1 = acc[ai][bj][m][1];
                    u32x4 w; w.x = cvt_pk_bf16(v0[0], v0[1]); w.y = cvt_pk_bf16(v0[2], v0[3]); w.z = cvt_pk_bf16(v1[0], v1[1]); w.w = cvt_pk_bf16(v1[2], v1[3]);
                    *(u32x4*)(tb + (size_t)(((ai * 4 + m) * 2 + bj) * 8192) + voff) = w; }
    }
};
struct EpiSwiglu {
    static constexpr bool PERM = true, AFTER_DRAIN = false;
    bf16_t* O; int ldc; const PG8_LAS float* rtab;
    __device__ __forceinline__ void operator()(const f32x4 (&acc)[2][2][4][2], const Unit& u, int wr, int wc, int fr, int fq) const {
        const int lrow0 = wr * 64 + fr, kt = 2 * u.pn + (wc >> 1), cc = (wc & 1) * 32 + 8 * fq;
        bf16_t* const blk = O + ((size_t)u.pm * (ldc / BK) + kt) * (BM * BK) + cc;
        float rs[2][4]; load_rstd(rtab, u.slot, lrow0, rs);
#pragma unroll
        for (int ai = 0; ai < 2; ++ai)
#pragma unroll
            for (int m = 0; m < 4; ++m) { bf16_t* rowp = blk + (lrow0 + ai * HALF + m * 16) * BK; const float r = rs[ai][m], rn = -1.4426950408889634f * r, r2 = r * r;
                float h[8], ee[8];
#pragma unroll
                for (int n = 0; n < 2; ++n)
#pragma unroll
                    for (int j = 0; j < 4; ++j) { ee[n * 4 + j] = __builtin_amdgcn_exp2f(acc[ai][0][m][n][j] * rn); h[n * 4 + j] = acc[ai][0][m][n][j] * acc[ai][1][m][n][j]; }
#pragma unroll
                for (int j = 0; j < 8; ++j) ee[j] = __builtin_amdgcn_rcpf(1.0f + ee[j]) * r2;
#pragma unroll
                for (int j = 0; j < 8; ++j) h[j] = h[j] * ee[j];
                u32x4 w; w.x = cvt_pk_bf16(h[0], h[1]); w.y = cvt_pk_bf16(h[2], h[3]); w.z = cvt_pk_bf16(h[4], h[5]); w.w = cvt_pk_bf16(h[6], h[7]);
                *(u32x4*)rowp = w; }
    }
};
struct EpiResidX {
    static constexpr bool PERM = true, AFTER_DRAIN = false;
    bf16_t* xb; float* out32; float* ssq; int ldc; float alpha;
    struct Bt { u32x4 v[2][2]; };
    __device__ __forceinline__ void ld(Bt& b, int row0, int col0, int k) const {
#pragma unroll
        for (int mm = 0; mm < 2; ++mm)
#pragma unroll
            for (int bj = 0; bj < 2; ++bj) b.v[mm][bj] = *(const u32x4*)(xb + (size_t)(row0 + (k >> 1) * HALF + (2 * (k & 1) + mm) * 16) * ldc + col0 + bj * HALF);
    }
    __device__ __forceinline__ void st(const Bt& b, const f32x4 (&acc)[2][2][4][2], const Unit& u, int row0, int col0, int wc, int fq, int k) const {
        const int ai = k >> 1, mp = k & 1;
#pragma unroll
        for (int mm = 0; mm < 2; ++mm) { const int m = 2 * mp + mm, row = row0 + ai * HALF + m * 16; const size_t off = (size_t)row * ldc + col0; float ss = 0.f;
#pragma unroll
            for (int bj = 0; bj < 2; ++bj) { const u32x4 r = b.v[mm][bj];
                const f32x4 o0 = (f32x4){bf_lo(r.x), bf_hi(r.x), bf_lo(r.y), bf_hi(r.y)} + acc[ai][bj][m][0] * alpha, o1 = (f32x4){bf_lo(r.z), bf_hi(r.z), bf_lo(r.w), bf_hi(r.w)} + acc[ai][bj][m][1] * alpha;
                if (out32) { *(f32x4*)(out32 + off + bj * HALF) = o0; *(f32x4*)(out32 + off + bj * HALF + 4) = o1; }
                else { u32x4 w; w.x = cvt_pk_bf16(o0[0], o0[1]); w.y = cvt_pk_bf16(o0[2], o0[3]); w.z = cvt_pk_bf16(o1[0], o1[1]); w.w = cvt_pk_bf16(o1[2], o1[3]);
                    *(u32x4*)(xb + off + bj * HALF) = w;
                    ss += ((o0[0] * o0[0] + o0[1] * o0[1]) + (o0[2] * o0[2] + o0[3] * o0[3])) + ((o1[0] * o1[0] + o1[1] * o1[1]) + (o1[2] * o1[2] + o1[3] * o1[3])); } }
            if (!out32) { ss = sum_x32(sum_x16(ss)); if (fq == 0) ssq[(size_t)row * NSSQ + u.pn * 4 + wc] = ss; } }
    }
    __device__ __forceinline__ void operator()(const f32x4 (&acc)[2][2][4][2], const Unit& u, int wr, int wc, int fr, int fq) const {
        const int row0 = u.pm * BM + wr * 64 + fr, col0 = u.pn * BM + wc * 32 + 8 * fq;
        Bt bA, bB;
        ld(bA, row0, col0, 0);
        ld(bB, row0, col0, 1); st(bA, acc, u, row0, col0, wc, fq, 0);
        ld(bA, row0, col0, 2); st(bB, acc, u, row0, col0, wc, fq, 1);
        ld(bB, row0, col0, 3); st(bA, acc, u, row0, col0, wc, fq, 2);
        st(bB, acc, u, row0, col0, wc, fq, 3);
    }
};
struct EpiGateAcc {
    static constexpr bool PERM = true, AFTER_DRAIN = false;
    const bf16_t* B; int ldb; float* scr; bf16_t* Mg; int ldm; const PG8_LAS float* rtab; int tid, nN3;
    struct Bt { u32x4 b[2]; u32x4 mo[2]; };
#define SCRQ(q) (*(u32x4*)(sb + (size_t)(q) * 8192 + voff))
    template <int SUB>
    __device__ __forceinline__ void ld(Bt& t, const char* bimg, char* sb, unsigned voff, int k) const {
#pragma unroll
        for (int bj = 0; bj < 2; ++bj) { t.b[bj] = *(const u32x4*)(bimg + (size_t)((k * 2 + bj) * 8192) + voff);
            const int q = k * 2 + bj;
            if constexpr (SUB != 0) t.mo[bj] = SCRQ(q); else t.mo[bj] = (u32x4){0u, 0u, 0u, 0u}; }
    }
    template <int SUB>
    __device__ __forceinline__ void st(const Bt& t, const f32x4 (&acc)[2][2][4][2], float r, int row0, int colm, char* sb, unsigned voff, int k) const {
        const int ai = k >> 2, m = k & 3;
        const float rn = -1.4426950408889634f * r;
#pragma unroll
        for (int bj = 0; bj < 2; ++bj) { const f32x4 v0 = acc[ai][bj][m][0] * rn, v1 = acc[ai][bj][m][1] * rn; const u32x4 bb = t.b[bj];
            f32x4 t0, t1; float ee[8];
#pragma unroll
            for (int j = 0; j < 4; ++j) { ee[j] = __builtin_amdgcn_exp2f(v0[j]); ee[4 + j] = __builtin_amdgcn_exp2f(v1[j]); }
#pragma unroll
            for (int j = 0; j < 8; ++j) ee[j] = __builtin_amdgcn_rcpf(1.0f + ee[j]);
            t0[0] = ee[0] * bf_lo(bb.x); t0[1] = ee[1] * bf_hi(bb.x); t0[2] = ee[2] * bf_lo(bb.y); t0[3] = ee[3] * bf_hi(bb.y);
            t1[0] = ee[4] * bf_lo(bb.z); t1[1] = ee[5] * bf_hi(bb.z); t1[2] = ee[6] * bf_lo(bb.w); t1[3] = ee[7] * bf_hi(bb.w);
            if constexpr (SUB != 0) { const u32x4 mm = t.mo[bj];
                t0[0] += bf_lo(mm.x); t0[1] += bf_hi(mm.x); t0[2] += bf_lo(mm.y); t0[3] += bf_hi(mm.y); t1[0] += bf_lo(mm.z); t1[1] += bf_hi(mm.z); t1[2] += bf_lo(mm.w); t1[3] += bf_hi(mm.w); }
            u32x4 w; w.x = cvt_pk_bf16(t0[0], t0[1]); w.y = cvt_pk_bf16(t0[2], t0[3]); w.z = cvt_pk_bf16(t1[0], t1[1]); w.w = cvt_pk_bf16(t1[2], t1[3]);
            if constexpr (SUB != 2) SCRQ(k * 2 + bj) = w;
            else *(u32x4*)(Mg + (size_t)(row0 + ai * HALF + m * 16) * ldm + colm + bj * HALF) = w; }
    }
    template <int SUB>
    __device__ __forceinline__ void run(const f32x4 (&acc)[2][2][4][2], const float (&rs)[2][4], const char* bimg, char* sb, unsigned voff, int row0, int colm) const {
        Bt tA, tB;
        ld<SUB>(tA, bimg, sb, voff, 0);
        ld<SUB>(tB, bimg, sb, voff, 1); st<SUB>(tA, acc, rs[0][0], row0, colm, sb, voff, 0);
        ld<SUB>(tA, bimg, sb, voff, 2); st<SUB>(tB, acc, rs[0][1], row0, colm, sb, voff, 1);
        ld<SUB>(tB, bimg, sb, voff, 3); st<SUB>(tA, acc, rs[0][2], row0, colm, sb, voff, 2);
        ld<SUB>(tA, bimg, sb, voff, 4); st<SUB>(tB, acc, rs[0][3], row0, colm, sb, voff, 3);
        ld<SUB>(tB, bimg, sb, voff, 5); st<SUB>(tA, acc, rs[1][0], row0, colm, sb, voff, 4);
        ld<SUB>(tA, bimg, sb, voff, 6); st<SUB>(tB, acc, rs[1][1], row0, colm, sb, voff, 5);
        ld<SUB>(tB, bimg, sb, voff, 7); st<SUB>(tA, acc, rs[1][2], row0, colm, sb, voff, 6);
        st<SUB>(tB, acc, rs[1][3], row0, colm, sb, voff, 7);
    }
    __device__ __forceinline__ void operator()(const f32x4 (&acc)[2][2][4][2], const Unit& u, int wr, int wc, int fr, int fq) const {
        const int sub = u.pn / nN3, pn3 = u.pn - sub * nN3;
        const int row0 = u.pm * BM + wr * 64 + fr, colm = pn3 * BM + wc * 32 + 8 * fq;
        const char* const bimg = (const char*)B + (size_t)(u.pm * ldb + u.pn) * 131072;
        float rs[2][4]; load_rstd(rtab, u.slot, wr * 64 + fr, rs);
        char* const sb = (char*)scr; unsigned voff = (unsigned)tid * 16u; asm volatile("" : "+v"(voff));
        if (sub == 0) run<0>(acc, rs, bimg, sb, voff, row0, colm); else if (sub == 1) run<1>(acc, rs, bimg, sb, voff, row0, colm); else run<2>(acc, rs, bimg, sb, voff, row0, colm);
    }
#undef SCRQ
};

template <class Epi, class Sched, bool ALIGN_EPI = false, bool SP2 = false>
__device__ __forceinline__ void gemm_phase(PG8_LAS unsigned char* lds, const Gemm g, const Sched& S, const Epi& E, const int tid) {
    const int wid = __builtin_amdgcn_readfirstlane(tid >> 6), lane = tid & 63, wr = wid >> 2, wc = wid & 3, fr = lane & 15, fq = lane >> 4;
    const int K = g.K, nt = K / BK;
    unsigned voffA[2], voffB[2];
#pragma unroll
    for (int i = 0; i < 2; ++i) { int R, C; stage_rc(tid * 16 + i * 8192, R, C); const int Rb = Epi::PERM ? ((R & ~31) + perm32(R & 31)) : R;
        voffA[i] = (unsigned)(R * (g.ablk ? BK : g.lda) + C) * 2u; voffB[i] = (unsigned)(Rb * (g.bblk ? BK : g.ldb) + C) * 2u; }
    const size_t kstepA = g.ablk ? (size_t)(BM * BK * 2) : (size_t)(BK * 2), kstepB = g.bblk ? (size_t)(BM * BK * 2) : (size_t)(BK * 2);
    const size_t hstepA = (size_t)HALF * (g.ablk ? BK : g.lda) * 2, hstepB = (size_t)HALF * (g.bblk ? BK : g.ldb) * 2;
    const size_t tstepA = g.ablk ? (size_t)nt * (BM * BK * 2) : 2 * hstepA, tstepB = g.bblk ? (size_t)nt * (BM * BK * 2) : 2 * hstepB;
    const unsigned ldsw = (unsigned)wid * 1024u;
    const unsigned ldsb = (unsigned)__builtin_amdgcn_readfirstlane((int)(unsigned)(unsigned long long)(lds + ldsw));
    const int aoff = lds_byte(wr * 64 + fr, fq * 8), boff = lds_byte(wc * 32 + fr, fq * 8);
#define PG8_ABASE(u) ((const char*)g.A + (size_t)(u).pm * tstepA + (g.grp ? (size_t)(((u).pn / g.grp) * g.grp_a) * 2 : (size_t)0))
#define PG8_BBASE(u) ((const char*)g.Bt + (size_t)(u).pn * tstepB)
#define PG8_SA(b, h) (((b) * 2 + (h)) * HTB)
#define PG8_SB(b, h) ((4 + (b) * 2 + (h)) * HTB)
#define PG8_STAGE(bufoff, gbase, voff) do { const char* _g = (const char*)(gbase); const unsigned _l = ldsb + (unsigned)(bufoff); unsigned _k; _Pragma("unroll") for (int _i = 0; _i < 2; ++_i) \
        asm volatile("s_mov_b32 %0, m0\n\ts_mov_b32 m0, %3\n\ts_nop 3\n\tglobal_load_lds_dwordx4 %1, %2\n\ts_mov_b32 m0, %0" : "=&s"(_k) : "v"((voff)[_i]), "s"(_g), "s"(_l + _i * 8192u) : "memory"); } while (0)
#define PG8_LDA(dst, b, h) do { _Pragma("unroll") for (int m = 0; m < 4; ++m) _Pragma("unroll") for (int k = 0; k < 2; ++k) dst[m][k] = *(const PG8_LAS bf16x8*)(lds + PG8_SA(b, h) + aoff + m * 2048 + k * 1024); } while (0)
#define PG8_LDB(dst, b, h) do { _Pragma("unroll") for (int n = 0; n < 2; ++n) _Pragma("unroll") for (int k = 0; k < 2; ++k) dst[n][k] = *(const PG8_LAS bf16x8*)(lds + PG8_SB(b, h) + boff + n * 2048 + k * 1024); } while (0)
#define PG8_MMA(ai, bj, At, Bt) do { __builtin_amdgcn_s_setprio(1); _Pragma("unroll") for (int m = 0; m < 4; ++m) _Pragma("unroll") for (int n = 0; n < 2; ++n) _Pragma("unroll") for (int k = 0; k < 2; ++k) \
        acc[ai][bj][m][n] = __builtin_amdgcn_mfma_f32_16x16x32_bf16(Bt[n][k], At[m][k], acc[ai][bj][m][n], 0, 0, 0); __builtin_amdgcn_s_setprio(0); } while (0)
#define PG8_WAIT_V(n) asm volatile("s_waitcnt vmcnt(" #n ")" ::: "memory")
#define PG8_WAIT_L(n) asm volatile("s_waitcnt lgkmcnt(" #n ")" ::: "memory")
#define PG8_BAR __builtin_amdgcn_s_barrier()
#define PG8_SCHED __builtin_amdgcn_sched_barrier(0)
    Unit cur, nxt; int ui = 0;
    if (!S.next(0, cur)) return;
    f32x4 acc[2][2][4][2];
#pragma unroll
    for (int a = 0; a < 2; ++a)
#pragma unroll
        for (int b = 0; b < 2; ++b)
#pragma unroll
            for (int m = 0; m < 4; ++m)
#pragma unroll
                for (int n = 0; n < 2; ++n) acc[a][b][m][n] = (f32x4){0.f, 0.f, 0.f, 0.f};
    bf16x8 At[4][2], B0[2][2], B1[2][2];
    const char* cA = PG8_ABASE(cur); const char* cB = PG8_BBASE(cur);
    S.a_ready(cur);
    if constexpr (SP2) {
        PG8_STAGE(PG8_SB(0, 0), cB, voffB); PG8_STAGE(PG8_SB(0, 1), cB + hstepB, voffB); PG8_STAGE(PG8_SA(0, 0), cA, voffA); PG8_STAGE(PG8_SA(0, 1), cA + hstepA, voffA);
        if (wr == 1) PG8_BAR;
        PG8_WAIT_V(2); PG8_BAR;
        PG8_STAGE(PG8_SB(1, 0), cB + kstepB, voffB); PG8_STAGE(PG8_SA(1, 0), cA + kstepA, voffA); PG8_STAGE(PG8_SB(1, 1), cB + hstepB + kstepB, voffB);
        PG8_WAIT_V(6); PG8_BAR;
    } else {
        PG8_STAGE(PG8_SB(0, 0), cB, voffB); PG8_STAGE(PG8_SA(0, 0), cA, voffA); PG8_STAGE(PG8_SB(0, 1), cB + hstepB, voffB); PG8_STAGE(PG8_SA(0, 1), cA + hstepA, voffA);
        if (wr == 1) PG8_BAR;
        PG8_WAIT_V(4); PG8_BAR;
        PG8_STAGE(PG8_SB(1, 0), cB + kstepB, voffB); PG8_STAGE(PG8_SA(1, 0), cA + kstepA, voffA); PG8_STAGE(PG8_SB(1, 1), cB + hstepB + kstepB, voffB);
        PG8_WAIT_V(6); PG8_BAR;
    }
    for (;;) {
        const bool has_next = S.next(ui + 1, nxt);
        const char* nA = has_next ? PG8_ABASE(nxt) : cA; const char* nB = has_next ? PG8_BBASE(nxt) : cB;
        for (int t = 0; t < nt; t += 2) {
            const bool last = (t == nt - 2);
            const char* a1 = cA + (size_t)(t + 1) * kstepA;
            const char* a2 = last ? nA : cA + (size_t)(t + 2) * kstepA; const char* b2 = last ? nB : cB + (size_t)(t + 2) * kstepB;
            const char* a3 = a2 + kstepA; const char* b3 = b2 + kstepB;
            if (last && has_next) S.a_ready(nxt);
            if constexpr (SP2) {
            PG8_LDB(B0, 0, 0); PG8_LDB(B1, 0, 1); PG8_SCHED; PG8_LDA(At, 0, 0); PG8_STAGE(PG8_SA(1, 1), a1 + hstepA, voffA);
            PG8_WAIT_V(8); PG8_WAIT_L(0); PG8_BAR; PG8_MMA(0, 0, At, B0); PG8_MMA(0, 1, At, B1); PG8_BAR; PG8_SCHED;
            PG8_LDA(At, 0, 1); PG8_STAGE(PG8_SB(0, 0), b2, voffB); PG8_STAGE(PG8_SB(0, 1), b2 + hstepB, voffB); PG8_STAGE(PG8_SA(0, 0), a2, voffA);
            PG8_WAIT_V(8); PG8_WAIT_L(0); PG8_BAR; PG8_MMA(1, 0, At, B0); PG8_MMA(1, 1, At, B1); PG8_BAR; PG8_SCHED;
            PG8_LDB(B0, 1, 0); PG8_LDB(B1, 1, 1); PG8_SCHED; PG8_LDA(At, 1, 0); PG8_STAGE(PG8_SA(0, 1), a2 + hstepA, voffA);
            PG8_WAIT_V(8); PG8_WAIT_L(0); PG8_BAR; PG8_MMA(0, 0, At, B0); PG8_MMA(0, 1, At, B1); PG8_BAR; PG8_SCHED;
            PG8_LDA(At, 1, 1); PG8_STAGE(PG8_SB(1, 0), b3, voffB); PG8_STAGE(PG8_SB(1, 1), b3 + hstepB, voffB); PG8_STAGE(PG8_SA(1, 0), a3, voffA);
            PG8_WAIT_V(8); PG8_WAIT_L(0); PG8_BAR; PG8_MMA(1, 0, At, B0); PG8_MMA(1, 1, At, B1); PG8_BAR; PG8_SCHED;
            } else {
            PG8_LDB(B0, 0, 0); PG8_SCHED; PG8_LDA(At, 0, 0); PG8_STAGE(PG8_SA(1, 1), a1 + hstepA, voffA);
            PG8_WAIT_L(8); PG8_BAR; PG8_WAIT_L(0); PG8_MMA(0, 0, At, B0); PG8_BAR; PG8_SCHED;
            PG8_LDB(B1, 0, 1); PG8_STAGE(PG8_SB(0, 0), b2, voffB);
            PG8_BAR; PG8_WAIT_L(0); PG8_MMA(0, 1, At, B1); PG8_BAR;
            PG8_LDA(At, 0, 1); PG8_STAGE(PG8_SA(0, 0), a2, voffA);
            PG8_BAR; PG8_WAIT_L(0); PG8_MMA(1, 0, At, B0); PG8_BAR; PG8_SCHED;
            PG8_STAGE(PG8_SB(0, 1), b2 + hstepB, voffB);
            PG8_WAIT_V(6); PG8_BAR; PG8_MMA(1, 1, At, B1); PG8_BAR;
            PG8_LDB(B0, 1, 0); PG8_SCHED; PG8_LDA(At, 1, 0); PG8_STAGE(PG8_SA(0, 1), a2 + hstepA, voffA);
            PG8_WAIT_L(8); PG8_BAR; PG8_WAIT_L(0); PG8_MMA(0, 0, At, B0); PG8_BAR; PG8_SCHED;
            PG8_LDB(B1, 1, 1); PG8_STAGE(PG8_SB(1, 0), b3, voffB);
            PG8_BAR; PG8_WAIT_L(0); PG8_MMA(0, 1, At, B1); PG8_BAR;
            PG8_LDA(At, 1, 1); PG8_STAGE(PG8_SA(1, 0), a3, voffA);
            PG8_BAR; PG8_WAIT_L(0); PG8_MMA(1, 0, At, B0); PG8_BAR; PG8_SCHED;
            PG8_STAGE(PG8_SB(1, 1), b3 + hstepB, voffB);
            PG8_WAIT_V(6); PG8_BAR; PG8_MMA(1, 1, At, B1); PG8_BAR;
            }
        }
        if constexpr (ALIGN_EPI) { if (wr == 0) PG8_BAR; }
        if constexpr (!Epi::AFTER_DRAIN) { E(acc, cur, wr, wc, fr, fq); S.done(cur); }
        if (!has_next) break;
#pragma unroll
        for (int a = 0; a < 2; ++a)
#pragma unroll
            for (int b = 0; b < 2; ++b)
#pragma unroll
                for (int m = 0; m < 4; ++m)
#pragma unroll
                    for (int n = 0; n < 2; ++n) acc[a][b][m][n] = (f32x4){0.f, 0.f, 0.f, 0.f};
        cur = nxt; cA = nA; cB = nB; ++ui;
        if constexpr (ALIGN_EPI) { if (wr == 1) PG8_BAR; }
    }
    PG8_WAIT_V(0);
    if constexpr (!ALIGN_EPI) { if (wr == 0) PG8_BAR; }
    PG8_BAR;
#undef PG8_ABASE
#undef PG8_BBASE
#undef PG8_SA
#undef PG8_SB
#undef PG8_STAGE
#undef PG8_LDA
#undef PG8_LDB
#undef PG8_MMA
#undef PG8_WAIT_V
#undef PG8_WAIT_L
#undef PG8_BAR
#undef PG8_SCHED
}
}

namespace att {
using bf16 = unsigned short;
constexpr int D = 128, NW = 8, QBLK = 32, KVBLK = 64;
constexpr float SCALE = 0.088388347648318440f;
constexpr float THR = 8.f;
constexpr float NEG = -1.0e5f;
constexpr int LDQ = 6144, LDK = 6144, LDO = 3072;
constexpr size_t SHM_V = KVBLK * D * 2, SHM_K = KVBLK * D * 2, SHM_ATTN = 2 * SHM_V + 2 * SHM_K + NW * 64 * 4;
constexpr int TBL_OFF = 69632;

using bf16x8 = __attribute__((ext_vector_type(8))) short;
using s16x4  = __attribute__((ext_vector_type(4))) short;
using f32x16 = __attribute__((ext_vector_type(16))) float;
using u32x4  = __attribute__((ext_vector_type(4))) unsigned;
#define KSWZ(row, colB) ((row) * 256 + ((colB) ^ (((row) & 7) << 4)))
#define SBAR() __builtin_amdgcn_sched_barrier(0)
__device__ __forceinline__ int crow(int r, int hi) { return (r & 3) + 8 * (r >> 2) + 4 * hi; }
__device__ __forceinline__ unsigned cvtpk(float lo, float hi) { const pg8::f32x2_t v = {lo, hi}; return __builtin_bit_cast(unsigned, __builtin_convertvector(v, pg8::bf16x2_t)); }

struct Par { int qpos0, kpos0, r0, rows, kr0; float slopeR, sinkR; const float* gq; const float* rope; int qt0; const float* gk; };

__device__ __forceinline__ void partialSM(f32x16& p0, f32x16& p1, float& m_reg, float& mn, float& alpha) {
  constexpr float C = SCALE * 1.4426950408889634f;
  float pmax = p0[0]; for (int r = 1; r < 16; ++r) pmax = fmaxf(pmax, p0[r]); for (int r = 0; r < 16; ++r) pmax = fmaxf(pmax, p1[r]);
  { auto rr = __builtin_amdgcn_permlane32_swap(__float_as_uint(pmax), __float_as_uint(pmax), false, false);
    pmax = fmaxf(__uint_as_float(rr[0]), __uint_as_float(rr[1])); }
  if (__builtin_expect(__all(pmax - m_reg <= THR / SCALE), 1)) { mn = m_reg; alpha = 1.f; }
  else { mn = fmaxf(m_reg, pmax); alpha = __builtin_amdgcn_exp2f((m_reg - mn) * C); m_reg = mn; }
  float mnC = -mn * C;
  for (int r = 0; r < 16; ++r) p0[r] = fmaf(p0[r], C, mnC); for (int r = 0; r < 16; ++r) p1[r] = fmaf(p1[r], C, mnC);
  for (int r = 0; r < 16; ++r) p0[r] = __builtin_amdgcn_exp2f(p0[r]);
}
template <int NEXP = 16>
__device__ __forceinline__ void finishSM(f32x16& p0, f32x16& p1, float alpha, float& l_reg, bf16x8& pa0, bf16x8& pa1, bf16x8& pa2, bf16x8& pa3) {
  for (int r = 16 - NEXP; r < 16; ++r) p1[r] = __builtin_amdgcn_exp2f(p1[r]);
  float ps = 0; for (int r = 0; r < 16; ++r) ps += p0[r]; for (int r = 0; r < 16; ++r) ps += p1[r];
  { auto rr = __builtin_amdgcn_permlane32_swap(__float_as_uint(ps), __float_as_uint(ps), false, false);
    ps = __uint_as_float(rr[0]) + __uint_as_float(rr[1]); }
  l_reg = l_reg * alpha + ps;
#define PK4(P, BASE, OUT) do { unsigned a0 = cvtpk(P[BASE + 0], P[BASE + 1]), a1 = cvtpk(P[BASE + 2], P[BASE + 3]);   \
    unsigned b0 = cvtpk(P[BASE + 4], P[BASE + 5]), b1 = cvtpk(P[BASE + 6], P[BASE + 7]);                              \
    auto r0 = __builtin_amdgcn_permlane32_swap(a0, b0, false, false); auto r1 = __builtin_amdgcn_permlane32_swap(a1, b1, false, false); \
    u32x4 w = {r0[0], r1[0], r0[1], r1[1]}; OUT = *reinterpret_cast<bf16x8*>(&w); } while (0)
  PK4(p0, 0, pa0); PK4(p0, 8, pa1); PK4(p1, 0, pa2); PK4(p1, 8, pa3);
#undef PK4
}
__device__ __forceinline__ void qkt(f32x16& p0, f32x16& p1, const bf16* Ks, const bf16x8* qr, int r32, int hi) {
  p0 = f32x16{}; p1 = f32x16{};
  for (int d0 = 0; d0 < 8; ++d0) { int cb = (d0 * 16 + hi * 8) * 2;
    bf16x8 b0 = *reinterpret_cast<const bf16x8*>((const char*)Ks + KSWZ(r32, cb));
    bf16x8 b1 = *reinterpret_cast<const bf16x8*>((const char*)Ks + KSWZ(32 + r32, cb));
    p0 = __builtin_amdgcn_mfma_f32_32x32x16_bf16(b0, qr[d0], p0, 0, 0, 0);
    p1 = __builtin_amdgcn_mfma_f32_32x32x16_bf16(b1, qr[d0], p1, 0, 0, 0); }
}
__device__ __forceinline__ void qkt_rel(f32x16& p0, f32x16& p1, const bf16* Ks, const bf16x8* qr, int r32, int hi, const f32x16& nm) {
  { bf16x8 b0 = *reinterpret_cast<const bf16x8*>((const char*)Ks + KSWZ(r32, hi * 16)); bf16x8 b1 = *reinterpret_cast<const bf16x8*>((const char*)Ks + KSWZ(32 + r32, hi * 16));
    p0 = __builtin_amdgcn_mfma_f32_32x32x16_bf16(b0, qr[0], nm, 0, 0, 0); p1 = __builtin_amdgcn_mfma_f32_32x32x16_bf16(b1, qr[0], nm, 0, 0, 0); }
  for (int d0 = 1; d0 < 8; ++d0) { int cb = ((d0 & 3) * 16 + hi * 8) * 2;
    bf16x8 b0 = *reinterpret_cast<const bf16x8*>((const char*)Ks + KSWZ(r32, cb) + (d0 >> 2) * 128);
    bf16x8 b1 = *reinterpret_cast<const bf16x8*>((const char*)Ks + KSWZ(32 + r32, cb) + (d0 >> 2) * 128);
    p0 = __builtin_amdgcn_mfma_f32_32x32x16_bf16(b0, qr[d0], p0, 0, 0, 0);
    p1 = __builtin_amdgcn_mfma_f32_32x32x16_bf16(b1, qr[d0], p1, 0, 0, 0); }
}
template <bool FIRST>
__device__ __forceinline__ void partialSM_rel(f32x16& p0, f32x16& p1, float& m_reg, f32x16& nm, float& alpha) {
  float pmax = p0[0]; for (int r = 1; r < 16; ++r) pmax = fmaxf(pmax, p0[r]); for (int r = 0; r < 16; ++r) pmax = fmaxf(pmax, p1[r]);
  { auto rr = __builtin_amdgcn_permlane32_swap(__float_as_uint(pmax), __float_as_uint(pmax), false, false);
    pmax = fmaxf(__uint_as_float(rr[0]), __uint_as_float(rr[1])); }
  if (!FIRST && __builtin_expect(__all(pmax <= THR * 1.4426950408889634f), 1)) { alpha = 1.f; }
  else { const float d = FIRST ? pmax : fmaxf(pmax, 0.f); alpha = FIRST ? 1.f : __builtin_amdgcn_exp2f(-d); m_reg += d;
    for (int r = 0; r < 16; ++r) { p0[r] -= d; p1[r] -= d; }
    for (int r = 0; r < 16; ++r) nm[r] = -m_reg; }
  for (int r = 0; r < 16; ++r) p0[r] = __builtin_amdgcn_exp2f(p0[r]);
  for (int r = 0; r < 8; ++r) p1[r] = __builtin_amdgcn_exp2f(p1[r]);
}
template <int MODE>
__device__ __forceinline__ void modify(f32x16& p0, f32x16& p1, int jt, const Par& P, int wid, int r32, int hi, const float* tbl) {
  if constexpr (MODE == 1) {
    const int qpos = P.qpos0 + wid * 32 + r32, kb = P.kpos0 + 64 * jt;
#pragma unroll
    for (int r = 0; r < 16; ++r) { const int kp = kb + crow(r, hi); int d0 = qpos - kp; d0 = d0 < 0 ? -d0 : d0; int d1 = qpos - (kp + 32); d1 = d1 < 0 ? -d1 : d1;
      p0[r] = (d0 <= 128) ? p0[r] - P.slopeR * (float)d0 : NEG; p1[r] = (d1 <= 128) ? p1[r] - P.slopeR * (float)d1 : NEG; }
  }
  if constexpr (MODE == 2) {
    const int r = P.r0 + (wid >> 1), c = 32 * (wid & 1) + r32;
    int rs = r - 4; rs = rs < 0 ? 0 : rs; rs = rs > P.rows - 8 ? P.rows - 8 : rs;
    int cs = c - 8; cs = cs < 0 ? 0 : cs; cs = cs > 48 ? 48 : cs;
    const int kr = P.kr0 + jt;
    if ((unsigned)(kr - rs) < 8u) {
      const float* tb = tbl + (kr - r + 7) * 32;
      int A = 4 * hi - cs, B = 4 * hi + 15 - c; asm volatile("" : "+v"(A), "+v"(B));
#pragma unroll
      for (int q = 0; q < 16; ++q) { const int kq = (q & 3) + 8 * (q >> 2);
        const int i0 = ((unsigned)(kq + A) < 16u) ? kq + B : 31, i1 = ((unsigned)(kq + 32 + A) < 16u) ? kq + 32 + B : 31;
        p0[q] += tb[i0]; p1[q] += tb[i1];
        if ((q & 3) == 3) asm volatile("" ::: "memory"); }
    } else {
#pragma unroll
      for (int q = 0; q < 16; ++q) { p0[q] = NEG; p1[q] = NEG; }
    }
  }
}
template <bool ROPE>
__device__ __forceinline__ void load_q(bf16x8 (&qr)[8], const char* Qp, const Par& P, int qrow, int hi) {
  float x[8][8]; float ss = 0.f;
#pragma unroll
  for (int d0 = 0; d0 < 8; ++d0) { const bf16x8 raw = *reinterpret_cast<const bf16x8*>(Qp + d0 * 32);
#pragma unroll
    for (int e = 0; e < 8; ++e) { x[d0][e] = __uint_as_float(((unsigned)(unsigned short)raw[e]) << 16); ss += x[d0][e] * x[d0][e]; } }
  { auto rr = __builtin_amdgcn_permlane32_swap(__float_as_uint(ss), __float_as_uint(ss), false, false); ss = __uint_as_float(rr[0]) + __uint_as_float(rr[1]); }
  const float rstd = __builtin_amdgcn_rsqf(ss * (1.0f / 128.0f) + 1e-6f) * (ROPE ? SCALE * 1.4426950408889634f : 1.0f);
#pragma unroll
  for (int d0 = 0; d0 < 8; ++d0) { const float* gp = P.gq + d0 * 16 + hi * 8;
#pragma unroll
    for (int e = 0; e < 8; ++e) x[d0][e] *= rstd * gp[e]; }
  if constexpr (ROPE) {
    const int t = P.qt0 + qrow; int hiR = hi; asm volatile("" : "+v"(hiR));
#pragma unroll
    for (int hb = 0; hb < 2; ++hb) { const int pos = hb ? (t & 63) : (t >> 6);
#pragma unroll
      for (int dd = 0; dd < 2; ++dd) { const float* cs = P.rope + ((size_t)pos * 32 + dd * 16 + hiR * 8) * 2; const int da = 4 * hb + dd, db = da + 2;
#pragma unroll
        for (int e = 0; e < 8; ++e) { const float c = cs[2 * e], s = cs[2 * e + 1], a = x[da][e], b = x[db][e]; x[da][e] = a * c - b * s; x[db][e] = b * c + a * s; } } }
  }
#pragma unroll
  for (int d0 = 0; d0 < 8; ++d0) { u32x4 w = {cvtpk(x[d0][0], x[d0][1]), cvtpk(x[d0][2], x[d0][3]), cvtpk(x[d0][4], x[d0][5]), cvtpk(x[d0][6], x[d0][7])}; qr[d0] = *reinterpret_cast<bf16x8*>(&w); }
}
__device__ __forceinline__ int v_st(int k, int c) { const int kk = (k & ~0xC) | ((k & 4) << 1) | ((k & 8) >> 1); return ((kk >> 3) * 4 + (c >> 5)) * 512 + ((kk & 7) * 32 + (c & 31)) * 2; }
__device__ __forceinline__ int v_rd_base(int lane) { return ((lane & 3) << 3) | (((lane >> 2) & 3) << 6) | (((lane >> 4) & 1) << 5) | (((lane >> 5) & 1) << 8); }
constexpr int v_rd_off(int d0, int ks, int half) { return d0 * 512 + ks * 4096 + half * 2048; }
template <int OFF> __device__ __forceinline__ s16x4 tr_read(int vb) {
  s16x4 r; asm volatile("ds_read_b64_tr_b16 %0, %1 offset:%2" : "=&v"(r) : "v"(vb), "i"(OFF) : "memory"); return r;
}
template <int D0> __device__ __forceinline__ void pv_one(f32x16& od, int vb, bf16x8 pa0, bf16x8 pa1, bf16x8 pa2, bf16x8 pa3) {
  const s16x4 l0 = tr_read<v_rd_off(D0, 0, 0)>(vb), h0 = tr_read<v_rd_off(D0, 0, 1)>(vb), l1 = tr_read<v_rd_off(D0, 1, 0)>(vb), h1 = tr_read<v_rd_off(D0, 1, 1)>(vb);
  const s16x4 l2 = tr_read<v_rd_off(D0, 2, 0)>(vb), h2 = tr_read<v_rd_off(D0, 2, 1)>(vb), l3 = tr_read<v_rd_off(D0, 3, 0)>(vb), h3 = tr_read<v_rd_off(D0, 3, 1)>(vb);
  asm volatile("s_waitcnt lgkmcnt(0)" ::: "memory"); SBAR();
#define PK(L, H) (bf16x8){L[0], L[1], L[2], L[3], H[0], H[1], H[2], H[3]}
  od = __builtin_amdgcn_mfma_f32_32x32x16_bf16(pa0, PK(l0, h0), od, 0, 0, 0);
  od = __builtin_amdgcn_mfma_f32_32x32x16_bf16(pa1, PK(l1, h1), od, 0, 0, 0);
  od = __builtin_amdgcn_mfma_f32_32x32x16_bf16(pa2, PK(l2, h2), od, 0, 0, 0);
  od = __builtin_amdgcn_mfma_f32_32x32x16_bf16(pa3, PK(l3, h3), od, 0, 0, 0);
#undef PK
}
__device__ __forceinline__ void pv_d0(f32x16* o, int vb, bf16x8 pa0, bf16x8 pa1, bf16x8 pa2, bf16x8 pa3) {
  pv_one<0>(o[0], vb, pa0, pa1, pa2, pa3); pv_one<1>(o[1], vb, pa0, pa1, pa2, pa3); pv_one<2>(o[2], vb, pa0, pa1, pa2, pa3); pv_one<3>(o[3], vb, pa0, pa1, pa2, pa3);
}

constexpr int GA_SLOT = 16384, GA_K = 0, GA_V = 4 * GA_SLOT, GA_WS = 134144;
__device__ __forceinline__ void glds16(const char* gbase, unsigned voff, unsigned ldsaddr) {
  unsigned sv; asm volatile("s_mov_b32 %0, m0\n\ts_mov_b32 m0, %3\n\ts_nop 3\n\tglobal_load_lds_dwordx4 %1, %2\n\ts_mov_b32 m0, %0" : "=&s"(sv) : "v"(voff), "s"(gbase), "s"(ldsaddr) : "memory"); }
typedef short v4i16_t __attribute__((ext_vector_type(4)));
typedef __attribute__((address_space(3))) char* lds_ptr;
template <int OFF> __device__ __forceinline__ s16x4 vtr(lds_ptr vb) {
  return __builtin_bit_cast(s16x4, __builtin_amdgcn_ds_read_tr16_b64_v4i16((__attribute__((address_space(3))) v4i16_t*)(vb + OFF))); }
template <int D0, int BASE> __device__ __forceinline__ void pv_oneB(f32x16& od, lds_ptr vb, bf16x8 pa0, bf16x8 pa1, bf16x8 pa2, bf16x8 pa3) {
  const s16x4 l0 = vtr<BASE + v_rd_off(D0, 0, 0)>(vb), h0 = vtr<BASE + v_rd_off(D0, 0, 1)>(vb), l1 = vtr<BASE + v_rd_off(D0, 1, 0)>(vb), h1 = vtr<BASE + v_rd_off(D0, 1, 1)>(vb);
  const s16x4 l2 = vtr<BASE + v_rd_off(D0, 2, 0)>(vb), h2 = vtr<BASE + v_rd_off(D0, 2, 1)>(vb), l3 = vtr<BASE + v_rd_off(D0, 3, 0)>(vb), h3 = vtr<BASE + v_rd_off(D0, 3, 1)>(vb);
#define PK(L, H) (bf16x8){L[0], L[1], L[2], L[3], H[0], H[1], H[2], H[3]}
  od = __builtin_amdgcn_mfma_f32_32x32x16_bf16(pa0, PK(l0, h0), od, 0, 0, 0);
  od = __builtin_amdgcn_mfma_f32_32x32x16_bf16(pa1, PK(l1, h1), od, 0, 0, 0);
  od = __builtin_amdgcn_mfma_f32_32x32x16_bf16(pa2, PK(l2, h2), od, 0, 0, 0);
  od = __builtin_amdgcn_mfma_f32_32x32x16_bf16(pa3, PK(l3, h3), od, 0, 0, 0);
#undef PK
}
template <int BASE> __device__ __forceinline__ void pv_d0B(f32x16* o, lds_ptr vb, bf16x8 pa0, bf16x8 pa1, bf16x8 pa2, bf16x8 pa3) {
  pv_oneB<0, BASE>(o[0], vb, pa0, pa1, pa2, pa3); pv_oneB<1, BASE>(o[1], vb, pa0, pa1, pa2, pa3); pv_oneB<2, BASE>(o[2], vb, pa0, pa1, pa2, pa3); pv_oneB<3, BASE>(o[3], vb, pa0, pa1, pa2, pa3);
}
struct KF { bf16x8 a, b; };
template <int OFF> __device__ __forceinline__ bf16x8 kld(lds_ptr p) { return *(const __attribute__((address_space(3))) bf16x8*)(p + OFF); }
#define KLDP(F, SLOT, d0) do { F.a = kld<(SLOT) * GA_SLOT + ((d0) >> 2) * 128>(kq[(d0) & 3]); F.b = kld<(SLOT) * GA_SLOT + ((d0) >> 2) * 128 + 8192>(kq[(d0) & 3]); } while (0)
#define PIN(x) asm volatile("" : "+v"(x))
#define MFMA32(a, b, c) __builtin_amdgcn_mfma_f32_32x32x16_bf16(a, b, c, 0, 0, 0)
template <int KS>
__device__ __forceinline__ void qk_softmax(f32x16& C0, f32x16& C1, KF& ka, KF& kb, const lds_ptr (&kq)[4], const bf16x8 (&qr)[8], const f32x16& nm,
                                           f32x16& P0, f32x16& P1, float alpha, float& l_reg, bf16x8& pa0, bf16x8& pa1, bf16x8& pa2, bf16x8& pa3) {
  float sacc; unsigned a0, a1, b0, b1;
#define EXP1(i) P1[i] = __builtin_amdgcn_exp2f(P1[i]); PIN(P1)
#define SWZ(OUT) do { auto r0_ = __builtin_amdgcn_permlane32_swap(a0, b0, false, false); auto r1_ = __builtin_amdgcn_permlane32_swap(a1, b1, false, false); \
    u32x4 w_ = {r0_[0], r1_[0], r0_[1], r1_[1]}; OUT = *reinterpret_cast<bf16x8*>(&w_); PIN(OUT); } while (0)
  C0 = MFMA32(ka.a, qr[0], nm); EXP1(8);  sacc = P0[0] + P0[1];            a0 = cvtpk(P0[0], P0[1]);   PIN(sacc); PIN(a0); SBAR();
  C1 = MFMA32(ka.b, qr[0], nm); EXP1(9);  sacc += P0[2]; sacc += P0[3];    a1 = cvtpk(P0[2], P0[3]);   PIN(sacc); PIN(a1); SBAR();
  KLDP(ka, KS, 2); SBAR();
  C0 = MFMA32(kb.a, qr[1], C0); EXP1(10); sacc += P0[4]; sacc += P0[5];    b0 = cvtpk(P0[4], P0[5]);   PIN(sacc); PIN(b0); SBAR();
  C1 = MFMA32(kb.b, qr[1], C1); EXP1(11); sacc += P0[6]; sacc += P0[7];    b1 = cvtpk(P0[6], P0[7]);   PIN(sacc); SWZ(pa0); SBAR();
  KLDP(kb, KS, 3); SBAR();
  C0 = MFMA32(ka.a, qr[2], C0); EXP1(12); sacc += P0[8]; sacc += P0[9];    a0 = cvtpk(P0[8], P0[9]);   PIN(sacc); PIN(a0); SBAR();
  C1 = MFMA32(ka.b, qr[2], C1); EXP1(13); sacc += P0[10]; sacc += P0[11];  a1 = cvtpk(P0[10], P0[11]); PIN(sacc); PIN(a1); SBAR();
  KLDP(ka, KS, 4); SBAR();
  C0 = MFMA32(kb.a, qr[3], C0); EXP1(14); sacc += P0[12]; sacc += P0[13];  b0 = cvtpk(P0[12], P0[13]); PIN(sacc); PIN(b0); SBAR();
  C1 = MFMA32(kb.b, qr[3], C1); EXP1(15); sacc += P0[14]; sacc += P0[15];  b1 = cvtpk(P0[14], P0[15]); PIN(sacc); SWZ(pa1); SBAR();
  KLDP(kb, KS, 5); SBAR();
  C0 = MFMA32(ka.a, qr[4], C0); sacc += P1[0]; sacc += P1[1];    a0 = cvtpk(P1[0], P1[1]);   PIN(sacc); PIN(a0); SBAR();
  C1 = MFMA32(ka.b, qr[4], C1); sacc += P1[2]; sacc += P1[3];    a1 = cvtpk(P1[2], P1[3]);   PIN(sacc); PIN(a1); SBAR();
  KLDP(ka, KS, 6); SBAR();
  C0 = MFMA32(kb.a, qr[5], C0); sacc += P1[4]; sacc += P1[5];    b0 = cvtpk(P1[4], P1[5]);   PIN(sacc); PIN(b0); SBAR();
  C1 = MFMA32(kb.b, qr[5], C1); sacc += P1[6]; sacc += P1[7];    b1 = cvtpk(P1[6], P1[7]);   PIN(sacc); SWZ(pa2); SBAR();
  KLDP(kb, KS, 7); SBAR();
  C0 = MFMA32(ka.a, qr[6], C0); sacc += P1[8]; sacc += P1[9];    a0 = cvtpk(P1[8], P1[9]);   PIN(sacc); PIN(a0); SBAR();
  C1 = MFMA32(ka.b, qr[6], C1); sacc += P1[10]; sacc += P1[11];  a1 = cvtpk(P1[10], P1[11]); PIN(sacc); PIN(a1); SBAR();
  C0 = MFMA32(kb.a, qr[7], C0); sacc += P1[12]; sacc += P1[13];  b0 = cvtpk(P1[12], P1[13]); PIN(sacc); PIN(b0); SBAR();
  C1 = MFMA32(kb.b, qr[7], C1); sacc += P1[14]; sacc += P1[15];  b1 = cvtpk(P1[14], P1[15]); PIN(sacc); SWZ(pa3);
  { auto rr = __builtin_amdgcn_permlane32_swap(__float_as_uint(sacc), __float_as_uint(sacc), false, false); sacc = __uint_as_float(rr[0]) + __uint_as_float(rr[1]); }
  l_reg = l_reg * alpha + sacc; SBAR();
#undef EXP1
#undef SWZ
}
struct VF { s16x4 l0, h0, l1, h1, l2, h2, l3, h3; };
template <int BASE, int D0> __device__ __forceinline__ void rdg(VF& f, lds_ptr vb) {
  f.l0 = vtr<BASE + v_rd_off(D0, 0, 0)>(vb); f.h0 = vtr<BASE + v_rd_off(D0, 0, 1)>(vb); f.l1 = vtr<BASE + v_rd_off(D0, 1, 0)>(vb); f.h1 = vtr<BASE + v_rd_off(D0, 1, 1)>(vb);
  f.l2 = vtr<BASE + v_rd_off(D0, 2, 0)>(vb); f.h2 = vtr<BASE + v_rd_off(D0, 2, 1)>(vb); f.l3 = vtr<BASE + v_rd_off(D0, 3, 0)>(vb); f.h3 = vtr<BASE + v_rd_off(D0, 3, 1)>(vb); }
#define MX3(a, b, c) fmaxf(fmaxf((a), (b)), (c))
#define PKF(L, H) (bf16x8){L[0], L[1], L[2], L[3], H[0], H[1], H[2], H[3]}
template <int BASE, int KSN>
__device__ __forceinline__ void pv_softmax(f32x16* o, lds_ptr vb, bf16x8 pa0, bf16x8 pa1, bf16x8 pa2, bf16x8 pa3, f32x16& C0, f32x16& C1, float& m_reg, f32x16& nm, float& alpha, KF& ka, KF& kb, const lds_ptr (&kq)[4]) {
  VF fa, fb; float mx0, mx1;
  rdg<BASE, 0>(fa, vb); rdg<BASE, 1>(fb, vb); SBAR();
  o[0] = MFMA32(pa0, PKF(fa.l0, fa.h0), o[0]); mx0 = MX3(C0[0], C0[1], C0[2]);    mx1 = MX3(C0[3], C0[4], C0[5]);    mx0 = MX3(mx0, C0[6], C0[7]);   mx1 = MX3(mx1, C0[8], C0[9]);   PIN(mx0); PIN(mx1); SBAR();
  o[0] = MFMA32(pa1, PKF(fa.l1, fa.h1), o[0]); mx0 = MX3(mx0, C0[10], C0[11]);    mx1 = MX3(mx1, C0[12], C0[13]);    mx0 = MX3(mx0, C0[14], C0[15]); mx1 = MX3(mx1, C1[0], C1[1]);   PIN(mx0); PIN(mx1); SBAR();
  o[0] = MFMA32(pa2, PKF(fa.l2, fa.h2), o[0]); mx0 = MX3(mx0, C1[2], C1[3]);      mx1 = MX3(mx1, C1[4], C1[5]);      mx0 = MX3(mx0, C1[6], C1[7]);   mx1 = MX3(mx1, C1[8], C1[9]);   PIN(mx0); PIN(mx1); SBAR();
  o[0] = MFMA32(pa3, PKF(fa.l3, fa.h3), o[0]); mx0 = MX3(mx0, C1[10], C1[11]);    mx1 = MX3(mx1, C1[12], C1[13]);    mx0 = MX3(mx0, C1[14], C1[15]); float pmax = fmaxf(mx0, mx1);
  { auto rr = __builtin_amdgcn_permlane32_swap(__float_as_uint(pmax), __float_as_uint(pmax), false, false); pmax = fmaxf(__uint_as_float(rr[0]), __uint_as_float(rr[1])); } PIN(pmax); SBAR();
  rdg<BASE, 2>(fa, vb); SBAR();
  if (__builtin_expect(__all(pmax <= THR * 1.4426950408889634f), 1)) { alpha = 1.f; }
  else { const float d = fmaxf(pmax, 0.f); alpha = __builtin_amdgcn_exp2f(-d); m_reg += d;
    for (int r = 0; r < 16; ++r) { C0[r] -= d; C1[r] -= d; }
    for (int r = 0; r < 16; ++r) nm[r] = -m_reg; }
  SBAR();
#define EX2(C, i) C[i] = __builtin_amdgcn_exp2f(C[i]); C[i + 1] = __builtin_amdgcn_exp2f(C[i + 1]); PIN(C); SBAR()
  o[1] = MFMA32(pa0, PKF(fb.l0, fb.h0), o[1]); EX2(C0, 0);
  o[1] = MFMA32(pa1, PKF(fb.l1, fb.h1), o[1]); EX2(C0, 2);
  o[1] = MFMA32(pa2, PKF(fb.l2, fb.h2), o[1]); EX2(C0, 4);
  o[1] = MFMA32(pa3, PKF(fb.l3, fb.h3), o[1]); EX2(C0, 6);
  rdg<BASE, 3>(fb, vb); KLDP(ka, KSN, 0); KLDP(kb, KSN, 1); SBAR();
  o[2] = MFMA32(pa0, PKF(fa.l0, fa.h0), o[2]); EX2(C0, 8);
  o[2] = MFMA32(pa1, PKF(fa.l1, fa.h1), o[2]); EX2(C0, 10);
  o[2] = MFMA32(pa2, PKF(fa.l2, fa.h2), o[2]); EX2(C0, 12);
  o[2] = MFMA32(pa3, PKF(fa.l3, fa.h3), o[2]); EX2(C0, 14);
  o[3] = MFMA32(pa0, PKF(fb.l0, fb.h0), o[3]); EX2(C1, 0);
  o[3] = MFMA32(pa1, PKF(fb.l1, fb.h1), o[3]); EX2(C1, 2);
  o[3] = MFMA32(pa2, PKF(fb.l2, fb.h2), o[3]); EX2(C1, 4);
  o[3] = MFMA32(pa3, PKF(fb.l3, fb.h3), o[3]); EX2(C1, 6);
#undef EX2
}
template <int MODE>
__device__ __forceinline__ void attn_body(const bf16* __restrict__ Qb, const bf16* __restrict__ Kh, const bf16* __restrict__ Vh, bf16* __restrict__ Ob, int NT, char* lds, const Par P, const int tid) {
  static_assert(MODE == 0, "dense only");
  const int wid = __builtin_amdgcn_readfirstlane(tid >> 6), lane = tid & 63, r32 = lane & 31, hi = lane >> 5;
  float* ws = (float*)(lds + GA_WS) + wid * 64; float* li_l = ws; float* al_l = ws + 32;
  float m_reg = 0.f, l_reg = 0; f32x16 nm = {}; f32x16 o[4] = {}; bf16x8 qr[8];
  unsigned kof0, kof1, vof0, vof1;
  { const int rw0 = wid * 8 + (lane >> 4), rw1 = rw0 + 4; kof0 = (unsigned)(rw0 * LDK * 2 + (((lane & 15) ^ (rw0 & 7)) << 4)); kof1 = (unsigned)(rw1 * LDK * 2 + (((lane & 15) ^ (rw1 & 7)) << 4));
    const int s0 = wid * 4 + (lane >> 5), s1 = s0 + 2, kl = (lane & 31) >> 2, cl = (lane & 3) * 8;
    const int kk0 = (s0 >> 2) * 8 + kl, kk1 = (s1 >> 2) * 8 + kl, k0 = (kk0 & ~0xC) | ((kk0 & 4) << 1) | ((kk0 & 8) >> 1), k1 = (kk1 & ~0xC) | ((kk1 & 4) << 1) | ((kk1 & 8) >> 1);
    vof0 = (unsigned)(k0 * LDK * 2 + ((s0 & 3) * 32 + cl) * 2); vof1 = (unsigned)(k1 * LDK * 2 + ((s1 & 3) * 32 + cl) * 2); }
  const unsigned lds0 = (unsigned)(uintptr_t)lds;
  const unsigned kdst = (unsigned)__builtin_amdgcn_readfirstlane((int)(lds0 + GA_K + wid * 2048)), vdst = (unsigned)__builtin_amdgcn_readfirstlane((int)(lds0 + GA_V + wid * 2048));
#define DMA_K(t, slot) do { const char* g_ = (const char*)Kh + (size_t)(t) * (KVBLK * LDK * 2); glds16(g_, kof0, kdst + (slot) * GA_SLOT); glds16(g_, kof1, kdst + (slot) * GA_SLOT + 1024); } while (0)
#define DMA_V(t, slot) do { const char* g_ = (const char*)Vh + (size_t)(t) * (KVBLK * LDK * 2); glds16(g_, vof0, vdst + (slot) * GA_SLOT); glds16(g_, vof1, vdst + (slot) * GA_SLOT + 1024); } while (0)
#define WAIT_BAR(N) asm volatile("s_waitcnt vmcnt(" #N ") lgkmcnt(0)\n\ts_barrier" ::: "memory")
  DMA_K(0, 0); DMA_V(0, 0); DMA_K(1, 1); DMA_K(2, 2); DMA_V(1, 1); DMA_K(3, 3); DMA_V(2, 2);
  const unsigned qoff = (unsigned)((wid * QBLK + r32) * LDQ + hi * 8) * 2u;
  load_q<true>(qr, (const char*)Qb + qoff, P, wid * QBLK + r32, hi);
  const lds_ptr vb0 = (lds_ptr)(lds + GA_V) + v_rd_base(lane);
  lds_ptr kq[4];
#pragma unroll
  for (int i = 0; i < 4; ++i) kq[i] = (lds_ptr)(lds + GA_K) + KSWZ(r32, i * 32 + hi * 16);
  KF ka, kb;
#define RESC(a) do { if (__any((a) < 1.f)) { if (hi == 0) al_l[r32] = (a); asm volatile("s_waitcnt lgkmcnt(0)" ::: "memory"); \
    for (int d = 0; d < 4; ++d) for (int r = 0; r < 16; ++r) o[d][r] *= al_l[crow(r, hi)]; } } while (0)
  f32x16 pA0, pA1, pB0, pB1; float alA, alB; bf16x8 pa0, pa1, pa2, pa3;
#define STEP(C0, C1, AC, P0, P1, AP, j, KS, VS, DK, DV, CLAMP) do { \
    SBAR(); qk_softmax<KS>(C0, C1, ka, kb, kq, qr, nm, P0, P1, AP, l_reg, pa0, pa1, pa2, pa3); \
    { int tk = (j) + 3, tv = (j) + 2; if (CLAMP) { tk = tk < NT - 1 ? tk : NT - 1; tv = tv < NT - 1 ? tv : NT - 1; } DMA_K(tk, DK); DMA_V(tv, DV); } SBAR(); \
    pv_softmax<(VS) * GA_SLOT, ((KS) + 1) & 3>(o, vb0, pa0, pa1, pa2, pa3, C0, C1, m_reg, nm, AC, ka, kb, kq); \
    RESC(AC); WAIT_BAR(6); } while (0)
  WAIT_BAR(0);
  qkt_rel(pA0, pA1, (const bf16*)(lds + GA_K), qr, r32, hi, nm); partialSM_rel<true>(pA0, pA1, m_reg, nm, alA);
  KLDP(ka, 1, 0); KLDP(kb, 1, 1);
  WAIT_BAR(6);
  int j = 1;
  for (; j + 6 < NT; j += 4) {
    STEP(pB0, pB1, alB, pA0, pA1, alA, j,     1, 0, 0, 3, false);
    STEP(pA0, pA1, alA, pB0, pB1, alB, j + 1, 2, 1, 1, 0, false);
    STEP(pB0, pB1, alB, pA0, pA1, alA, j + 2, 3, 2, 2, 1, false);
    STEP(pA0, pA1, alA, pB0, pB1, alB, j + 3, 0, 3, 3, 2, false);
  }
  STEP(pB0, pB1, alB, pA0, pA1, alA, j,     1, 0, 0, 3, true);
  STEP(pA0, pA1, alA, pB0, pB1, alB, j + 1, 2, 1, 1, 0, true);
  STEP(pB0, pB1, alB, pA0, pA1, alA, j + 2, 3, 2, 2, 1, true);
  finishSM<8>(pB0, pB1, alB, l_reg, pa0, pa1, pa2, pa3); SBAR();
  pv_d0B<3 * GA_SLOT>(o, vb0, pa0, pa1, pa2, pa3);
  asm volatile("s_waitcnt vmcnt(0)" ::: "memory");
  if (hi == 0) li_l[r32] = l_reg; asm volatile("s_waitcnt lgkmcnt(0)" ::: "memory");
  float rli[16];
#pragma unroll
  for (int r = 0; r < 16; ++r) rli[r] = __builtin_amdgcn_rcpf(li_l[crow(r, hi)]);
  const unsigned ooff = (unsigned)((wid * QBLK + 4 * hi) * LDO + r32) * 2u;
#pragma unroll
  for (int r = 0; r < 16; ++r) { const int orow0 = (r & 3) + 8 * (r >> 2);
#pragma unroll
    for (int d0 = 0; d0 < 4; ++d0) *reinterpret_cast<bf16*>((char*)Ob + ooff + (unsigned)(orow0 * LDO + d0 * 32) * 2u) = (bf16)(cvtpk(o[d0][r] * rli[r], 0.f) & 0xffffu); }
  asm volatile("s_waitcnt lgkmcnt(0)\n\ts_barrier" ::: "memory");
#undef DMA_K
#undef DMA_V
#undef WAIT_BAR
#undef RESC
#undef STEP
}
__device__ __forceinline__ float sum16_dpp(float v) {
  v += __int_as_float(__builtin_amdgcn_update_dpp(0, __float_as_int(v), 0xB1, 0xF, 0xF, true));
  v += __int_as_float(__builtin_amdgcn_update_dpp(0, __float_as_int(v), 0x4E, 0xF, 0xF, true));
  v += __int_as_float(__builtin_amdgcn_update_dpp(0, __float_as_int(v), 0x141, 0xF, 0xF, true));
  v += __int_as_float(__builtin_amdgcn_update_dpp(0, __float_as_int(v), 0x140, 0xF, 0xF, true));
  return v;
}
__device__ __forceinline__ bf16x8 knorm8(bf16x8 raw, const float (&g)[8]) {
  float x[8]; float ss = 0.f;
#pragma unroll
  for (int e = 0; e < 8; ++e) { x[e] = __uint_as_float(((unsigned)(unsigned short)raw[e]) << 16); ss += x[e] * x[e]; }
  const float rstd = __builtin_amdgcn_rsqf(sum16_dpp(ss) * (1.0f / 128.0f) + 1e-6f);
  u32x4 w = {cvtpk(x[0] * (rstd * g[0]), x[1] * (rstd * g[1])), cvtpk(x[2] * (rstd * g[2]), x[3] * (rstd * g[3])), cvtpk(x[4] * (rstd * g[4]), x[5] * (rstd * g[5])), cvtpk(x[6] * (rstd * g[6]), x[7] * (rstd * g[7]))};
  return *reinterpret_cast<bf16x8*>(&w);
}
template <int MODE>
__device__ __forceinline__ void attn_body_simple(const bf16* __restrict__ Qb, const bf16* __restrict__ Kh, const bf16* __restrict__ Vh, bf16* __restrict__ Ob, int NT, char* lds, const Par P, const int tid) {
  const int wid = __builtin_amdgcn_readfirstlane(tid >> 6), lane = tid & 63, r32 = lane & 31, hi = lane >> 5;
  char* V_lds = lds; char* K_lds = lds + 2 * SHM_V;
  float* ws = (float*)(lds + 2 * SHM_V + 2 * SHM_K) + wid * 64; float* li_l = ws; float* al_l = ws + 32;
  const float* tbl = (const float*)(lds + TBL_OFF);
  float m_reg = NEG, l_reg = 0; f32x16 o[4] = {}; bf16x8 qr[8];
  const unsigned qoff = (unsigned)((wid * QBLK + r32) * LDQ + hi * 8) * 2u;
  load_q<false>(qr, (const char*)Qb + qoff, P, wid * QBLK + r32, hi);
  const int sr = tid >> 4, sc = (tid & 15) * 8, vst0 = v_st(sr, sc), vst1 = v_st(32 + sr, sc), kst0 = KSWZ(sr, sc * 2), kst1 = KSWZ(32 + sr, sc * 2);
  const unsigned kvo0 = (unsigned)(sr * LDK + sc) * 2u, kvo1 = kvo0 + (unsigned)(32 * LDK * 2);
  const int vb0 = (int)(uintptr_t)V_lds + v_rd_base(lane);
  bf16x8 vs0, vs1, ks0, ks1; float gk[8];
  { const float* gp = P.gk + sc;
#pragma unroll
    for (int e = 0; e < 8; ++e) gk[e] = gp[e]; }
#define SLD(k0) do { const char* vp_ = (const char*)Vh + (size_t)(k0) * (LDK * 2); const char* kp_ = (const char*)Kh + (size_t)(k0) * (LDK * 2); \
    vs0 = *reinterpret_cast<const bf16x8*>(vp_ + kvo0); vs1 = *reinterpret_cast<const bf16x8*>(vp_ + kvo1); ks0 = *reinterpret_cast<const bf16x8*>(kp_ + kvo0); ks1 = *reinterpret_cast<const bf16x8*>(kp_ + kvo1); } while (0)
  SLD(0);
  for (int jt = 0; jt < NT; ++jt) {
    const int b = jt & 1; char* Vb = V_lds + b * SHM_V; char* Kb = K_lds + b * SHM_K;
    *(bf16x8*)(Vb + vst0) = vs0; *(bf16x8*)(Vb + vst1) = vs1; *(bf16x8*)(Kb + kst0) = knorm8(ks0, gk); *(bf16x8*)(Kb + kst1) = knorm8(ks1, gk);
    if (jt + 1 < NT) SLD((jt + 1) * KVBLK);
    __syncthreads();
    bool need;
    if constexpr (MODE == 1) { const int kb = P.kpos0 + 64 * jt, qlo = P.qpos0 + wid * 32; need = (kb + 63 >= qlo - 128) && (kb <= qlo + 31 + 128); }
    else { const int r = P.r0 + (wid >> 1); int rs = r - 4; rs = rs < 0 ? 0 : rs; rs = rs > P.rows - 8 ? P.rows - 8 : rs; need = (unsigned)(P.kr0 + jt - rs) < 8u; }
    if (!need) continue;
    f32x16 p0, p1; float mn, alpha; bf16x8 pa0, pa1, pa2, pa3;
    qkt(p0, p1, (const bf16*)Kb, qr, r32, hi); modify<MODE>(p0, p1, jt, P, wid, r32, hi, tbl);
    partialSM(p0, p1, m_reg, mn, alpha);
    if (__any(alpha < 1.f)) { if (hi == 0) al_l[r32] = alpha; asm volatile("s_waitcnt lgkmcnt(0)" ::: "memory");
      for (int d = 0; d < 4; ++d) for (int r = 0; r < 16; ++r) o[d][r] *= al_l[crow(r, hi)]; }
    finishSM(p0, p1, alpha, l_reg, pa0, pa1, pa2, pa3);
    pv_d0(o, vb0 + b * (int)SHM_V, pa0, pa1, pa2, pa3);
  }
  if constexpr (MODE == 1) l_reg += __builtin_amdgcn_exp2f((P.sinkR - m_reg) * (SCALE * 1.4426950408889634f));
  if (hi == 0) li_l[r32] = l_reg; asm volatile("s_waitcnt lgkmcnt(0)" ::: "memory");
  float rli[16];
#pragma unroll
  for (int r = 0; r < 16; ++r) rli[r] = __builtin_amdgcn_rcpf(li_l[crow(r, hi)]);
  const unsigned ooff = (unsigned)((wid * QBLK + 4 * hi) * LDO + r32) * 2u;
#pragma unroll
  for (int r = 0; r < 16; ++r) { const int orow0 = (r & 3) + 8 * (r >> 2);
#pragma unroll
    for (int d0 = 0; d0 < 4; ++d0) *reinterpret_cast<bf16*>((char*)Ob + ooff + (unsigned)(orow0 * LDO + d0 * 32) * 2u) = (bf16)(cvtpk(o[d0][r] * rli[r], 0.f) & 0xffffu); }
  __syncthreads();
#undef SLD
}
#undef KSWZ
#undef SBAR
#undef MX3
#undef PIN
#undef PKF
#undef MFMA32
#undef KLDP
}

constexpr int NWAVES = 8;
constexpr int DM = 2048, DFF = 5632, DIN = 6144, HD = 128, NLAYER = 2;
constexpr int MTOT = 65536, MC = 32768, NCHUNK = 2;
constexpr float EPS = 1e-6f;
constexpr int C_QA = 0, C_KA = 1024, C_VA = 2048, C_QB = 3072, C_KB = 4096, C_VB = 4352, C_QC = 4608, C_KC = 5632, C_VC = 5888;
constexpr size_t MiB = 1u << 20;
constexpr size_t WS_CTL = 0, CTL_ZERO_BYTES = 1 * MiB;
constexpr size_t WS_ROPE = 1 * MiB;
constexpr size_t WS_W = 2 * MiB;
constexpr size_t W13_BYTES = (size_t)2 * DFF * DM * 2, WD_BYTES = (size_t)DM * DFF * 2, WIN_BYTES = (size_t)DIN * DM * 2, WGATE_BYTES = (size_t)3 * DM * DM * 2,
                 WBR_BYTES = (size_t)3 * DM * 1024 * 2, WOUT3_BYTES = (size_t)DM * DM * 2;
constexpr size_t LW_W13_1 = 0, LW_WD_1 = LW_W13_1 + W13_BYTES, LW_WIN = LW_WD_1 + WD_BYTES, LW_WGATE = LW_WIN + WIN_BYTES, LW_WBR = LW_WGATE + WGATE_BYTES,
                 LW_WOUT3 = LW_WBR + WBR_BYTES, LW_W13_2 = LW_WOUT3 + WOUT3_BYTES, LW_WD_2 = LW_W13_2 + W13_BYTES, LAYER_W_BYTES = LW_WD_2 + WD_BYTES;
constexpr size_t WS_H = WS_W + NLAYER * LAYER_W_BYTES;
constexpr size_t WS_QKV = WS_H + (size_t)MC * DM * 2;
constexpr size_t WS_BB = WS_QKV;
constexpr size_t WS_O = WS_QKV + (size_t)MC * DIN * 2;
constexpr size_t WS_MRG = WS_O;
constexpr size_t WS_SSQ = WS_O + (size_t)MC * 3072 * 2;
constexpr size_t WS_SCR = WS_SSQ + (size_t)MC * 32 * 4;
constexpr size_t WS_END = WS_SCR + (size_t)304 * 262144;
static_assert(LAYER_W_BYTES % 256 == 0 && WS_H % 256 == 0, "ws map alignment");
constexpr int CW_BAR = 4096;
constexpr int RING_OFF = 0, RING_BYTES = 131072;
constexpr int LDSCTL_OFF = RING_BYTES, MISC_OFF = LDSCTL_OFF + 320, RTAB_OFF = LDSCTL_OFF + 1024;
constexpr int LDS_BYTES = 147456;
static_assert(RING_OFF == 0 && att::GA_WS >= RTAB_OFF + 2048 && att::GA_WS + att::NW * 256 <= LDS_BYTES && att::GA_V + 4 * att::GA_SLOT <= RING_BYTES, "the dense attention rings fill the stage ring; its per-wave scratch sits behind the row-scale tables");

#define GAS __attribute__((address_space(1)))
#define LAS __attribute__((address_space(3)))
typedef unsigned short bf16;
typedef unsigned v4u __attribute__((ext_vector_type(4)));
typedef unsigned v2u __attribute__((ext_vector_type(2)));
typedef float f32x4 __attribute__((ext_vector_type(4)));
typedef GAS unsigned gu32;
#define LDS_WAIT() asm volatile("s_waitcnt lgkmcnt(0)" ::: "memory")
#define VM_WAIT() asm volatile("s_waitcnt vmcnt(0)" ::: "memory")
__device__ __forceinline__ unsigned f2bf(float f) { unsigned u = __builtin_bit_cast(unsigned, f); return (u + 0x7fffu + ((u >> 16) & 1u)) >> 16; }
__device__ __forceinline__ unsigned pk2(float lo, float hi) { return f2bf(lo) | (f2bf(hi) << 16); }

__device__ __forceinline__ int launder_s(int x) { asm volatile("" : "+s"(x)); return x; }
__device__ __forceinline__ int launder_v(int x) { asm volatile("" : "+v"(x)); return x; }
__device__ __forceinline__ int lane_id_local() { unsigned m = ~0u; asm volatile("" : "+s"(m)); return (int)__builtin_amdgcn_mbcnt_hi(m, __builtin_amdgcn_mbcnt_lo(m, 0u)); }

#define XB_TMO      128
#define XB_XCNT(j)  (256  + 64 * (j))
#define XB_XSUB(j)  (1280 + 64 * (j))
#define XB_XGEN(j)  (2304 + 64 * (j))
#define XB_TOP      3328
#define XB_TOPGEN   3392
#define XCD_BAR_WORDS 3456
#define XB_SPIN_CAP (1u << 22)

__device__ __forceinline__ unsigned xb_ld(unsigned* p)              { return __hip_atomic_load(p, __ATOMIC_RELAXED, __HIP_MEMORY_SCOPE_AGENT); }
__device__ __forceinline__ unsigned xb_add(unsigned* p, unsigned v) { return __hip_atomic_fetch_add(p, v, __ATOMIC_RELAXED, __HIP_MEMORY_SCOPE_AGENT); }
__device__ __forceinline__ unsigned xb_xcc_id() { return (unsigned)__builtin_amdgcn_s_getreg((3 << 11) | 20) & 0xFu; }
#define XB_SPIN(cond, bar) do { unsigned _sp = 0; while (cond) { __builtin_amdgcn_s_sleep(1); \
    if ((++_sp & 255u) == 0u) { if (xb_ld(&(bar)[XB_TMO])) break; if (_sp > XB_SPIN_CAP) { atomicAdd(&(bar)[XB_TMO], 1u); break; } } } } while (0)

struct XcdBarrier { unsigned* bar; unsigned x; volatile LAS unsigned* st; };

__device__ __forceinline__ XcdBarrier xcd_barrier_post(unsigned* bar, volatile LAS unsigned* st) {
    XcdBarrier b; b.bar = bar; b.x = xb_xcc_id(); b.st = st;
    if (threadIdx.x == 0) (void)xb_add(&bar[XB_XCNT(b.x)], 1u);
    return b;
}
__device__ __forceinline__ void xcd_barrier_complete(unsigned* bar, unsigned x, unsigned& nloc, unsigned& nx) {
    const unsigned G = gridDim.x * gridDim.y * gridDim.z;
    unsigned sum, cnt, mine, sp = 0u;
    for (;;) {
        sum = 0u; cnt = 0u; mine = 0u;
#pragma unroll
        for (unsigned j = 0; j < 16; ++j) { const unsigned c = xb_ld(&bar[XB_XCNT(j)]); sum += c; cnt += (c > 0u) ? 1u : 0u; mine = (j == x) ? c : mine; }
        if (sum == G) break;
        __builtin_amdgcn_s_sleep(1);
        if ((++sp & 255u) == 0u) { if (xb_ld(&bar[XB_TMO])) break; if (sp > XB_SPIN_CAP) { atomicAdd(&bar[XB_TMO], 1u); break; } }
    }
    nloc = mine > 0u ? mine : 1u; nx = cnt > 0u ? cnt : 1u;
}
__device__ __forceinline__ void xcd_barrier(const XcdBarrier& b, const int wave_s) {
    asm volatile("s_waitcnt vmcnt(0)" ::: "memory");
    __syncthreads();
    if (launder_s(wave_s) == 0 && lane_id_local() == 0) {
        unsigned* bar = b.bar; unsigned bx_ = b.x; asm volatile("" : "+s"(bar), "+s"(bx_));
        __builtin_amdgcn_s_waitcnt(0);
        unsigned nloc = b.st[0], nx = b.st[1];
        if (nloc == 0u) { xcd_barrier_complete(bar, bx_, nloc, nx); b.st[0] = nloc; b.st[1] = nx; }
        const unsigned old = xb_add(&bar[XB_XSUB(bx_)], 1u);
        const unsigned gen = old / nloc;
        if (old + 1u == (gen + 1u) * nloc) {
            __builtin_amdgcn_fence(__ATOMIC_RELEASE, "agent");
            asm volatile("s_waitcnt vmcnt(0)" ::: "memory");
            const unsigned og = xb_add(&bar[XB_TOP], 1u);
            const unsigned tg = og / nx;
            if (og + 1u == (tg + 1u) * nx) xb_add(&bar[XB_TOPGEN], 1u);
            else XB_SPIN(xb_ld(&bar[XB_TOPGEN]) == tg, bar);
            __builtin_amdgcn_fence(__ATOMIC_ACQUIRE, "agent");
            xb_add(&bar[XB_XGEN(bx_)], 1u);
            asm volatile("s_waitcnt vmcnt(0)" ::: "memory");
        } else {
            XB_SPIN(xb_ld(&bar[XB_XGEN(bx_)]) == gen, bar);
            __builtin_amdgcn_fence(__ATOMIC_ACQUIRE, "agent");
            asm volatile("s_waitcnt vmcnt(0)" ::: "memory");
        }
    }
    __syncthreads();
}

using pg8::shx;
__device__ __forceinline__ float wave_sum(float v, int lane) {
#pragma unroll
    for (int o = 1; o < 64; o <<= 1) v += shx(v, o, lane);
    return v;
}
__device__ __forceinline__ void row_to_xb(const float* xrow, bf16* orow, float* ssqrow, int lane) {
    const GAS f32x4* xr = (const GAS f32x4*)xrow + lane;
    f32x4 v[8]; float s = 0.f;
#pragma unroll
    for (int j = 0; j < 8; ++j) { v[j] = xr[64 * j]; s += (v[j].x * v[j].x + v[j].y * v[j].y) + (v[j].z * v[j].z + v[j].w * v[j].w); }
    s = wave_sum(s, lane);
    GAS v2u* o8 = (GAS v2u*)orow + lane;
#pragma unroll
    for (int j = 0; j < 8; ++j) { v2u w; w.x = pk2(v[j].x, v[j].y); w.y = pk2(v[j].z, v[j].w); o8[64 * j] = w; }
    if (lane < pg8::NSSQ) ssqrow[lane] = lane == 0 ? s : 0.f;
}

__device__ __forceinline__ void convert_item(const float* W, int K, int N, bf16* dst, int ldd, int mode, const float* gain, int item, int lane) {
    const int nb = N >> 8, kb = item / nb, n0 = ((item - kb * nb) << 8) + 4 * lane, k0 = 32 * kb;
    bf16* dp;
    if (mode == 2) dp = dst + (((size_t)(n0 >> 8) * (K >> 6) + (k0 >> 6)) * 256 + (n0 & 255)) * 64 + (k0 & 63);
    else dp = dst + (size_t)(mode ? ((n0 >> 7) * 256 + (n0 & 127)) : n0) * ldd + k0;
    const int rp = (mode == 2) ? 64 : ldd;
#pragma unroll 1
    for (int t8 = 0; t8 < 4; ++t8) {
        f32x4 v[8];
#pragma unroll
        for (int t = 0; t < 8; ++t) { const int k = k0 + 8 * t8 + t; const float gk = gain ? gain[k] : 1.0f; v[t] = *(const GAS f32x4*)(W + (size_t)k * N + n0) * gk; }
#pragma unroll
        for (int e = 0; e < 4; ++e) { v4u o; o.x = pk2(v[0][e], v[1][e]); o.y = pk2(v[2][e], v[3][e]); o.z = pk2(v[4][e], v[5][e]); o.w = pk2(v[6][e], v[7][e]);
            *(GAS v4u*)(dp + (size_t)e * rp + 8 * t8) = o; }
    }
}

struct Args { const float* in[23]; float* out; unsigned char* ws; int ph_lo, ph_hi, pad0, pad1; };
constexpr int NPH_PER = 13, NPHASE = 1 + NCHUNK * NLAYER * NPH_PER;
typedef const __attribute__((address_space(4))) Args* KArgs;
__device__ __forceinline__ KArgs kargs() { unsigned long long p = (unsigned long long)__builtin_amdgcn_kernarg_segment_ptr(); asm volatile("" : "+s"(p)); return (KArgs)p; }

__device__ __forceinline__ void convert_flat(KArgs ap, unsigned char* ws, int g, int lane) {
    const int l = g / 12800; int r = g - l * 12800;
    unsigned char* wl = ws + WS_W + (size_t)l * LAYER_W_BYTES;
    const float* g1 = ap->in[2] + l * DM; const float* gm = ap->in[6] + l * DM; const float* g2 = ap->in[19] + l * DM;
    if (r < 1408) { convert_item(ap->in[3] + (size_t)l * DM * DFF, DM, DFF, (bf16*)(wl + LW_W13_1), DM, 1, g1, r, lane); return; } r -= 1408;
    if (r < 1408) { convert_item(ap->in[4] + (size_t)l * DM * DFF, DM, DFF, (bf16*)(wl + LW_W13_1) + (size_t)128 * DM, DM, 1, g1, r, lane); return; } r -= 1408;
    if (r < 1408) { convert_item(ap->in[5] + (size_t)l * DFF * DM, DFF, DM, (bf16*)(wl + LW_WD_1), DFF, 2, nullptr, r, lane); return; } r -= 1408;
    if (r < 1536) { convert_item(ap->in[7] + (size_t)l * DM * DIN, DM, DIN, (bf16*)(wl + LW_WIN), DM, 0, gm, r, lane); return; } r -= 1536;
    if (r < 1536) { const int i = r / 512; convert_item(ap->in[8] + (size_t)(l * 3 + i) * DM * DM, DM, DM, (bf16*)(wl + LW_WGATE) + (size_t)i * DM * DM, DM, 0, gm, r - 512 * i, lane); return; } r -= 1536;
    if (r < 768) { const int i = r / 256; convert_item(ap->in[17] + (size_t)(l * 3 + i) * 1024 * DM, 1024, DM, (bf16*)(wl + LW_WBR) + (size_t)i * DM * 1024, 1024, 0, nullptr, r - 256 * i, lane); return; } r -= 768;
    if (r < 512) { convert_item(ap->in[18] + (size_t)l * DM * DM, DM, DM, (bf16*)(wl + LW_WOUT3), DM, 0, nullptr, r, lane); return; } r -= 512;
    if (r < 1408) { convert_item(ap->in[20] + (size_t)l * DM * DFF, DM, DFF, (bf16*)(wl + LW_W13_2), DM, 1, g2, r, lane); return; } r -= 1408;
    if (r < 1408) { convert_item(ap->in[21] + (size_t)l * DM * DFF, DM, DFF, (bf16*)(wl + LW_W13_2) + (size_t)128 * DM, DM, 1, g2, r, lane); return; } r -= 1408;
    convert_item(ap->in[22] + (size_t)l * DFF * DM, DFF, DM, (bf16*)(wl + LW_WD_2), DFF, 2, nullptr, r, lane);
}
#define PH_PRE \
    const int wave = launder_s(wave_s); const int lane = lane_id_local(); const int tid = wave * 64 + lane; (void)lane; (void)wave; \
    const KArgs ap = kargs(); const int bx = launder_s((int)blockIdx.x), G = launder_s((int)gridDim.x); \
    const int vcu = (G % 8 == 0) ? (bx % 8) * (G / 8) + bx / 8 : bx; const int gw = vcu * NWAVES + wave, NGW = G * NWAVES; (void)gw; (void)NGW; \
    unsigned char* const ws = ap->ws; (void)ws;
#define PH_PRE_CL \
    PH_PRE \
    const int c2 = launder_s(cl); const int chunk = c2 >> 1, layer = c2 & 1; (void)chunk; (void)layer; \
    const int S = chunk < 1 ? 8192 : 4096; (void)S; \
    float* const xo = ap->out + (size_t)chunk * MC * DM; (void)xo; \
    unsigned char* const wl = ws + WS_W + (size_t)layer * LAYER_W_BYTES; (void)wl; \
    float* const SSQ = (float*)(ws + WS_SSQ); (void)SSQ; bf16* const Hb = (bf16*)(ws + WS_H); bf16* const QKV = (bf16*)(ws + WS_QKV); bf16* const BB = (bf16*)(ws + WS_BB); bf16* const Ob = (bf16*)(ws + WS_O); (void)Hb; (void)QKV; (void)BB; (void)Ob;
#define XIN_PTR (chunk < 1 ? ap->in[0] : ap->in[1])

__global__ void __launch_bounds__(NWAVES * 64, 2) mk_fwd(Args args) {
    extern __shared__ __attribute__((aligned(16))) unsigned char lds[];
    LAS unsigned char* const ldsL = (LAS unsigned char*)lds;
    volatile LAS unsigned* const MISC = (volatile LAS unsigned*)(ldsL + MISC_OFF);
    const int wave_s = __builtin_amdgcn_readfirstlane((int)threadIdx.x >> 6);
    for (int u = threadIdx.x; u < (LDS_BYTES - LDSCTL_OFF) / 4; u += NWAVES * 64) ((LAS unsigned*)(ldsL + LDSCTL_OFF))[u] = 0u;
    __syncthreads();
    XcdBarrier bar = xcd_barrier_post((unsigned*)((gu32*)(args.ws + WS_CTL) + CW_BAR), MISC + 8);
    const int lo = args.ph_lo, hi = args.ph_hi;
#define IN(k) (lo <= (k) && (k) < hi)
#define SEAM(k) do { if (IN(k) && IN((k) + 1)) xcd_barrier(bar, wave_s); } while (0)

    if (IN(0)) {
        PH_PRE
        for (int g = gw; g < NLAYER * 12800; g += NGW) convert_flat(ap, ws, g, lane);
        { float* rope = (float*)(ws + WS_ROPE); const int gt = bx * (NWAVES * 64) + tid;
          if (gt < 128 * 32) { const int pos = gt >> 5, j = gt & 31;
              double f = 1.0; for (int q = 0; q < j; ++q) f *= 0.74989420933245582730;
              const double x2 = f * f; double c = 1.0, s = f, tc = 1.0, ts = f;
              for (int n = 1; n <= 12; ++n) { tc *= -x2 / (double)((2 * n - 1) * (2 * n)); c += tc; ts *= -x2 / (double)((2 * n) * (2 * n + 1)); s += ts; }
              double cr = 1.0, si = 0.0; for (int q = 0; q < pos; ++q) { const double t = cr * c - si * s; si = cr * s + si * c; cr = t; }
              rope[2 * gt] = (float)cr; rope[2 * gt + 1] = (float)si; } }
    }
    SEAM(0);

    for (int cl = 0; cl < NCHUNK * NLAYER; ++cl) {
        const int pb = 1 + cl * NPH_PER;
        if (hi <= pb || lo >= pb + NPH_PER) continue;

        if (IN(pb + 0) && (cl & 1) == 0) { PH_PRE_CL const float* x0 = XIN_PTR;
            for (int m = gw; m < MC; m += NGW) row_to_xb(x0 + (size_t)m * DM, Hb + (size_t)m * DM, SSQ + (size_t)m * pg8::NSSQ, lane); }
        if ((cl & 1) == 0) SEAM(pb + 0);
        if (IN(pb + 1)) { PH_PRE_CL pg8::Gemm g{Hb, (const bf16*)(wl + LW_W13_1), MC, 2 * DFF, DM, DM, DM, 0, 0, 0, 0}; pg8::RsOrder So; So.init(MC, 2 * DFF, G, bx); So.ssq = SSQ; So.tab = (LAS float*)(ldsL + RTAB_OFF); So.inv_ncol = 1.0f / DM; So.eps = EPS; So.tid = tid;
            pg8::EpiSwiglu E{QKV, DFF, (const LAS float*)(ldsL + RTAB_OFF)}; pg8::gemm_phase<pg8::EpiSwiglu, pg8::RsOrder, true, true>(ldsL + RING_OFF, g, So, E, tid); }
        SEAM(pb + 1);
        if (IN(pb + 2)) { PH_PRE_CL
            pg8::Gemm g{QKV, (const bf16*)(wl + LW_WD_1), MC, DM, DFF, DFF, DFF, 0, 0, 1, 1}; pg8::StaticOrder So; So.init(MC, DM, G, bx);
            pg8::EpiResidX E{Hb, nullptr, SSQ, DM, 0.5f}; pg8::gemm_phase<pg8::EpiResidX, pg8::StaticOrder, true, true>(ldsL + RING_OFF, g, So, E, tid); }
        SEAM(pb + 2);
        if (IN(pb + 4)) { PH_PRE_CL pg8::Gemm g{Hb, (const bf16*)(wl + LW_WIN), MC, DIN, DM, DM, DM, 0, 0, 0, 0}; pg8::RsOrder So; So.init(MC, DIN, G, bx); So.ssq = SSQ; So.tab = (LAS float*)(ldsL + RTAB_OFF); So.inv_ncol = 1.0f / DM; So.eps = EPS; So.tid = tid;
            pg8::EpiBf16 E{QKV, DIN, (const LAS float*)(ldsL + RTAB_OFF)}; pg8::gemm_phase<pg8::EpiBf16, pg8::RsOrder, true, true>(ldsL + RING_OFF, g, So, E, tid); }
        SEAM(pb + 4);
        if (IN(pb + 5)) { PH_PRE_CL
            const float* rope = (const float*)(ws + WS_ROPE);
            const int sub = lane >> 4, t16 = lane & 15;
            for (int task = gw; task < MC / 2; task += NGW) {
                const int m = task * 2 + (sub >> 1), hidx = sub & 1;
                const int cb = 32 + hidx; const float* gp = ap->in[13] + layer * HD + 8 * t16;
                GAS v4u* p = (GAS v4u*)(QKV + (size_t)m * DIN + cb * 128 + 8 * t16);
                const v4u raw = *p;
                float x[8] = {pg8::bf_lo(raw.x), pg8::bf_hi(raw.x), pg8::bf_lo(raw.y), pg8::bf_hi(raw.y), pg8::bf_lo(raw.z), pg8::bf_hi(raw.z), pg8::bf_lo(raw.w), pg8::bf_hi(raw.w)};
                float ss = 0.f;
#pragma unroll
                for (int i = 0; i < 8; ++i) ss += x[i] * x[i];
                ss += shx(ss, 1, lane); ss += shx(ss, 2, lane); ss += shx(ss, 4, lane); ss += shx(ss, 8, lane);
                const float rstd = __builtin_amdgcn_rsqf(ss * (1.f / HD) + EPS);
                const f32x4 g0 = *(const GAS f32x4*)gp, g1 = *(const GAS f32x4*)(gp + 4);
                x[0] *= rstd * g0.x; x[1] *= rstd * g0.y; x[2] *= rstd * g0.z; x[3] *= rstd * g0.w; x[4] *= rstd * g1.x; x[5] *= rstd * g1.y; x[6] *= rstd * g1.z; x[7] *= rstd * g1.w;
                float y[8];
                { const int tpos = m % S, pos = (t16 & 8) ? (tpos & 63) : (tpos >> 6);
                    const bool first = (t16 & 4) == 0; const int j0 = 8 * (t16 & 3);
                    const GAS f32x4* rt = (const GAS f32x4*)(rope + ((size_t)pos * 32 + j0) * 2);
                    const f32x4 cs0 = rt[0], cs1 = rt[1], cs2 = rt[2], cs3 = rt[3];
                    const float cc[8] = {cs0.x, cs0.z, cs1.x, cs1.z, cs2.x, cs2.z, cs3.x, cs3.z}, sn[8] = {cs0.y, cs0.w, cs1.y, cs1.w, cs2.y, cs2.w, cs3.y, cs3.w};
#pragma unroll
                    for (int i = 0; i < 8; ++i) { const float other = shx(x[i], 4, lane); y[i] = x[i] * cc[i] + (first ? -other : other) * sn[i]; }
                }
                v4u w; w.x = pk2(y[0], y[1]); w.y = pk2(y[2], y[3]); w.z = pk2(y[4], y[5]); w.w = pk2(y[6], y[7]);
                *p = w;
            }
        }
        SEAM(pb + 5);
        if (IN(pb + 6)) {
          { PH_PRE_CL
            const int nqb = S / 256, nunit = MC / 256 * 8;
            for (int u = vcu; u < nunit; u += G) {
                const int qb = u % nqb, h = (u / nqb) % 8, sq = u / (nqb * 8); const int kvh = h >> 2;
                const size_t row0 = (size_t)sq * S;
                att::Par P{0, 0, 0, 0, 0, 0.f, 0.f, ap->in[12] + layer * HD, (const float*)(ws + WS_ROPE), qb * 256};
                att::attn_body<0>(QKV + (row0 + (size_t)qb * 256) * DIN + C_QB + h * 128, QKV + row0 * DIN + C_KB + kvh * 128, QKV + row0 * DIN + C_VB + kvh * 128,
                                  Ob + (row0 + (size_t)qb * 256) * 3072 + 1024 + h * 128, S / 64, (char*)lds + RING_OFF, P, launder_s(wave_s) * 64 + lane_id_local());
            } }
          { PH_PRE_CL
            const int rows = S / 64, nqb = S / 256, nunit = MC / 256 * 8;
            for (int u = vcu; u < nunit; u += G) {
                const int qb = u % nqb, h = (u / nqb) % 8, sq = u / (nqb * 8);
                const size_t row0 = (size_t)sq * S;
                int kr0 = qb * 4 - 4; kr0 = kr0 < 0 ? 0 : kr0; kr0 = kr0 > rows - 12 ? rows - 12 : kr0;
                { const float* rb = ap->in[11] + (size_t)(layer * 8 + h) * 465; float* tb = (float*)((char*)lds + RING_OFF + att::TBL_OFF);
                  if (tid < 480) { const int rr = tid >> 5, cc = tid & 31; tb[tid] = (cc < 31) ? rb[rr * 31 + cc] * (1.0f / att::SCALE) : att::NEG; } }
                att::Par P{0, 0, qb * 4, rows, kr0, 0.f, 0.f, ap->in[9] + layer * HD, nullptr, qb * 256, ap->in[10] + layer * HD};
                att::attn_body_simple<2>(QKV + (row0 + (size_t)qb * 256) * DIN + C_QA + h * 128, QKV + (row0 + (size_t)kr0 * 64) * DIN + C_KA + h * 128, QKV + (row0 + (size_t)kr0 * 64) * DIN + C_VA + h * 128,
                                  Ob + (row0 + (size_t)qb * 256) * 3072 + h * 128, 12, (char*)lds + RING_OFF, P, tid);
            } }
          { PH_PRE_CL
            const int nqb = S / 256, nunit = MC / 256 * 8;
            for (int u = vcu; u < nunit; u += G) {
                const int qb = u % nqb, h = (u / nqb) % 8, sq = u / (nqb * 8); const int kvh = h >> 2;
                const size_t row0 = (size_t)sq * S;
                int ks = qb * 256 - 128; ks = ks < 0 ? 0 : ks; ks = ks > S - 512 ? S - 512 : ks;
                const float slope = exp2f(-(float)(h + 1)), sink = ap->in[16][layer * 8 + h];
                att::Par P{qb * 256, ks, 0, 0, 0, slope * (1.0f / att::SCALE), sink * (1.0f / att::SCALE), ap->in[14] + layer * HD, nullptr, qb * 256, ap->in[15] + layer * HD};
                att::attn_body_simple<1>(QKV + (row0 + (size_t)qb * 256) * DIN + C_QC + h * 128, QKV + (row0 + (size_t)ks) * DIN + C_KC + kvh * 128, QKV + (row0 + (size_t)ks) * DIN + C_VC + kvh * 128,
                                  Ob + (row0 + (size_t)qb * 256) * 3072 + 2048 + h * 128, 8, (char*)lds + RING_OFF, P, tid);
            } }
        }
        SEAM(pb + 6);
        if (IN(pb + 7)) { PH_PRE_CL pg8::Gemm g{Ob, (const bf16*)(wl + LW_WBR), MC, DIN, 1024, 3072, 1024, 8, 1024, 0, 0}; pg8::StaticOrder So; So.init(MC, DIN, G, bx);
            pg8::EpiTileImg E{BB, DIN / 256, tid}; pg8::gemm_phase<pg8::EpiTileImg, pg8::StaticOrder, true, true>(ldsL + RING_OFF, g, So, E, tid); }
        SEAM(pb + 7);
        if (IN(pb + 8)) { PH_PRE_CL pg8::Gemm g{Hb, (const bf16*)(wl + LW_WGATE), MC, DIN, DM, DM, DM, 0, 0, 0, 0}; pg8::TriOrder So; So.init3(MC, DM, G, bx); So.ssq = SSQ; So.tab = (LAS float*)(ldsL + RTAB_OFF); So.inv_ncol = 1.0f / DM; So.eps = EPS; So.tid = tid;
            pg8::EpiGateAcc E{BB, DIN / 256, (float*)(ws + WS_SCR) + (size_t)bx * 65536, (bf16*)(ws + WS_MRG), DM, (const LAS float*)(ldsL + RTAB_OFF), tid, DM / 256};
            pg8::gemm_phase<pg8::EpiGateAcc, pg8::TriOrder, true, true>(ldsL + RING_OFF, g, So, E, tid); }
        SEAM(pb + 8);
        if (IN(pb + 9)) { PH_PRE_CL pg8::Gemm g{(const bf16*)(ws + WS_MRG), (const bf16*)(wl + LW_WOUT3), MC, DM, DM, DM, DM, 0, 0, 0, 0}; pg8::StaticOrder So; So.init(MC, DM, G, bx);
            pg8::EpiResidX E{Hb, nullptr, SSQ, DM, 1.0f}; pg8::gemm_phase<pg8::EpiResidX, pg8::StaticOrder, true, true>(ldsL + RING_OFF, g, So, E, tid); }
        SEAM(pb + 9);
        if (IN(pb + 11)) { PH_PRE_CL pg8::Gemm g{Hb, (const bf16*)(wl + LW_W13_2), MC, 2 * DFF, DM, DM, DM, 0, 0, 0, 0}; pg8::RsOrder So; So.init(MC, 2 * DFF, G, bx); So.ssq = SSQ; So.tab = (LAS float*)(ldsL + RTAB_OFF); So.inv_ncol = 1.0f / DM; So.eps = EPS; So.tid = tid;
            pg8::EpiSwiglu E{QKV, DFF, (const LAS float*)(ldsL + RTAB_OFF)}; pg8::gemm_phase<pg8::EpiSwiglu, pg8::RsOrder, true, true>(ldsL + RING_OFF, g, So, E, tid); }
        SEAM(pb + 11);
        if (IN(pb + 12)) { PH_PRE_CL pg8::Gemm g{QKV, (const bf16*)(wl + LW_WD_2), MC, DM, DFF, DFF, DFF, 0, 0, 1, 1}; pg8::StaticOrder So; So.init(MC, DM, G, bx);
            pg8::EpiResidX E{Hb, (layer == NLAYER - 1) ? xo : nullptr, SSQ, DM, 0.5f}; pg8::gemm_phase<pg8::EpiResidX, pg8::StaticOrder, true, true>(ldsL + RING_OFF, g, So, E, tid); }
        SEAM(pb + 12);
    }
#undef IN
#undef SEAM
}

extern "C" void kernel_launch(void* const* d_in, const int* in_sizes, int n_in, void* d_out, int out_size, void* d_ws, size_t ws_size, hipStream_t stream) {
    static int grid = 0;
    if (grid == 0) {
        if (n_in != 23 || out_size != MTOT * DM || ws_size < WS_END) { fprintf(stderr, "kernel_launch: unexpected shapes: n_in %d out %d ws %zu (need %zu)\n", n_in, out_size, ws_size, (size_t)WS_END); grid = -1; return; }
        int dev = 0, cus = 0, per_cu = 0;
        if (hipGetDevice(&dev) != hipSuccess || hipDeviceGetAttribute(&cus, hipDeviceAttributeMultiprocessorCount, dev) != hipSuccess) { grid = -1; return; }
        if (hipFuncSetAttribute((const void*)mk_fwd, hipFuncAttributeMaxDynamicSharedMemorySize, LDS_BYTES) != hipSuccess) { fprintf(stderr, "kernel_launch: hipFuncSetAttribute failed\n"); grid = -1; return; }
        if (hipOccupancyMaxActiveBlocksPerMultiprocessor(&per_cu, (const void*)mk_fwd, NWAVES * 64, LDS_BYTES) != hipSuccess || per_cu < 1)
            fprintf(stderr, "kernel_launch: occupancy query reports %d workgroups per CU\n", per_cu);
        (void)hipGetLastError();
        grid = cus > 304 ? 304 : cus;
    }
    if (grid < 0) return;
    if (hipMemsetAsync((char*)d_ws + WS_CTL, 0, CTL_ZERO_BYTES, stream) != hipSuccess) return;
    Args a{};
    for (int i = 0; i < 23; ++i) a.in[i] = (const float*)d_in[i];
    a.out = (float*)d_out; a.ws = (unsigned char*)d_ws;
#if MK_ONE_LAUNCH
    a.ph_lo = 0; a.ph_hi = NPHASE;
    hipLaunchKernelGGL(mk_fwd, dim3(grid), dim3(NWAVES * 64), LDS_BYTES, stream, a);
#else
    for (int p = 0; p < NPHASE; ++p) { a.ph_lo = p; a.ph_hi = p + 1; hipLaunchKernelGGL(mk_fwd, dim3(grid), dim3(NWAVES * 64), LDS_BYTES, stream, a); }
#endif
    const hipError_t le = hipPeekAtLastError();
    if (le != hipSuccess) fprintf(stderr, "kernel_launch: launch failed: %s\n", hipGetErrorName(le));
}
```

```cpp
#include <hip/hip_runtime.h>
#include <cstdio>
#include <cstdint>

#ifndef MK_ONE_LAUNCH
#define MK_ONE_LAUNCH 1
#endif

namespace pg8 {
#define PG8_LAS __attribute__((address_space(3)))
typedef unsigned short bf16_t;
typedef short bf16x8 __attribute__((ext_vector_type(8)));
typedef float f32x4 __attribute__((ext_vector_type(4)));
typedef unsigned u32x4 __attribute__((ext_vector_type(4)));
constexpr int BM = 256, BK = 64, HALF = 128, HTB = HALF * BK * 2  , STAGE_BYTES = 8 * HTB, NXCD = 8, WGM = 4;

__host__ __device__ __forceinline__ int lds_byte(int r, int c) { const int st = (r >> 4) * 2 + (c >> 5), rr = r & 15, cc = c & 31, ob = rr * 64 + cc * 2; return st * 1024 + (ob ^ (((ob >> 9) & 1) << 5)); }
__host__ __device__ __forceinline__ void stage_rc(int b, int& R, int& C) { const int st = b / 1024, sb = b % 1024, swz = sb ^ (((sb >> 9) & 1) << 5); R = (st >> 1) * 16 + swz / 64; C = (st & 1) * 32 + (swz % 64) / 2; }
__host__ __device__ __forceinline__ int perm32(int rho) { const int n = rho >> 4, i = rho & 15; return 8 * (i >> 2) + 4 * n + (i & 3); }

struct Unit { int pm, pn, slot, fill; };
struct Gemm { const bf16_t* A; const bf16_t* Bt; int M, N, K, lda, ldb, grp, grp_a, ablk, bblk; };

struct StaticOrder {
    int nM, nN, nwg, G, c;
    __host__ __device__ void init(int M, int N, int G_, int c_) { nM = M / BM; nN = N / BM; nwg = nM * nN; G = G_; c = c_; }
    __host__ __device__ bool next(int i, Unit& u) const {
        const long L = (long)i * G + c; if (L >= nwg) return false;
        int wgid = (int)L; { const int q = nwg / NXCD, r = nwg % NXCD, xcd = wgid % NXCD, off = wgid / NXCD; wgid = (xcd < r ? xcd * (q + 1) : r * (q + 1) + (xcd - r) * q) + off; }
        const int nig = WGM * nN, gid = wgid / nig, fm = gid * WGM, gsz = (nM - fm) < WGM ? (nM - fm) : WGM;
        u.pm = fm + ((wgid % nig) % gsz); u.pn = (wgid % nig) / gsz;
        int pg = -1; if (i > 0) { int w2 = (int)(L - G); { const int q = nwg / NXCD, r = nwg % NXCD, xcd = w2 % NXCD, off = w2 / NXCD; w2 = (xcd < r ? xcd * (q + 1) : r * (q + 1) + (xcd - r) * q) + off; } pg = w2 / nig; }
        u.slot = gid & 1; u.fill = (pg != gid) ? 1 : 0; return true;
    }
    __device__ __forceinline__ void a_ready(const Unit&) const {}
    __device__ __forceinline__ void done(const Unit&) const {}
};

struct RsOrder : StaticOrder {
    const float* ssq; PG8_LAS float* tab; float inv_ncol, eps; int tid;
    __device__ __forceinline__ void a_ready(const Unit& u) const {
        if (u.fill && tid < 256) {
            const f32x4* p = (const f32x4*)(ssq + (size_t)(u.pm * BM + tid) * 32); float s = 0.f;
#pragma unroll
            for (int j = 0; j < 8; ++j) { const f32x4 a = p[j]; s += (a[0] + a[1]) + (a[2] + a[3]); }
            tab[u.slot * 256 + tid] = __builtin_amdgcn_rsqf(s * inv_ncol + eps);
        }
    }
};
struct TriOrder : RsOrder {
    int nN3;
    __host__ __device__ void init3(int M, int N3, int G_, int c_) { init(M, N3, G_, c_); nN3 = N3 / BM; }
    __host__ __device__ bool next(int i, Unit& u) const {
        const int t = i / 3, sub = i - 3 * t;
        if (!StaticOrder::next(t, u)) return false;
        u.pn += nN3 * sub; if (sub) u.fill = 0; return true;
    }
};
typedef float f32x2_t __attribute__((ext_vector_type(2))); typedef __bf16 bf16x2_t __attribute__((ext_vector_type(2)));
__device__ __forceinline__ unsigned cvt_pk_bf16(float lo, float hi) { const f32x2_t v = {lo, hi}; return __builtin_bit_cast(unsigned, __builtin_convertvector(v, bf16x2_t)); }
__device__ __forceinline__ float bf_lo(unsigned w) { return __uint_as_float(w << 16); }
__device__ __forceinline__ float bf_hi(unsigned w) { return __uint_as_float(w & 0xffff0000u); }
__device__ __forceinline__ float sigmoid_f(float x) { return __builtin_amdgcn_rcpf(1.0f + __builtin_amdgcn_exp2f(-1.4426950408889634f * x)); }

__device__ __forceinline__ float shx(float v, int mask, int lane) { return __builtin_bit_cast(float, __builtin_amdgcn_ds_bpermute((lane ^ mask) << 2, __builtin_bit_cast(int, v))); }
__device__ __forceinline__ float sum_x16(float v) { const auto r = __builtin_amdgcn_permlane16_swap(__float_as_uint(v), __float_as_uint(v), false, false); return __uint_as_float(r[0]) + __uint_as_float(r[1]); }
__device__ __forceinline__ float sum_x32(float v) { const auto r = __builtin_amdgcn_permlane32_swap(__float_as_uint(v), __float_as_uint(v), false, false); return __uint_as_float(r[0]) + __uint_as_float(r[1]); }
constexpr int NSSQ = 32;
__device__ __forceinline__ void load_rstd(const PG8_LAS float* rtab, int slot, int lrow0, float (&rs)[2][4]) {
#pragma unroll
    for (int ai = 0; ai < 2; ++ai)
#pragma unroll
        for (int m = 0; m < 4; ++m) rs[ai][m] = rtab ? rtab[slot * 256 + lrow0 + ai * HALF + m * 16] : 1.0f;
}
struct EpiBf16 {
    static constexpr bool PERM = true, AFTER_DRAIN = false;
    bf16_t* O; int ldc; const PG8_LAS float* rtab;
    __device__ __forceinline__ void operator()(const f32x4 (&acc)[2][2][4][2], const Unit& u, int wr, int wc, int fr, int fq) const {
        const int row0 = u.pm * BM + wr * 64 + fr, col0 = u.pn * BM + wc * 32 + 8 * fq;
        float rs[2][4]; load_rstd(rtab, u.slot, wr * 64 + fr, rs);
#pragma unroll
        for (int ai = 0; ai < 2; ++ai)
#pragma unroll
            for (int m = 0; m < 4; ++m) { bf16_t* rowp = O + (size_t)(row0 + ai * HALF + m * 16) * ldc + col0; const float r = rs[ai][m];
#pragma unroll
                for (int bj = 0; bj < 2; ++bj) { const f32x4 v0 = acc[ai][bj][m][0] * r, v1 = acc[ai][bj][m][1] * r;
                    u32x4 w; w.x = cvt_pk_bf16(v0[0], v0[1]); w.y = cvt_pk_bf16(v0[2], v0[3]); w.z = cvt_pk_bf16(v1[0], v1[1]); w.w = cvt_pk_bf16(v1[2], v1[3]);
                    *(u32x4*)(rowp + bj * HALF) = w; } }
    }
};
struct EpiTileImg {
    static constexpr bool PERM = true, AFTER_DRAIN = false;
    bf16_t* T; int ntn, tid;
    __device__ __forceinline__ void operator()(const f32x4 (&acc)[2][2][4][2], const Unit& u, int wr, int wc, int fr, int fq) const {
        char* const tb = (char*)T + (size_t)(u.pm * ntn + u.pn) * 131072; unsigned voff = (unsigned)tid * 16u; asm volatile("" : "+v"(voff));
#pragma unroll
        for (int ai = 0; ai < 2; ++ai)
#pragma unroll
            for (int m = 0; m < 4; ++m)
#pragma unroll
                for (int bj = 0; bj < 2; ++bj) { const f32x4 v0 = acc[ai][bj][m][0], v1 = acc[ai][bj][m][1];
                    u32x4 w; w.x = cvt_pk_bf16(v0[0], v0[1]); w.y = cvt_pk_bf16(v0[2], v0[3]); w.z = cvt_pk_bf16(v1[0], v1[1]); w.w = cvt_pk_bf16(v1[2], v1[3]);
                    *(u32x4*)(tb + (size_t)(((ai * 4 + m) * 2 + bj) * 8192) + voff) = w; }
    }
};
struct EpiSwiglu {
    static constexpr bool PERM = true, AFTER_DRAIN = false;
    bf16_t* O; int ldc; const PG8_LAS float* rtab;
    __device__ __forceinline__ void operator()(const f32x4 (&acc)[2][2][4][2], const Unit& u, int wr, int wc, int fr, int fq) const {
        const int lrow0 = wr * 64 + fr, kt = 2 * u.pn + (wc >> 1), cc = (wc & 1) * 32 + 8 * fq;
        bf16_t* const blk = O + ((size_t)u.pm * (ldc / BK) + kt) * (BM * BK) + cc;
        float rs[2][4]; load_rstd(rtab, u.slot, lrow0, rs);
#pragma unroll
        for (int ai = 0; ai < 2; ++ai)
#pragma unroll
            for (int m = 0; m < 4; ++m) { bf16_t* rowp = blk + (lrow0 + ai * HALF + m * 16) * BK; const float r = rs[ai][m], rn = -1.4426950408889634f * r, r2 = r * r;
                float h[8], ee[8];
#pragma unroll
                for (int n = 0; n < 2; ++n)
#pragma unroll
                    for (int j = 0; j < 4; ++j) { ee[n * 4 + j] = __builtin_amdgcn_exp2f(acc[ai][0][m][n][j] * rn); h[n * 4 + j] = acc[ai][0][m][n][j] * acc[ai][1][m][n][j]; }
#pragma unroll
                for (int j = 0; j < 8; ++j) ee[j] = __builtin_amdgcn_rcpf(1.0f + ee[j]) * r2;
#pragma unroll
                for (int j = 0; j < 8; ++j) h[j] = h[j] * ee[j];
                u32x4 w; w.x = cvt_pk_bf16(h[0], h[1]); w.y = cvt_pk_bf16(h[2], h[3]); w.z = cvt_pk_bf16(h[4], h[5]); w.w = cvt_pk_bf16(h[6], h[7]);
                *(u32x4*)rowp = w; }
    }
};
struct EpiResidX {
    static constexpr bool PERM = true, AFTER_DRAIN = false;
    bf16_t* xb; float* out32; float* ssq; int ldc; float alpha;
    struct Bt { u32x4 v[2][2]; };
    __device__ __forceinline__ void ld(Bt& b, int row0, int col0, int k) const {
#pragma unroll
        for (int mm = 0; mm < 2; ++mm)
#pragma unroll
            for (int bj = 0; bj < 2; ++bj) b.v[mm][bj] = *(const u32x4*)(xb + (size_t)(row0 + (k >> 1) * HALF + (2 * (k & 1) + mm) * 16) * ldc + col0 + bj * HALF);
    }
    __device__ __forceinline__ void st(const Bt& b, const f32x4 (&acc)[2][2][4][2], const Unit& u, int row0, int col0, int wc, int fq, int k) const {
        const int ai = k >> 1, mp = k & 1;
#pragma unroll
        for (int mm = 0; mm < 2; ++mm) { const int m = 2 * mp + mm, row = row0 + ai * HALF + m * 16; const size_t off = (size_t)row * ldc + col0; float ss = 0.f;
#pragma unroll
            for (int bj = 0; bj < 2; ++bj) { const u32x4 r = b.v[mm][bj];
                const f32x4 o0 = (f32x4){bf_lo(r.x), bf_hi(r.x), bf_lo(r.y), bf_hi(r.y)} + acc[ai][bj][m][0] * alpha, o1 = (f32x4){bf_lo(r.z), bf_hi(r.z), bf_lo(r.w), bf_hi(r.w)} + acc[ai][bj][m][1] * alpha;
                if (out32) { *(f32x4*)(out32 + off + bj * HALF) = o0; *(f32x4*)(out32 + off + bj * HALF + 4) = o1; }
                else { u32x4 w; w.x = cvt_pk_bf16(o0[0], o0[1]); w.y = cvt_pk_bf16(o0[2], o0[3]); w.z = cvt_pk_bf16(o1[0], o1[1]); w.w = cvt_pk_bf16(o1[2], o1[3]);
                    *(u32x4*)(xb + off + bj * HALF) = w;
                    ss += ((o0[0] * o0[0] + o0[1] * o0[1]) + (o0[2] * o0[2] + o0[3] * o0[3])) + ((o1[0] * o1[0] + o1[1] * o1[1]) + (o1[2] * o1[2] + o1[3] * o1[3])); } }
            if (!out32) { ss = sum_x32(sum_x16(ss)); if (fq == 0) ssq[(size_t)row * NSSQ + u.pn * 4 + wc] = ss; } }
    }
    __device__ __forceinline__ void operator()(const f32x4 (&acc)[2][2][4][2], const Unit& u, int wr, int wc, int fr, int fq) const {
        const int row0 = u.pm * BM + wr * 64 + fr, col0 = u.pn * BM + wc * 32 + 8 * fq;
        Bt bA, bB;
        ld(bA, row0, col0, 0);
        ld(bB, row0, col0, 1); st(bA, acc, u, row0, col0, wc, fq, 0);
        ld(bA, row0, col0, 2); st(bB, acc, u, row0, col0, wc, fq, 1);
        ld(bB, row0, col0, 3); st(bA, acc, u, row0, col0, wc, fq, 2);
        st(bB, acc, u, row0, col0, wc, fq, 3);
    }
};
struct EpiGateAcc {
    static constexpr bool PERM = true, AFTER_DRAIN = false;
    const bf16_t* B; int ldb; float* scr; bf16_t* Mg; int ldm; const PG8_LAS float* rtab; int tid, nN3;
    struct Bt { u32x4 b[2]; u32x4 mo[2]; };
#define SCRQ(q) (*(u32x4*)(sb + (size_t)(q) * 8192 + voff))
    template <int SUB>
    __device__ __forceinline__ void ld(Bt& t, const char* bimg, char* sb, unsigned voff, int k) const {
#pragma unroll
        for (int bj = 0; bj < 2; ++bj) { t.b[bj] = *(const u32x4*)(bimg + (size_t)((k * 2 + bj) * 8192) + voff);
            const int q = k * 2 + bj;
            if constexpr (SUB != 0) t.mo[bj] = SCRQ(q); else t.mo[bj] = (u32x4){0u, 0u, 0u, 0u}; }
    }
    template <int SUB>
    __device__ __forceinline__ void st(const Bt& t, const f32x4 (&acc)[2][2][4][2], float r, int row0, int colm, char* sb, unsigned voff, int k) const {
        const int ai = k >> 2, m = k & 3;
        const float rn = -1.4426950408889634f * r;
#pragma unroll
        for (int bj = 0; bj < 2; ++bj) { const f32x4 v0 = acc[ai][bj][m][0] * rn, v1 = acc[ai][bj][m][1] * rn; const u32x4 bb = t.b[bj];
            f32x4 t0, t1; float ee[8];
#pragma unroll
            for (int j = 0; j < 4; ++j) { ee[j] = __builtin_amdgcn_exp2f(v0[j]); ee[4 + j] = __builtin_amdgcn_exp2f(v1[j]); }
#pragma unroll
            for (int j = 0; j < 8; ++j) ee[j] = __builtin_amdgcn_rcpf(1.0f + ee[j]);
            t0[0] = ee[0] * bf_lo(bb.x); t0[1] = ee[1] * bf_hi(bb.x); t0[2] = ee[2] * bf_lo(bb.y); t0[3] = ee[3] * bf_hi(bb.y);
            t1[0] = ee[4] * bf_lo(bb.z); t1[1] = ee[5] * bf_hi(bb.z); t1[2] = ee[6] * bf_lo(bb.w); t1[3] = ee[7] * bf_hi(bb.w);
            if constexpr (SUB != 0) { const u32x4 mm = t.mo[bj];
                t0[0] += bf_lo(mm.x); t0[1] += bf_hi(mm.x); t0[2] += bf_lo(mm.y); t0[3] += bf_hi(mm.y); t1[0] += bf_lo(mm.z); t1[1] += bf_hi(mm.z); t1[2] += bf_lo(mm.w); t1[3] += bf_hi(mm.w); }
            u32x4 w; w.x = cvt_pk_bf16(t0[0], t0[1]); w.y = cvt_pk_bf16(t0[2], t0[3]); w.z = cvt_pk_bf16(t1[0], t1[1]); w.w = cvt_pk_bf16(t1[2], t1[3]);
            if constexpr (SUB != 2) SCRQ(k * 2 + bj) = w;
            else *(u32x4*)(Mg + (size_t)(row0 + ai * HALF + m * 16) * ldm + colm + bj * HALF) = w; }
    }
    template <int SUB>
    __device__ __forceinline__ void run(const f32x4 (&acc)[2][2][4][2], const float (&rs)[2][4], const char* bimg, char* sb, unsigned voff, int row0, int colm) const {
        Bt tA, tB;
        ld<SUB>(tA, bimg, sb, voff, 0);
        ld<SUB>(tB, bimg, sb, voff, 1); st<SUB>(tA, acc, rs[0][0], row0, colm, sb, voff, 0);
        ld<SUB>(tA, bimg, sb, voff, 2); st<SUB>(tB, acc, rs[0][1], row0, colm, sb, voff, 1);
        ld<SUB>(tB, bimg, sb, voff, 3); st<SUB>(tA, acc, rs[0][2], row0, colm, sb, voff, 2);
        ld<SUB>(tA, bimg, sb, voff, 4); st<SUB>(tB, acc, rs[0][3], row0, colm, sb, voff, 3);
        ld<SUB>(tB, bimg, sb, voff, 5); st<SUB>(tA, acc, rs[1][0], row0, colm, sb, voff, 4);
        ld<SUB>(tA, bimg, sb, voff, 6); st<SUB>(tB, acc, rs[1][1], row0, colm, sb, voff, 5);
        ld<SUB>(tB, bimg, sb, voff, 7); st<SUB>(tA, acc, rs[1][2], row0, colm, sb, voff, 6);
        st<SUB>(tB, acc, rs[1][3], row0, colm, sb, voff, 7);
    }
    __device__ __forceinline__ void operator()(const f32x4 (&acc)[2][2][4][2], const Unit& u, int wr, int wc, int fr, int fq) const {
        const int sub = u.pn / nN3, pn3 = u.pn - sub * nN3;
        const int row0 = u.pm * BM + wr * 64 + fr, colm = pn3 * BM + wc * 32 + 8 * fq;
        const char* const bimg = (const char*)B + (size_t)(u.pm * ldb + u.pn) * 131072;
        float rs[2][4]; load_rstd(rtab, u.slot, wr * 64 + fr, rs);
        char* const sb = (char*)scr; unsigned voff = (unsigned)tid * 16u; asm volatile("" : "+v"(voff));
        if (sub == 0) run<0>(acc, rs, bimg, sb, voff, row0, colm); else if (sub == 1) run<1>(acc, rs, bimg, sb, voff, row0, colm); else run<2>(acc, rs, bimg, sb, voff, row0, colm);
    }
#undef SCRQ
};

template <class Epi, class Sched, bool ALIGN_EPI = false, bool SP2 = false>
__device__ __forceinline__ void gemm_phase(PG8_LAS unsigned char* lds, const Gemm g, const Sched& S, const Epi& E, const int tid) {
    const int wid = __builtin_amdgcn_readfirstlane(tid >> 6), lane = tid & 63, wr = wid >> 2, wc = wid & 3, fr = lane & 15, fq = lane >> 4;
    const int K = g.K, nt = K / BK;
    unsigned voffA[2], voffB[2];
#pragma unroll
    for (int i = 0; i < 2; ++i) { int R, C; stage_rc(tid * 16 + i * 8192, R, C); const int Rb = Epi::PERM ? ((R & ~31) + perm32(R & 31)) : R;
        voffA[i] = (unsigned)(R * (g.ablk ? BK : g.lda) + C) * 2u; voffB[i] = (unsigned)(Rb * (g.bblk ? BK : g.ldb) + C) * 2u; }
    const size_t kstepA = g.ablk ? (size_t)(BM * BK * 2) : (size_t)(BK * 2), kstepB = g.bblk ? (size_t)(BM * BK * 2) : (size_t)(BK * 2);
    const size_t hstepA = (size_t)HALF * (g.ablk ? BK : g.lda) * 2, hstepB = (size_t)HALF * (g.bblk ? BK : g.ldb) * 2;
    const size_t tstepA = g.ablk ? (size_t)nt * (BM * BK * 2) : 2 * hstepA, tstepB = g.bblk ? (size_t)nt * (BM * BK * 2) : 2 * hstepB;
    const unsigned ldsw = (unsigned)wid * 1024u;
    const unsigned ldsb = (unsigned)__builtin_amdgcn_readfirstlane((int)(unsigned)(unsigned long long)(lds + ldsw));
    const int aoff = lds_byte(wr * 64 + fr, fq * 8), boff = lds_byte(wc * 32 + fr, fq * 8);
#define PG8_ABASE(u) ((const char*)g.A + (size_t)(u).pm * tstepA + (g.grp ? (size_t)(((u).pn / g.grp) * g.grp_a) * 2 : (size_t)0))
#define PG8_BBASE(u) ((const char*)g.Bt + (size_t)(u).pn * tstepB)
#define PG8_SA(b, h) (((b) * 2 + (h)) * HTB)
#define PG8_SB(b, h) ((4 + (b) * 2 + (h)) * HTB)
#define PG8_STAGE(bufoff, gbase, voff) do { const char* _g = (const char*)(gbase); const unsigned _l = ldsb + (unsigned)(bufoff); unsigned _k; _Pragma("unroll") for (int _i = 0; _i < 2; ++_i) \
        asm volatile("s_mov_b32 %0, m0\n\ts_mov_b32 m0, %3\n\ts_nop 3\n\tglobal_load_lds_dwordx4 %1, %2\n\ts_mov_b32 m0, %0" : "=&s"(_k) : "v"((voff)[_i]), "s"(_g), "s"(_l + _i * 8192u) : "memory"); } while (0)
#define PG8_LDA(dst, b, h) do { _Pragma("unroll") for (int m = 0; m < 4; ++m) _Pragma("unroll") for (int k = 0; k < 2; ++k) dst[m][k] = *(const PG8_LAS bf16x8*)(lds + PG8_SA(b, h) + aoff + m * 2048 + k * 1024); } while (0)
#define PG8_LDB(dst, b, h) do { _Pragma("unroll") for (int n = 0; n < 2; ++n) _Pragma("unroll") for (int k = 0; k < 2; ++k) dst[n][k] = *(const PG8_LAS bf16x8*)(lds + PG8_SB(b, h) + boff + n * 2048 + k * 1024); } while (0)
#define PG8_MMA(ai, bj, At, Bt) do { __builtin_amdgcn_s_setprio(1); _Pragma("unroll") for (int m = 0; m < 4; ++m) _Pragma("unroll") for (int n = 0; n < 2; ++n) _Pragma("unroll") for (int k = 0; k < 2; ++k) \
        acc[ai][bj][m][n] = __builtin_amdgcn_mfma_f32_16x16x32_bf16(Bt[n][k], At[m][k], acc[ai][bj][m][n], 0, 0, 0); __builtin_amdgcn_s_setprio(0); } while (0)
#define PG8_WAIT_V(n) asm volatile("s_waitcnt vmcnt(" #n ")" ::: "memory")
#define PG8_WAIT_L(n) asm volatile("s_waitcnt lgkmcnt(" #n ")" ::: "memory")
#define PG8_BAR __builtin_amdgcn_s_barrier()
#define PG8_SCHED __builtin_amdgcn_sched_barrier(0)
    Unit cur, nxt; int ui = 0;
    if (!S.next(0, cur)) return;
    f32x4 acc[2][2][4][2];
#pragma unroll
    for (int a = 0; a < 2; ++a)
#pragma unroll
        for (int b = 0; b < 2; ++b)
#pragma unroll
            for (int m = 0; m < 4; ++m)
#pragma unroll
                for (int n = 0; n < 2; ++n) acc[a][b][m][n] = (f32x4){0.f, 0.f, 0.f, 0.f};
    bf16x8 At[4][2], B0[2][2], B1[2][2];
    const char* cA = PG8_ABASE(cur); const char* cB = PG8_BBASE(cur);
    S.a_ready(cur);
    if constexpr (SP2) {
        PG8_STAGE(PG8_SB(0, 0), cB, voffB); PG8_STAGE(PG8_SB(0, 1), cB + hstepB, voffB); PG8_STAGE(PG8_SA(0, 0), cA, voffA); PG8_STAGE(PG8_SA(0, 1), cA + hstepA, voffA);
        if (wr == 1) PG8_BAR;
        PG8_WAIT_V(2); PG8_BAR;
        PG8_STAGE(PG8_SB(1, 0), cB + kstepB, voffB); PG8_STAGE(PG8_SA(1, 0), cA + kstepA, voffA); PG8_STAGE(PG8_SB(1, 1), cB + hstepB + kstepB, voffB);
        PG8_WAIT_V(6); PG8_BAR;
    } else {
        PG8_STAGE(PG8_SB(0, 0), cB, voffB); PG8_STAGE(PG8_SA(0, 0), cA, voffA); PG8_STAGE(PG8_SB(0, 1), cB + hstepB, voffB); PG8_STAGE(PG8_SA(0, 1), cA + hstepA, voffA);
        if (wr == 1) PG8_BAR;
        PG8_WAIT_V(4); PG8_BAR;
        PG8_STAGE(PG8_SB(1, 0), cB + kstepB, voffB); PG8_STAGE(PG8_SA(1, 0), cA + kstepA, voffA); PG8_STAGE(PG8_SB(1, 1), cB + hstepB + kstepB, voffB);
        PG8_WAIT_V(6); PG8_BAR;
    }
    for (;;) {
        const bool has_next = S.next(ui + 1, nxt);
        const char* nA = has_next ? PG8_ABASE(nxt) : cA; const char* nB = has_next ? PG8_BBASE(nxt) : cB;
        for (int t = 0; t < nt; t += 2) {
            const bool last = (t == nt - 2);
            const char* a1 = cA + (size_t)(t + 1) * kstepA;
            const char* a2 = last ? nA : cA + (size_t)(t + 2) * kstepA; const char* b2 = last ? nB : cB + (size_t)(t + 2) * kstepB;
            const char* a3 = a2 + kstepA; const char* b3 = b2 + kstepB;
            if (last && has_next) S.a_ready(nxt);
            if constexpr (SP2) {
            PG8_LDB(B0, 0, 0); PG8_LDB(B1, 0, 1); PG8_SCHED; PG8_LDA(At, 0, 0); PG8_STAGE(PG8_SA(1, 1), a1 + hstepA, voffA);
            PG8_WAIT_V(8); PG8_WAIT_L(0); PG8_BAR; PG8_MMA(0, 0, At, B0); PG8_MMA(0, 1, At, B1); PG8_BAR; PG8_SCHED;
            PG8_LDA(At, 0, 1); PG8_STAGE(PG8_SB(0, 0), b2, voffB); PG8_STAGE(PG8_SB(0, 1), b2 + hstepB, voffB); PG8_STAGE(PG8_SA(0, 0), a2, voffA);
            PG8_WAIT_V(8); PG8_WAIT_L(0); PG8_BAR; PG8_MMA(1, 0, At, B0); PG8_MMA(1, 1, At, B1); PG8_BAR; PG8_SCHED;
            PG8_LDB(B0, 1, 0); PG8_LDB(B1, 1, 1); PG8_SCHED; PG8_LDA(At, 1, 0); PG8_STAGE(PG8_SA(0, 1), a2 + hstepA, voffA);
            PG8_WAIT_V(8); PG8_WAIT_L(0); PG8_BAR; PG8_MMA(0, 0, At, B0); PG8_MMA(0, 1, At, B1); PG8_BAR; PG8_SCHED;
            PG8_LDA(At, 1, 1); PG8_STAGE(PG8_SB(1, 0), b3, voffB); PG8_STAGE(PG8_SB(1, 1), b3 + hstepB, voffB); PG8_STAGE(PG8_SA(1, 0), a3, voffA);
            PG8_WAIT_V(8); PG8_WAIT_L(0); PG8_BAR; PG8_MMA(1, 0, At, B0); PG8_MMA(1, 1, At, B1); PG8_BAR; PG8_SCHED;
            } else {
            PG8_LDB(B0, 0, 0); PG8_SCHED; PG8_LDA(At, 0, 0); PG8_STAGE(PG8_SA(1, 1), a1 + hstepA, voffA);
            PG8_WAIT_L(8); PG8_BAR; PG8_WAIT_L(0); PG8_MMA(0, 0, At, B0); PG8_BAR; PG8_SCHED;
            PG8_LDB(B1, 0, 1); PG8_STAGE(PG8_SB(0, 0), b2, voffB);
            PG8_BAR; PG8_WAIT_L(0); PG8_MMA(0, 1, At, B1); PG8_BAR;
            PG8_LDA(At, 0, 1); PG8_STAGE(PG8_SA(0, 0), a2, voffA);
            PG8_BAR; PG8_WAIT_L(0); PG8_MMA(1, 0, At, B0); PG8_BAR; PG8_SCHED;
            PG8_STAGE(PG8_SB(0, 1), b2 + hstepB, voffB);
            PG8_WAIT_V(6); PG8_BAR; PG8_MMA(1, 1, At, B1); PG8_BAR;
            PG8_LDB(B0, 1, 0); PG8_SCHED; PG8_LDA(At, 1, 0); PG8_STAGE(PG8_SA(0, 1), a2 + hstepA, voffA);
            PG8_WAIT_L(8); PG8_BAR; PG8_WAIT_L(0); PG8_MMA(0, 0, At, B0); PG8_BAR; PG8_SCHED;
            PG8_LDB(B1, 1, 1); PG8_STAGE(PG8_SB(1, 0), b3, voffB);
            PG8_BAR; PG8_WAIT_L(0); PG8_MMA(0, 1, At, B1); PG8_BAR;
            PG8_LDA(At, 1, 1); PG8_STAGE(PG8_SA(1, 0), a3, voffA);
            PG8_BAR; PG8_WAIT_L(0); PG8_MMA(1, 0, At, B0); PG8_BAR; PG8_SCHED;
            PG8_STAGE(PG8_SB(1, 1), b3 + hstepB, voffB);
            PG8_WAIT_V(6); PG8_BAR; PG8_MMA(1, 1, At, B1); PG8_BAR;
            }
        }
        if constexpr (ALIGN_EPI) { if (wr == 0) PG8_BAR; }
        if constexpr (!Epi::AFTER_DRAIN) { E(acc, cur, wr, wc, fr, fq); S.done(cur); }
        if (!has_next) break;
#pragma unroll
        for (int a = 0; a < 2; ++a)
#pragma unroll
            for (int b = 0; b < 2; ++b)
#pragma unroll
                for (int m = 0; m < 4; ++m)
#pragma unroll
                    for (int n = 0; n < 2; ++n) acc[a][b][m][n] = (f32x4){0.f, 0.f, 0.f, 0.f};
        cur = nxt; cA = nA; cB = nB; ++ui;
        if constexpr (ALIGN_EPI) { if (wr == 1) PG8_BAR; }
    }
    PG8_WAIT_V(0);
    if constexpr (!ALIGN_EPI) { if (wr == 0) PG8_BAR; }
    PG8_BAR;
#undef PG8_ABASE
#undef PG8_BBASE
#undef PG8_SA
#undef PG8_SB
#undef PG8_STAGE
#undef PG8_LDA
#undef PG8_LDB
#undef PG8_MMA
#undef PG8_WAIT_V
#undef PG8_WAIT_L
#undef PG8_BAR
#undef PG8_SCHED
}
}

namespace att {
using bf16 = unsigned short;
constexpr int D = 128, NW = 8, QBLK = 32, KVBLK = 64;
constexpr float SCALE = 0.088388347648318440f;
constexpr float THR = 8.f;
constexpr float NEG = -1.0e5f;
constexpr int LDQ = 6144, LDK = 6144, LDO = 3072;
constexpr size_t SHM_V = KVBLK * D * 2, SHM_K = KVBLK * D * 2, SHM_ATTN = 2 * SHM_V + 2 * SHM_K + NW * 64 * 4;
constexpr int TBL_OFF = 69632;

using bf16x8 = __attribute__((ext_vector_type(8))) short;
using s16x4  = __attribute__((ext_vector_type(4))) short;
using f32x16 = __attribute__((ext_vector_type(16))) float;
using u32x4  = __attribute__((ext_vector_type(4))) unsigned;
#define KSWZ(row, colB) ((row) * 256 + ((colB) ^ (((row) & 7) << 4)))
#define SBAR() __builtin_amdgcn_sched_barrier(0)
__device__ __forceinline__ int crow(int r, int hi) { return (r & 3) + 8 * (r >> 2) + 4 * hi; }
__device__ __forceinline__ unsigned cvtpk(float lo, float hi) { const pg8::f32x2_t v = {lo, hi}; return __builtin_bit_cast(unsigned, __builtin_convertvector(v, pg8::bf16x2_t)); }

struct Par { int qpos0, kpos0, r0, rows, kr0; float slopeR, sinkR; const float* gq; const float* rope; int qt0; const float* gk; };

__device__ __forceinline__ void partialSM(f32x16& p0, f32x16& p1, float& m_reg, float& mn, float& alpha) {
  constexpr float C = SCALE * 1.4426950408889634f;
  float pmax = p0[0]; for (int r = 1; r < 16; ++r) pmax = fmaxf(pmax, p0[r]); for (int r = 0; r < 16; ++r) pmax = fmaxf(pmax, p1[r]);
  { auto rr = __builtin_amdgcn_permlane32_swap(__float_as_uint(pmax), __float_as_uint(pmax), false, false);
    pmax = fmaxf(__uint_as_float(rr[0]), __uint_as_float(rr[1])); }
  if (__builtin_expect(__all(pmax - m_reg <= THR / SCALE), 1)) { mn = m_reg; alpha = 1.f; }
  else { mn = fmaxf(m_reg, pmax); alpha = __builtin_amdgcn_exp2f((m_reg - mn) * C); m_reg = mn; }
  float mnC = -mn * C;
  for (int r = 0; r < 16; ++r) p0[r] = fmaf(p0[r], C, mnC); for (int r = 0; r < 16; ++r) p1[r] = fmaf(p1[r], C, mnC);
  for (int r = 0; r < 16; ++r) p0[r] = __builtin_amdgcn_exp2f(p0[r]);
}
template <int NEXP = 16>
__device__ __forceinline__ void finishSM(f32x16& p0, f32x16& p1, float alpha, float& l_reg, bf16x8& pa0, bf16x8& pa1, bf16x8& pa2, bf16x8& pa3) {
  for (int r = 16 - NEXP; r < 16; ++r) p1[r] = __builtin_amdgcn_exp2f(p1[r]);
  float ps = 0; for (int r = 0; r < 16; ++r) ps += p0[r]; for (int r = 0; r < 16; ++r) ps += p1[r];
  { auto rr = __builtin_amdgcn_permlane32_swap(__float_as_uint(ps), __float_as_uint(ps), false, false);
    ps = __uint_as_float(rr[0]) + __uint_as_float(rr[1]); }
  l_reg = l_reg * alpha + ps;
#define PK4(P, BASE, OUT) do { unsigned a0 = cvtpk(P[BASE + 0], P[BASE + 1]), a1 = cvtpk(P[BASE + 2], P[BASE + 3]);   \
    unsigned b0 = cvtpk(P[BASE + 4], P[BASE + 5]), b1 = cvtpk(P[BASE + 6], P[BASE + 7]);                              \
    auto r0 = __builtin_amdgcn_permlane32_swap(a0, b0, false, false); auto r1 = __builtin_amdgcn_permlane32_swap(a1, b1, false, false); \
    u32x4 w = {r0[0], r1[0], r0[1], r1[1]}; OUT = *reinterpret_cast<bf16x8*>(&w); } while (0)
  PK4(p0, 0, pa0); PK4(p0, 8, pa1); PK4(p1, 0, pa2); PK4(p1, 8, pa3);
#undef PK4
}
__device__ __forceinline__ void qkt(f32x16& p0, f32x16& p1, const bf16* Ks, const bf16x8* qr, int r32, int hi) {
  p0 = f32x16{}; p1 = f32x16{};
  for (int d0 = 0; d0 < 8; ++d0) { int cb = (d0 * 16 + hi * 8) * 2;
    bf16x8 b0 = *reinterpret_cast<const bf16x8*>((const char*)Ks + KSWZ(r32, cb));
    bf16x8 b1 = *reinterpret_cast<const bf16x8*>((const char*)Ks + KSWZ(32 + r32, cb));
    p0 = __builtin_amdgcn_mfma_f32_32x32x16_bf16(b0, qr[d0], p0, 0, 0, 0);
    p1 = __builtin_amdgcn_mfma_f32_32x32x16_bf16(b1, qr[d0], p1, 0, 0, 0); }
}
__device__ __forceinline__ void qkt_rel(f32x16& p0, f32x16& p1, const bf16* Ks, const bf16x8* qr, int r32, int hi, const f32x16& nm) {
  { bf16x8 b0 = *reinterpret_cast<const bf16x8*>((const char*)Ks + KSWZ(r32, hi * 16)); bf16x8 b1 = *reinterpret_cast<const bf16x8*>((const char*)Ks + KSWZ(32 + r32, hi * 16));
    p0 = __builtin_amdgcn_mfma_f32_32x32x16_bf16(b0, qr[0], nm, 0, 0, 0); p1 = __builtin_amdgcn_mfma_f32_32x32x16_bf16(b1, qr[0], nm, 0, 0, 0); }
  for (int d0 = 1; d0 < 8; ++d0) { int cb = ((d0 & 3) * 16 + hi * 8) * 2;
    bf16x8 b0 = *reinterpret_cast<const bf16x8*>((const char*)Ks + KSWZ(r32, cb) + (d0 >> 2) * 128);
    bf16x8 b1 = *reinterpret_cast<const bf16x8*>((const char*)Ks + KSWZ(32 + r32, cb) + (d0 >> 2) * 128);
    p0 = __builtin_amdgcn_mfma_f32_32x32x16_bf16(b0, qr[d0], p0, 0, 0, 0);
    p1 = __builtin_amdgcn_mfma_f32_32x32x16_bf16(b1, qr[d0], p1, 0, 0, 0); }
}
template <bool FIRST>
__device__ __forceinline__ void partialSM_rel(f32x16& p0, f32x16& p1, float& m_reg, f32x16& nm, float& alpha) {
  float pmax = p0[0]; for (int r = 1; r < 16; ++r) pmax = fmaxf(pmax, p0[r]); for (int r = 0; r < 16; ++r) pmax = fmaxf(pmax, p1[r]);
  { auto rr = __builtin_amdgcn_permlane32_swap(__float_as_uint(pmax), __float_as_uint(pmax), false, false);
    pmax = fmaxf(__uint_as_float(rr[0]), __uint_as_float(rr[1])); }
  if (!FIRST && __builtin_expect(__all(pmax <= THR * 1.4426950408889634f), 1)) { alpha = 1.f; }
  else { const float d = FIRST ? pmax : fmaxf(pmax, 0.f); alpha = FIRST ? 1.f : __builtin_amdgcn_exp2f(-d); m_reg += d;
    for (int r = 0; r < 16; ++r) { p0[r] -= d; p1[r] -= d; }
    for (int r = 0; r < 16; ++r) nm[r] = -m_reg; }
  for (int r = 0; r < 16; ++r) p0[r] = __builtin_amdgcn_exp2f(p0[r]);
  for (int r = 0; r < 8; ++r) p1[r] = __builtin_amdgcn_exp2f(p1[r]);
}
template <int MODE>
__device__ __forceinline__ void modify(f32x16& p0, f32x16& p1, int jt, const Par& P, int wid, int r32, int hi, const float* tbl) {
  if constexpr (MODE == 1) {
    const int qpos = P.qpos0 + wid * 32 + r32, kb = P.kpos0 + 64 * jt;
#pragma unroll
    for (int r = 0; r < 16; ++r) { const int kp = kb + crow(r, hi); int d0 = qpos - kp; d0 = d0 < 0 ? -d0 : d0; int d1 = qpos - (kp + 32); d1 = d1 < 0 ? -d1 : d1;
      p0[r] = (d0 <= 128) ? p0[r] - P.slopeR * (float)d0 : NEG; p1[r] = (d1 <= 128) ? p1[r] - P.slopeR * (float)d1 : NEG; }
  }
  if constexpr (MODE == 2) {
    const int r = P.r0 + (wid >> 1), c = 32 * (wid & 1) + r32;
    int rs = r - 4; rs = rs < 0 ? 0 : rs; rs = rs > P.rows - 8 ? P.rows - 8 : rs;
    int cs = c - 8; cs = cs < 0 ? 0 : cs; cs = cs > 48 ? 48 : cs;
    const int kr = P.kr0 + jt;
    if ((unsigned)(kr - rs) < 8u) {
      const float* tb = tbl + (kr - r + 7) * 32;
      int A = 4 * hi - cs, B = 4 * hi + 15 - c; asm volatile("" : "+v"(A), "+v"(B));
#pragma unroll
      for (int q = 0; q < 16; ++q) { const int kq = (q & 3) + 8 * (q >> 2);
        const int i0 = ((unsigned)(kq + A) < 16u) ? kq + B : 31, i1 = ((unsigned)(kq + 32 + A) < 16u) ? kq + 32 + B : 31;
        p0[q] += tb[i0]; p1[q] += tb[i1];
        if ((q & 3) == 3) asm volatile("" ::: "memory"); }
    } else {
#pragma unroll
      for (int q = 0; q < 16; ++q) { p0[q] = NEG; p1[q] = NEG; }
    }
  }
}
template <bool ROPE>
__device__ __forceinline__ void load_q(bf16x8 (&qr)[8], const char* Qp, const Par& P, int qrow, int hi) {
  float x[8][8]; float ss = 0.f;
#pragma unroll
  for (int d0 = 0; d0 < 8; ++d0) { const bf16x8 raw = *reinterpret_cast<const bf16x8*>(Qp + d0 * 32);
#pragma unroll
    for (int e = 0; e < 8; ++e) { x[d0][e] = __uint_as_float(((unsigned)(unsigned short)raw[e]) << 16); ss += x[d0][e] * x[d0][e]; } }
  { auto rr = __builtin_amdgcn_permlane32_swap(__float_as_uint(ss), __float_as_uint(ss), false, false); ss = __uint_as_float(rr[0]) + __uint_as_float(rr[1]); }
  const float rstd = __builtin_amdgcn_rsqf(ss * (1.0f / 128.0f) + 1e-6f) * (ROPE ? SCALE * 1.4426950408889634f : 1.0f);
#pragma unroll
  for (int d0 = 0; d0 < 8; ++d0) { const float* gp = P.gq + d0 * 16 + hi * 8;
#pragma unroll
    for (int e = 0; e < 8; ++e) x[d0][e] *= rstd * gp[e]; }
  if constexpr (ROPE) {
    const int t = P.qt0 + qrow; int hiR = hi; asm volatile("" : "+v"(hiR));
#pragma unroll
    for (int hb = 0; hb < 2; ++hb) { const int pos = hb ? (t & 63) : (t >> 6);
#pragma unroll
      for (int dd = 0; dd < 2; ++dd) { const float* cs = P.rope + ((size_t)pos * 32 + dd * 16 + hiR * 8) * 2; const int da = 4 * hb + dd, db = da + 2;
#pragma unroll
        for (int e = 0; e < 8; ++e) { const float c = cs[2 * e], s = cs[2 * e + 1], a = x[da][e], b = x[db][e]; x[da][e] = a * c - b * s; x[db][e] = b * c + a * s; } } }
  }
#pragma unroll
  for (int d0 = 0; d0 < 8; ++d0) { u32x4 w = {cvtpk(x[d0][0], x[d0][1]), cvtpk(x[d0][2], x[d0][3]), cvtpk(x[d0][4], x[d0][5]), cvtpk(x[d0][6], x[d0][7])}; qr[d0] = *reinterpret_cast<bf16x8*>(&w); }
}
__device__ __forceinline__ int v_st(int k, int c) { const int kk = (k & ~0xC) | ((k & 4) << 1) | ((k & 8) >> 1); return ((kk >> 3) * 4 + (c >> 5)) * 512 + ((kk & 7) * 32 + (c & 31)) * 2; }
__device__ __forceinline__ int v_rd_base(int lane) { return ((lane & 3) << 3) | (((lane >> 2) & 3) << 6) | (((lane >> 4) & 1) << 5) | (((lane >> 5) & 1) << 8); }
constexpr int v_rd_off(int d0, int ks, int half) { return d0 * 512 + ks * 4096 + half * 2048; }
template <int OFF> __device__ __forceinline__ s16x4 tr_read(int vb) {
  s16x4 r; asm volatile("ds_read_b64_tr_b16 %0, %1 offset:%2" : "=&v"(r) : "v"(vb), "i"(OFF) : "memory"); return r;
}
template <int D0> __device__ __forceinline__ void pv_one(f32x16& od, int vb, bf16x8 pa0, bf16x8 pa1, bf16x8 pa2, bf16x8 pa3) {
  const s16x4 l0 = tr_read<v_rd_off(D0, 0, 0)>(vb), h0 = tr_read<v_rd_off(D0, 0, 1)>(vb), l1 = tr_read<v_rd_off(D0, 1, 0)>(vb), h1 = tr_read<v_rd_off(D0, 1, 1)>(vb);
  const s16x4 l2 = tr_read<v_rd_off(D0, 2, 0)>(vb), h2 = tr_read<v_rd_off(D0, 2, 1)>(vb), l3 = tr_read<v_rd_off(D0, 3, 0)>(vb), h3 = tr_read<v_rd_off(D0, 3, 1)>(vb);
  asm volatile("s_waitcnt lgkmcnt(0)" ::: "memory"); SBAR();
#define PK(L, H) (bf16x8){L[0], L[1], L[2], L[3], H[0], H[1], H[2], H[3]}
  od = __builtin_amdgcn_mfma_f32_32x32x16_bf16(pa0, PK(l0, h0), od, 0, 0, 0);
  od = __builtin_amdgcn_mfma_f32_32x32x16_bf16(pa1, PK(l1, h1), od, 0, 0, 0);
  od = __builtin_amdgcn_mfma_f32_32x32x16_bf16(pa2, PK(l2, h2), od, 0, 0, 0);
  od = __builtin_amdgcn_mfma_f32_32x32x16_bf16(pa3, PK(l3, h3), od, 0, 0, 0);
#undef PK
}
__device__ __forceinline__ void pv_d0(f32x16* o, int vb, bf16x8 pa0, bf16x8 pa1, bf16x8 pa2, bf16x8 pa3) {
  pv_one<0>(o[0], vb, pa0, pa1, pa2, pa3); pv_one<1>(o[1], vb, pa0, pa1, pa2, pa3); pv_one<2>(o[2], vb, pa0, pa1, pa2, pa3); pv_one<3>(o[3], vb, pa0, pa1, pa2, pa3);
}

constexpr int GA_SLOT = 16384, GA_K = 0, GA_V = 4 * GA_SLOT, GA_WS = 134144;
__device__ __forceinline__ void glds16(const char* gbase, unsigned voff, unsigned ldsaddr) {
  unsigned sv; asm volatile("s_mov_b32 %0, m0\n\ts_mov_b32 m0, %3\n\ts_nop 3\n\tglobal_load_lds_dwordx4 %1, %2\n\ts_mov_b32 m0, %0" : "=&s"(sv) : "v"(voff), "s"(gbase), "s"(ldsaddr) : "memory"); }
typedef short v4i16_t __attribute__((ext_vector_type(4)));
typedef __attribute__((address_space(3))) char* lds_ptr;
template <int OFF> __device__ __forceinline__ s16x4 vtr(lds_ptr vb) {
  return __builtin_bit_cast(s16x4, __builtin_amdgcn_ds_read_tr16_b64_v4i16((__attribute__((address_space(3))) v4i16_t*)(vb + OFF))); }
template <int D0, int BASE> __device__ __forceinline__ void pv_oneB(f32x16& od, lds_ptr vb, bf16x8 pa0, bf16x8 pa1, bf16x8 pa2, bf16x8 pa3) {
  const s16x4 l0 = vtr<BASE + v_rd_off(D0, 0, 0)>(vb), h0 = vtr<BASE + v_rd_off(D0, 0, 1)>(vb), l1 = vtr<BASE + v_rd_off(D0, 1, 0)>(vb), h1 = vtr<BASE + v_rd_off(D0, 1, 1)>(vb);
  const s16x4 l2 = vtr<BASE + v_rd_off(D0, 2, 0)>(vb), h2 = vtr<BASE + v_rd_off(D0, 2, 1)>(vb), l3 = vtr<BASE + v_rd_off(D0, 3, 0)>(vb), h3 = vtr<BASE + v_rd_off(D0, 3, 1)>(vb);
#define PK(L, H) (bf16x8){L[0], L[1], L[2], L[3], H[0], H[1], H[2], H[3]}
  od = __builtin_amdgcn_mfma_f32_32x32x16_bf16(pa0, PK(l0, h0), od, 0, 0, 0);
  od = __builtin_amdgcn_mfma_f32_32x32x16_bf16(pa1, PK(l1, h1), od, 0, 0, 0);
  od = __builtin_amdgcn_mfma_f32_32x32x16_bf16(pa2, PK(l2, h2), od, 0, 0, 0);
  od = __builtin_amdgcn_mfma_f32_32x32x16_bf16(pa3, PK(l3, h3), od, 0, 0, 0);
#undef PK
}
template <int BASE> __device__ __forceinline__ void pv_d0B(f32x16* o, lds_ptr vb, bf16x8 pa0, bf16x8 pa1, bf16x8 pa2, bf16x8 pa3) {
  pv_oneB<0, BASE>(o[0], vb, pa0, pa1, pa2, pa3); pv_oneB<1, BASE>(o[1], vb, pa0, pa1, pa2, pa3); pv_oneB<2, BASE>(o[2], vb, pa0, pa1, pa2, pa3); pv_oneB<3, BASE>(o[3], vb, pa0, pa1, pa2, pa3);
}
struct KF { bf16x8 a, b; };
template <int OFF> __device__ __forceinline__ bf16x8 kld(lds_ptr p) { return *(const __attribute__((address_space(3))) bf16x8*)(p + OFF); }
#define KLDP(F, SLOT, d0) do { F.a = kld<(SLOT) * GA_SLOT + ((d0) >> 2) * 128>(kq[(d0) & 3]); F.b = kld<(SLOT) * GA_SLOT + ((d0) >> 2) * 128 + 8192>(kq[(d0) & 3]); } while (0)
#define PIN(x) asm volatile("" : "+v"(x))
#define MFMA32(a, b, c) __builtin_amdgcn_mfma_f32_32x32x16_bf16(a, b, c, 0, 0, 0)
template <int KS>
__device__ __forceinline__ void qk_softmax(f32x16& C0, f32x16& C1, KF& ka, KF& kb, const lds_ptr (&kq)[4], const bf16x8 (&qr)[8], const f32x16& nm,
                                           f32x16& P0, f32x16& P1, float alpha, float& l_reg, bf16x8& pa0, bf16x8& pa1, bf16x8& pa2, bf16x8& pa3) {
  float sacc; unsigned a0, a1, b0, b1;
#define EXP1(i) P1[i] = __builtin_amdgcn_exp2f(P1[i]); PIN(P1)
#define SWZ(OUT) do { auto r0_ = __builtin_amdgcn_permlane32_swap(a0, b0, false, false); auto r1_ = __builtin_amdgcn_permlane32_swap(a1, b1, false, false); \
    u32x4 w_ = {r0_[0], r1_[0], r0_[1], r1_[1]}; OUT = *reinterpret_cast<bf16x8*>(&w_); PIN(OUT); } while (0)
  C0 = MFMA32(ka.a, qr[0], nm); EXP1(8);  sacc = P0[0] + P0[1];            a0 = cvtpk(P0[0], P0[1]);   PIN(sacc); PIN(a0); SBAR();
  C1 = MFMA32(ka.b, qr[0], nm); EXP1(9);  sacc += P0[2]; sacc += P0[3];    a1 = cvtpk(P0[2], P0[3]);   PIN(sacc); PIN(a1); SBAR();
  KLDP(ka, KS, 2); SBAR();
  C0 = MFMA32(kb.a, qr[1], C0); EXP1(10); sacc += P0[4]; sacc += P0[5];    b0 = cvtpk(P0[4], P0[5]);   PIN(sacc); PIN(b0); SBAR();
  C1 = MFMA32(kb.b, qr[1], C1); EXP1(11); sacc += P0[6]; sacc += P0[7];    b1 = cvtpk(P0[6], P0[7]);   PIN(sacc); SWZ(pa0); SBAR();
  KLDP(kb, KS, 3); SBAR();
  C0 = MFMA32(ka.a, qr[2], C0); EXP1(12); sacc += P0[8]; sacc += P0[9];    a0 = cvtpk(P0[8], P0[9]);   PIN(sacc); PIN(a0); SBAR();
  C1 = MFMA32(ka.b, qr[2], C1); EXP1(13); sacc += P0[10]; sacc += P0[11];  a1 = cvtpk(P0[10], P0[11]); PIN(sacc); PIN(a1); SBAR();
  KLDP(ka, KS, 4); SBAR();
  C0 = MFMA32(kb.a, qr[3], C0); EXP1(14); sacc += P0[12]; sacc += P0[13];  b0 = cvtpk(P0[12], P0[13]); PIN(sacc); PIN(b0); SBAR();
  C1 = MFMA32(kb.b, qr[3], C1); EXP1(15); sacc += P0[14]; sacc += P0[15];  b1 = cvtpk(P0[14], P0[15]); PIN(sacc); SWZ(pa1); SBAR();
  KLDP(kb, KS, 5); SBAR();
  C0 = MFMA32(ka.a, qr[4], C0); sacc += P1[0]; sacc += P1[1];    a0 = cvtpk(P1[0], P1[1]);   PIN(sacc); PIN(a0); SBAR();
  C1 = MFMA32(ka.b, qr[4], C1); sacc += P1[2]; sacc += P1[3];    a1 = cvtpk(P1[2], P1[3]);   PIN(sacc); PIN(a1); SBAR();
  KLDP(ka, KS, 6); SBAR();
  C0 = MFMA32(kb.a, qr[5], C0); sacc += P1[4]; sacc += P1[5];    b0 = cvtpk(P1[4], P1[5]);   PIN(sacc); PIN(b0); SBAR();
  C1 = MFMA32(kb.b, qr[5], C1); sacc += P1[6]; sacc += P1[7];    b1 = cvtpk(P1[6], P1[7]);   PIN(sacc); SWZ(pa2); SBAR();
  KLDP(kb, KS, 7); SBAR();
  C0 = MFMA32(ka.a, qr[6], C0); sacc += P1[8]; sacc += P1[9];    a0 = cvtpk(P1[8], P1[9]);   PIN(sacc); PIN(a0); SBAR();
  C1 = MFMA32(ka.b, qr[6], C1); sacc += P1[10]; sacc += P1[11];  a1 = cvtpk(P1[10], P1[11]); PIN(sacc); PIN(a1); SBAR();
  C0 = MFMA32(kb.a, qr[7], C0); sacc += P1[12]; sacc += P1[13];  b0 = cvtpk(P1[12], P1[13]); PIN(sacc); PIN(b0); SBAR();
  C1 = MFMA32(kb.b, qr[7], C1); sacc += P1[14]; sacc += P1[15];  b1 = cvtpk(P1[14], P1[15]); PIN(sacc); SWZ(pa3);
  { auto rr = __builtin_amdgcn_permlane32_swap(__float_as_uint(sacc), __float_as_uint(sacc), false, false); sacc = __uint_as_float(rr[0]) + __uint_as_float(rr[1]); }
  l_reg = l_reg * alpha + sacc; SBAR();
#undef EXP1
#undef SWZ
}
struct VF { s16x4 l0, h0, l1, h1, l2, h2, l3, h3; };
template <int BASE, int D0> __device__ __forceinline__ void rdg(VF& f, lds_ptr vb) {
  f.l0 = vtr<BASE + v_rd_off(D0, 0, 0)>(vb); f.h0 = vtr<BASE + v_rd_off(D0, 0, 1)>(vb); f.l1 = vtr<BASE + v_rd_off(D0, 1, 0)>(vb); f.h1 = vtr<BASE + v_rd_off(D0, 1, 1)>(vb);
  f.l2 = vtr<BASE + v_rd_off(D0, 2, 0)>(vb); f.h2 = vtr<BASE + v_rd_off(D0, 2, 1)>(vb); f.l3 = vtr<BASE + v_rd_off(D0, 3, 0)>(vb); f.h3 = vtr<BASE + v_rd_off(D0, 3, 1)>(vb); }
#define MX3(a, b, c) fmaxf(fmaxf((a), (b)), (c))
#define PKF(L, H) (bf16x8){L[0], L[1], L[2], L[3], H[0], H[1], H[2], H[3]}
template <int BASE, int KSN>
__device__ __forceinline__ void pv_softmax(f32x16* o, lds_ptr vb, bf16x8 pa0, bf16x8 pa1, bf16x8 pa2, bf16x8 pa3, f32x16& C0, f32x16& C1, float& m_reg, f32x16& nm, float& alpha, KF& ka, KF& kb, const lds_ptr (&kq)[4]) {
  VF fa, fb; float mx0, mx1;
  rdg<BASE, 0>(fa, vb); rdg<BASE, 1>(fb, vb); SBAR();
  o[0] = MFMA32(pa0, PKF(fa.l0, fa.h0), o[0]); mx0 = MX3(C0[0], C0[1], C0[2]);    mx1 = MX3(C0[3], C0[4], C0[5]);    mx0 = MX3(mx0, C0[6], C0[7]);   mx1 = MX3(mx1, C0[8], C0[9]);   PIN(mx0); PIN(mx1); SBAR();
  o[0] = MFMA32(pa1, PKF(fa.l1, fa.h1), o[0]); mx0 = MX3(mx0, C0[10], C0[11]);    mx1 = MX3(mx1, C0[12], C0[13]);    mx0 = MX3(mx0, C0[14], C0[15]); mx1 = MX3(mx1, C1[0], C1[1]);   PIN(mx0); PIN(mx1); SBAR();
  o[0] = MFMA32(pa2, PKF(fa.l2, fa.h2), o[0]); mx0 = MX3(mx0, C1[2], C1[3]);      mx1 = MX3(mx1, C1[4], C1[5]);      mx0 = MX3(mx0, C1[6], C1[7]);   mx1 = MX3(mx1, C1[8], C1[9]);   PIN(mx0); PIN(mx1); SBAR();
  o[0] = MFMA32(pa3, PKF(fa.l3, fa.h3), o[0]); mx0 = MX3(mx0, C1[10], C1[11]);    mx1 = MX3(mx1, C1[12], C1[13]);    mx0 = MX3(mx0, C1[14], C1[15]); float pmax = fmaxf(mx0, mx1);
  { auto rr = __builtin_amdgcn_permlane32_swap(__float_as_uint(pmax), __float_as_uint(pmax), false, false); pmax = fmaxf(__uint_as_float(rr[0]), __uint_as_float(rr[1])); } PIN(pmax); SBAR();
  rdg<BASE, 2>(fa, vb); SBAR();
  if (__builtin_expect(__all(pmax <= THR * 1.4426950408889634f), 1)) { alpha = 1.f; }
  else { const float d = fmaxf(pmax, 0.f); alpha = __builtin_amdgcn_exp2f(-d); m_reg += d;
    for (int r = 0; r < 16; ++r) { C0[r] -= d; C1[r] -= d; }
    for (int r = 0; r < 16; ++r) nm[r] = -m_reg; }
  SBAR();
#define EX2(C, i) C[i] = __builtin_amdgcn_exp2f(C[i]); C[i + 1] = __builtin_amdgcn_exp2f(C[i + 1]); PIN(C); SBAR()
  o[1] = MFMA32(pa0, PKF(fb.l0, fb.h0), o[1]); EX2(C0, 0);
  o[1] = MFMA32(pa1, PKF(fb.l1, fb.h1), o[1]); EX2(C0, 2);
  o[1] = MFMA32(pa2, PKF(fb.l2, fb.h2), o[1]); EX2(C0, 4);
  o[1] = MFMA32(pa3, PKF(fb.l3, fb.h3), o[1]); EX2(C0, 6);
  rdg<BASE, 3>(fb, vb); KLDP(ka, KSN, 0); KLDP(kb, KSN, 1); SBAR();
  o[2] = MFMA32(pa0, PKF(fa.l0, fa.h0), o[2]); EX2(C0, 8);
  o[2] = MFMA32(pa1, PKF(fa.l1, fa.h1), o[2]); EX2(C0, 10);
  o[2] = MFMA32(pa2, PKF(fa.l2, fa.h2), o[2]); EX2(C0, 12);
  o[2] = MFMA32(pa3, PKF(fa.l3, fa.h3), o[2]); EX2(C0, 14);
  o[3] = MFMA32(pa0, PKF(fb.l0, fb.h0), o[3]); EX2(C1, 0);
  o[3] = MFMA32(pa1, PKF(fb.l1, fb.h1), o[3]); EX2(C1, 2);
  o[3] = MFMA32(pa2, PKF(fb.l2, fb.h2), o[3]); EX2(C1, 4);
  o[3] = MFMA32(pa3, PKF(fb.l3, fb.h3), o[3]); EX2(C1, 6);
#undef EX2
}
template <int MODE>
__device__ __forceinline__ void attn_body(const bf16* __restrict__ Qb, const bf16* __restrict__ Kh, const bf16* __restrict__ Vh, bf16* __restrict__ Ob, int NT, char* lds, const Par P, const int tid) {
  static_assert(MODE == 0, "dense only");
  const int wid = __builtin_amdgcn_readfirstlane(tid >> 6), lane = tid & 63, r32 = lane & 31, hi = lane >> 5;
  float* ws = (float*)(lds + GA_WS) + wid * 64; float* li_l = ws; float* al_l = ws + 32;
  float m_reg = 0.f, l_reg = 0; f32x16 nm = {}; f32x16 o[4] = {}; bf16x8 qr[8];
  unsigned kof0, kof1, vof0, vof1;
  { const int rw0 = wid * 8 + (lane >> 4), rw1 = rw0 + 4; kof0 = (unsigned)(rw0 * LDK * 2 + (((lane & 15) ^ (rw0 & 7)) << 4)); kof1 = (unsigned)(rw1 * LDK * 2 + (((lane & 15) ^ (rw1 & 7)) << 4));
    const int s0 = wid * 4 + (lane >> 5), s1 = s0 + 2, kl = (lane & 31) >> 2, cl = (lane & 3) * 8;
    const int kk0 = (s0 >> 2) * 8 + kl, kk1 = (s1 >> 2) * 8 + kl, k0 = (kk0 & ~0xC) | ((kk0 & 4) << 1) | ((kk0 & 8) >> 1), k1 = (kk1 & ~0xC) | ((kk1 & 4) << 1) | ((kk1 & 8) >> 1);
    vof0 = (unsigned)(k0 * LDK * 2 + ((s0 & 3) * 32 + cl) * 2); vof1 = (unsigned)(k1 * LDK * 2 + ((s1 & 3) * 32 + cl) * 2); }
  const unsigned lds0 = (unsigned)(uintptr_t)lds;
  const unsigned kdst = (unsigned)__builtin_amdgcn_readfirstlane((int)(lds0 + GA_K + wid * 2048)), vdst = (unsigned)__builtin_amdgcn_readfirstlane((int)(lds0 + GA_V + wid * 2048));
#define DMA_K(t, slot) do { const char* g_ = (const char*)Kh + (size_t)(t) * (KVBLK * LDK * 2); glds16(g_, kof0, kdst + (slot) * GA_SLOT); glds16(g_, kof1, kdst + (slot) * GA_SLOT + 1024); } while (0)
#define DMA_V(t, slot) do { const char* g_ = (const char*)Vh + (size_t)(t) * (KVBLK * LDK * 2); glds16(g_, vof0, vdst + (slot) * GA_SLOT); glds16(g_, vof1, vdst + (slot) * GA_SLOT + 1024); } while (0)
#define WAIT_BAR(N) asm volatile("s_waitcnt vmcnt(" #N ") lgkmcnt(0)\n\ts_barrier" ::: "memory")
  DMA_K(0, 0); DMA_V(0, 0); DMA_K(1, 1); DMA_K(2, 2); DMA_V(1, 1); DMA_K(3, 3); DMA_V(2, 2);
  const unsigned qoff = (unsigned)((wid * QBLK + r32) * LDQ + hi * 8) * 2u;
  load_q<true>(qr, (const char*)Qb + qoff, P, wid * QBLK + r32, hi);
  const lds_ptr vb0 = (lds_ptr)(lds + GA_V) + v_rd_base(lane);
  lds_ptr kq[4];
#pragma unroll
  for (int i = 0; i < 4; ++i) kq[i] = (lds_ptr)(lds + GA_K) + KSWZ(r32, i * 32 + hi * 16);
  KF ka, kb;
#define RESC(a) do { if (__any((a) < 1.f)) { if (hi == 0) al_l[r32] = (a); asm volatile("s_waitcnt lgkmcnt(0)" ::: "memory"); \
    for (int d = 0; d < 4; ++d) for (int r = 0; r < 16; ++r) o[d][r] *= al_l[crow(r, hi)]; } } while (0)
  f32x16 pA0, pA1, pB0, pB1; float alA, alB; bf16x8 pa0, pa1, pa2, pa3;
#define STEP(C0, C1, AC, P0, P1, AP, j, KS, VS, DK, DV, CLAMP) do { \
    SBAR(); qk_softmax<KS>(C0, C1, ka, kb, kq, qr, nm, P0, P1, AP, l_reg, pa0, pa1, pa2, pa3); \
    { int tk = (j) + 3, tv = (j) + 2; if (CLAMP) { tk = tk < NT - 1 ? tk : NT - 1; tv = tv < NT - 1 ? tv : NT - 1; } DMA_K(tk, DK); DMA_V(tv, DV); } SBAR(); \
    pv_softmax<(VS) * GA_SLOT, ((KS) + 1) & 3>(o, vb0, pa0, pa1, pa2, pa3, C0, C1, m_reg, nm, AC, ka, kb, kq); \
    RESC(AC); WAIT_BAR(6); } while (0)
  WAIT_BAR(0);
  qkt_rel(pA0, pA1, (const bf16*)(lds + GA_K), qr, r32, hi, nm); partialSM_rel<true>(pA0, pA1, m_reg, nm, alA);
  KLDP(ka, 1, 0); KLDP(kb, 1, 1);
  WAIT_BAR(6);
  int j = 1;
  for (; j + 6 < NT; j += 4) {
    STEP(pB0, pB1, alB, pA0, pA1, alA, j,     1, 0, 0, 3, false);
    STEP(pA0, pA1, alA, pB0, pB1, alB, j + 1, 2, 1, 1, 0, false);
    STEP(pB0, pB1, alB, pA0, pA1, alA, j + 2, 3, 2, 2, 1, false);
    STEP(pA0, pA1, alA, pB0, pB1, alB, j + 3, 0, 3, 3, 2, false);
  }
  STEP(pB0, pB1, alB, pA0, pA1, alA, j,     1, 0, 0, 3, true);
  STEP(pA0, pA1, alA, pB0, pB1, alB, j + 1, 2, 1, 1, 0, true);
  STEP(pB0, pB1, alB, pA0, pA1, alA, j + 2, 3, 2, 2, 1, true);
  finishSM<8>(pB0, pB1, alB, l_reg, pa0, pa1, pa2, pa3); SBAR();
  pv_d0B<3 * GA_SLOT>(o, vb0, pa0, pa1, pa2, pa3);
  asm volatile("s_waitcnt vmcnt(0)" ::: "memory");
  if (hi == 0) li_l[r32] = l_reg; asm volatile("s_waitcnt lgkmcnt(0)" ::: "memory");
  float rli[16];
#pragma unroll
  for (int r = 0; r < 16; ++r) rli[r] = __builtin_amdgcn_rcpf(li_l[crow(r, hi)]);
  const unsigned ooff = (unsigned)((wid * QBLK + 4 * hi) * LDO + r32) * 2u;
#pragma unroll
  for (int r = 0; r < 16; ++r) { const int orow0 = (r & 3) + 8 * (r >> 2);
#pragma unroll
    for (int d0 = 0; d0 < 4; ++d0) *reinterpret_cast<bf16*>((char*)Ob + ooff + (unsigned)(orow0 * LDO + d0 * 32) * 2u) = (bf16)(cvtpk(o[d0][r] * rli[r], 0.f) & 0xffffu); }
  asm volatile("s_waitcnt lgkmcnt(0)\n\ts_barrier" ::: "memory");
#undef DMA_K
#undef DMA_V
#undef WAIT_BAR
#undef RESC
#undef STEP
}
__device__ __forceinline__ float sum16_dpp(float v) {
  v += __int_as_float(__builtin_amdgcn_update_dpp(0, __float_as_int(v), 0xB1, 0xF, 0xF, true));
  v += __int_as_float(__builtin_amdgcn_update_dpp(0, __float_as_int(v), 0x4E, 0xF, 0xF, true));
  v += __int_as_float(__builtin_amdgcn_update_dpp(0, __float_as_int(v), 0x141, 0xF, 0xF, true));
  v += __int_as_float(__builtin_amdgcn_update_dpp(0, __float_as_int(v), 0x140, 0xF, 0xF, true));
  return v;
}
__device__ __forceinline__ bf16x8 knorm8(bf16x8 raw, const float (&g)[8]) {
  float x[8]; float ss = 0.f;
#pragma unroll
  for (int e = 0; e < 8; ++e) { x[e] = __uint_as_float(((unsigned)(unsigned short)raw[e]) << 16); ss += x[e] * x[e]; }
  const float rstd = __builtin_amdgcn_rsqf(sum16_dpp(ss) * (1.0f / 128.0f) + 1e-6f);
  u32x4 w = {cvtpk(x[0] * (rstd * g[0]), x[1] * (rstd * g[1])), cvtpk(x[2] * (rstd * g[2]), x[3] * (rstd * g[3])), cvtpk(x[4] * (rstd * g[4]), x[5] * (rstd * g[5])), cvtpk(x[6] * (rstd * g[6]), x[7] * (rstd * g[7]))};
  return *reinterpret_cast<bf16x8*>(&w);
}
template <int MODE>
__device__ __forceinline__ void attn_body_simple(const bf16* __restrict__ Qb, const bf16* __restrict__ Kh, const bf16* __restrict__ Vh, bf16* __restrict__ Ob, int NT, char* lds, const Par P, const int tid) {
  const int wid = __builtin_amdgcn_readfirstlane(tid >> 6), lane = tid & 63, r32 = lane & 31, hi = lane >> 5;
  char* V_lds = lds; char* K_lds = lds + 2 * SHM_V;
  float* ws = (float*)(lds + 2 * SHM_V + 2 * SHM_K) + wid * 64; float* li_l = ws; float* al_l = ws + 32;
  const float* tbl = (const float*)(lds + TBL_OFF);
  float m_reg = NEG, l_reg = 0; f32x16 o[4] = {}; bf16x8 qr[8];
  const unsigned qoff = (unsigned)((wid * QBLK + r32) * LDQ + hi * 8) * 2u;
  load_q<false>(qr, (const char*)Qb + qoff, P, wid * QBLK + r32, hi);
  const int sr = tid >> 4, sc = (tid & 15) * 8, vst0 = v_st(sr, sc), vst1 = v_st(32 + sr, sc), kst0 = KSWZ(sr, sc * 2), kst1 = KSWZ(32 + sr, sc * 2);
  const unsigned kvo0 = (unsigned)(sr * LDK + sc) * 2u, kvo1 = kvo0 + (unsigned)(32 * LDK * 2);
  const int vb0 = (int)(uintptr_t)V_lds + v_rd_base(lane);
  bf16x8 vs0, vs1, ks0, ks1; float gk[8];
  { const float* gp = P.gk + sc;
#pragma unroll
    for (int e = 0; e < 8; ++e) gk[e] = gp[e]; }
#define SLD(k0) do { const char* vp_ = (const char*)Vh + (size_t)(k0) * (LDK * 2); const char* kp_ = (const char*)Kh + (size_t)(k0) * (LDK * 2); \
    vs0 = *reinterpret_cast<const bf16x8*>(vp_ + kvo0); vs1 = *reinterpret_cast<const bf16x8*>(vp_ + kvo1); ks0 = *reinterpret_cast<const bf16x8*>(kp_ + kvo0); ks1 = *reinterpret_cast<const bf16x8*>(kp_ + kvo1); } while (0)
  SLD(0);
  for (int jt = 0; jt < NT; ++jt) {
    const int b = jt & 1; char* Vb = V_lds + b * SHM_V; char* Kb = K_lds + b * SHM_K;
    *(bf16x8*)(Vb + vst0) = vs0; *(bf16x8*)(Vb + vst1) = vs1; *(bf16x8*)(Kb + kst0) = knorm8(ks0, gk); *(bf16x8*)(Kb + kst1) = knorm8(ks1, gk);
    if (jt + 1 < NT) SLD((jt + 1) * KVBLK);
    __syncthreads();
    bool need;
    if constexpr (MODE == 1) { const int kb = P.kpos0 + 64 * jt, qlo = P.qpos0 + wid * 32; need = (kb + 63 >= qlo - 128) && (kb <= qlo + 31 + 128); }
    else { const int r = P.r0 + (wid >> 1); int rs = r - 4; rs = rs < 0 ? 0 : rs; rs = rs > P.rows - 8 ? P.rows - 8 : rs; need = (unsigned)(P.kr0 + jt - rs) < 8u; }
    if (!need) continue;
    f32x16 p0, p1; float mn, alpha; bf16x8 pa0, pa1, pa2, pa3;
    qkt(p0, p1, (const bf16*)Kb, qr, r32, hi); modify<MODE>(p0, p1, jt, P, wid, r32, hi, tbl);
    partialSM(p0, p1, m_reg, mn, alpha);
    if (__any(alpha < 1.f)) { if (hi == 0) al_l[r32] = alpha; asm volatile("s_waitcnt lgkmcnt(0)" ::: "memory");
      for (int d = 0; d < 4; ++d) for (int r = 0; r < 16; ++r) o[d][r] *= al_l[crow(r, hi)]; }
    finishSM(p0, p1, alpha, l_reg, pa0, pa1, pa2, pa3);
    pv_d0(o, vb0 + b * (int)SHM_V, pa0, pa1, pa2, pa3);
  }
  if constexpr (MODE == 1) l_reg += __builtin_amdgcn_exp2f((P.sinkR - m_reg) * (SCALE * 1.4426950408889634f));
  if (hi == 0) li_l[r32] = l_reg; asm volatile("s_waitcnt lgkmcnt(0)" ::: "memory");
  float rli[16];
#pragma unroll
  for (int r = 0; r < 16; ++r) rli[r] = __builtin_amdgcn_rcpf(li_l[crow(r, hi)]);
  const unsigned ooff = (unsigned)((wid * QBLK + 4 * hi) * LDO + r32) * 2u;
#pragma unroll
  for (int r = 0; r < 16; ++r) { const int orow0 = (r & 3) + 8 * (r >> 2);
#pragma unroll
    for (int d0 = 0; d0 < 4; ++d0) *reinterpret_cast<bf16*>((char*)Ob + ooff + (unsigned)(orow0 * LDO + d0 * 32) * 2u) = (bf16)(cvtpk(o[d0][r] * rli[r], 0.f) & 0xffffu); }
  __syncthreads();
#undef SLD
}
#undef KSWZ
#undef SBAR
#undef MX3
#undef PIN
#undef PKF
#undef MFMA32
#undef KLDP
}

constexpr int NWAVES = 8;
constexpr int DM = 2048, DFF = 5632, DIN = 6144, HD = 128, NLAYER = 2;
constexpr int MTOT = 65536, MC = 32768, NCHUNK = 2;
constexpr float EPS = 1e-6f;
constexpr int C_QA = 0, C_KA = 1024, C_VA = 2048, C_QB = 3072, C_KB = 4096, C_VB = 4352, C_QC = 4608, C_KC = 5632, C_VC = 5888;
constexpr size_t MiB = 1u << 20;
constexpr size_t WS_CTL = 0, CTL_ZERO_BYTES = 1 * MiB;
constexpr size_t WS_ROPE = 1 * MiB;
constexpr size_t WS_W = 2 * MiB;
constexpr size_t W13_BYTES = (size_t)2 * DFF * DM * 2, WD_BYTES = (size_t)DM * DFF * 2, WIN_BYTES = (size_t)DIN * DM * 2, WGATE_BYTES = (size_t)3 * DM * DM * 2,
                 WBR_BYTES = (size_t)3 * DM * 1024 * 2, WOUT3_BYTES = (size_t)DM * DM * 2;
constexpr size_t LW_W13_1 = 0, LW_WD_1 = LW_W13_1 + W13_BYTES, LW_WIN = LW_WD_1 + WD_BYTES, LW_WGATE = LW_WIN + WIN_BYTES, LW_WBR = LW_WGATE + WGATE_BYTES,
                 LW_WOUT3 = LW_WBR + WBR_BYTES, LW_W13_2 = LW_WOUT3 + WOUT3_BYTES, LW_WD_2 = LW_W13_2 + W13_BYTES, LAYER_W_BYTES = LW_WD_2 + WD_BYTES;
constexpr size_t WS_H = WS_W + NLAYER * LAYER_W_BYTES;
constexpr size_t WS_QKV = WS_H + (size_t)MC * DM * 2;
constexpr size_t WS_BB = WS_QKV;
constexpr size_t WS_O = WS_QKV + (size_t)MC * DIN * 2;
constexpr size_t WS_MRG = WS_O;
constexpr size_t WS_SSQ = WS_O + (size_t)MC * 3072 * 2;
constexpr size_t WS_SCR = WS_SSQ + (size_t)MC * 32 * 4;
constexpr size_t WS_END = WS_SCR + (size_t)304 * 262144;
static_assert(LAYER_W_BYTES % 256 == 0 && WS_H % 256 == 0, "ws map alignment");
constexpr int CW_BAR = 4096;
constexpr int RING_OFF = 0, RING_BYTES = 131072;
constexpr int LDSCTL_OFF = RING_BYTES, MISC_OFF = LDSCTL_OFF + 320, RTAB_OFF = LDSCTL_OFF + 1024;
constexpr int LDS_BYTES = 147456;
static_assert(RING_OFF == 0 && att::GA_WS >= RTAB_OFF + 2048 && att::GA_WS + att::NW * 256 <= LDS_BYTES && att::GA_V + 4 * att::GA_SLOT <= RING_BYTES, "the dense attention rings fill the stage ring; its per-wave scratch sits behind the row-scale tables");

#define GAS __attribute__((address_space(1)))
#define LAS __attribute__((address_space(3)))
typedef unsigned short bf16;
typedef unsigned v4u __attribute__((ext_vector_type(4)));
typedef unsigned v2u __attribute__((ext_vector_type(2)));
typedef float f32x4 __attribute__((ext_vector_type(4)));
typedef GAS unsigned gu32;
#define LDS_WAIT() asm volatile("s_waitcnt lgkmcnt(0)" ::: "memory")
#define VM_WAIT() asm volatile("s_waitcnt vmcnt(0)" ::: "memory")
__device__ __forceinline__ unsigned f2bf(float f) { unsigned u = __builtin_bit_cast(unsigned, f); return (u + 0x7fffu + ((u >> 16) & 1u)) >> 16; }
__device__ __forceinline__ unsigned pk2(float lo, float hi) { return f2bf(lo) | (f2bf(hi) << 16); }

__device__ __forceinline__ int launder_s(int x) { asm volatile("" : "+s"(x)); return x; }
__device__ __forceinline__ int launder_v(int x) { asm volatile("" : "+v"(x)); return x; }
__device__ __forceinline__ int lane_id_local() { unsigned m = ~0u; asm volatile("" : "+s"(m)); return (int)__builtin_amdgcn_mbcnt_hi(m, __builtin_amdgcn_mbcnt_lo(m, 0u)); }

#define XB_TMO      128
#define XB_XCNT(j)  (256  + 64 * (j))
#define XB_XSUB(j)  (1280 + 64 * (j))
#define XB_XGEN(j)  (2304 + 64 * (j))
#define XB_TOP      3328
#define XB_TOPGEN   3392
#define XCD_BAR_WORDS 3456
#define XB_SPIN_CAP (1u << 22)

__device__ __forceinline__ unsigned xb_ld(unsigned* p)              { return __hip_atomic_load(p, __ATOMIC_RELAXED, __HIP_MEMORY_SCOPE_AGENT); }
__device__ __forceinline__ unsigned xb_add(unsigned* p, unsigned v) { return __hip_atomic_fetch_add(p, v, __ATOMIC_RELAXED, __HIP_MEMORY_SCOPE_AGENT); }
__device__ __forceinline__ unsigned xb_xcc_id() { return (unsigned)__builtin_amdgcn_s_getreg((3 << 11) | 20) & 0xFu; }
#define XB_SPIN(cond, bar) do { unsigned _sp = 0; while (cond) { __builtin_amdgcn_s_sleep(1); \
    if ((++_sp & 255u) == 0u) { if (xb_ld(&(bar)[XB_TMO])) break; if (_sp > XB_SPIN_CAP) { atomicAdd(&(bar)[XB_TMO], 1u); break; } } } } while (0)

struct XcdBarrier { unsigned* bar; unsigned x; volatile LAS unsigned* st; };

__device__ __forceinline__ XcdBarrier xcd_barrier_post(unsigned* bar, volatile LAS unsigned* st) {
    XcdBarrier b; b.bar = bar; b.x = xb_xcc_id(); b.st = st;
    if (threadIdx.x == 0) (void)xb_add(&bar[XB_XCNT(b.x)], 1u);
    return b;
}
__device__ __forceinline__ void xcd_barrier_complete(unsigned* bar, unsigned x, unsigned& nloc, unsigned& nx) {
    const unsigned G = gridDim.x * gridDim.y * gridDim.z;
    unsigned sum, cnt, mine, sp = 0u;
    for (;;) {
        sum = 0u; cnt = 0u; mine = 0u;
#pragma unroll
        for (unsigned j = 0; j < 16; ++j) { const unsigned c = xb_ld(&bar[XB_XCNT(j)]); sum += c; cnt += (c > 0u) ? 1u : 0u; mine = (j == x) ? c : mine; }
        if (sum == G) break;
        __builtin_amdgcn_s_sleep(1);
        if ((++sp & 255u) == 0u) { if (xb_ld(&bar[XB_TMO])) break; if (sp > XB_SPIN_CAP) { atomicAdd(&bar[XB_TMO], 1u); break; } }
    }
    nloc = mine > 0u ? mine : 1u; nx = cnt > 0u ? cnt : 1u;
}
__device__ __forceinline__ void xcd_barrier(const XcdBarrier& b, const int wave_s) {
    asm volatile("s_waitcnt vmcnt(0)" ::: "memory");
    __syncthreads();
    if (launder_s(wave_s) == 0 && lane_id_local() == 0) {
        unsigned* bar = b.bar; unsigned bx_ = b.x; asm volatile("" : "+s"(bar), "+s"(bx_));
        __builtin_amdgcn_s_waitcnt(0);
        unsigned nloc = b.st[0], nx = b.st[1];
        if (nloc == 0u) { xcd_barrier_complete(bar, bx_, nloc, nx); b.st[0] = nloc; b.st[1] = nx; }
        const unsigned old = xb_add(&bar[XB_XSUB(bx_)], 1u);
        const unsigned gen = old / nloc;
        if (old + 1u == (gen + 1u) * nloc) {
            __builtin_amdgcn_fence(__ATOMIC_RELEASE, "agent");
            asm volatile("s_waitcnt vmcnt(0)" ::: "memory");
            const unsigned og = xb_add(&bar[XB_TOP], 1u);
            const unsigned tg = og / nx;
            if (og + 1u == (tg + 1u) * nx) xb_add(&bar[XB_TOPGEN], 1u);
            else XB_SPIN(xb_ld(&bar[XB_TOPGEN]) == tg, bar);
            __builtin_amdgcn_fence(__ATOMIC_ACQUIRE, "agent");
            xb_add(&bar[XB_XGEN(bx_)], 1u);
            asm volatile("s_waitcnt vmcnt(0)" ::: "memory");
        } else {
            XB_SPIN(xb_ld(&bar[XB_XGEN(bx_)]) == gen, bar);
            __builtin_amdgcn_fence(__ATOMIC_ACQUIRE, "agent");
            asm volatile("s_waitcnt vmcnt(0)" ::: "memory");
        }
    }
    __syncthreads();
}

using pg8::shx;
__device__ __forceinline__ float wave_sum(float v, int lane) {
#pragma unroll
    for (int o = 1; o < 64; o <<= 1) v += shx(v, o, lane);
    return v;
}
__device__ __forceinline__ void row_to_xb(const float* xrow, bf16* orow, float* ssqrow, int lane) {
    const GAS f32x4* xr = (const GAS f32x4*)xrow + lane;
    f32x4 v[8]; float s = 0.f;
#pragma unroll
    for (int j = 0; j < 8; ++j) { v[j] = xr[64 * j]; s += (v[j].x * v[j].x + v[j].y * v[j].y) + (v[j].z * v[j].z + v[j].w * v[j].w); }
    s = wave_sum(s, lane);
    GAS v2u* o8 = (GAS v2u*)orow + lane;
#pragma unroll
    for (int j = 0; j < 8; ++j) { v2u w; w.x = pk2(v[j].x, v[j].y); w.y = pk2(v[j].z, v[j].w); o8[64 * j] = w; }
    if (lane < pg8::NSSQ) ssqrow[lane] = lane == 0 ? s : 0.f;
}

constexpr int CV_PITCH = 144, CV_STAGE = 64 * CV_PITCH;
__device__ __forceinline__ void convert_item(const float* W, int K, int N, bf16* dst, int ldd, int mode, const float* gain, int item, int lane, char* stg) {
    const int nbn = N >> 6, kb = item / nbn, n0 = (item - kb * nbn) << 6, k0 = kb << 6, kq = lane >> 4, nq = lane & 15;
    bf16* dp;
    if (mode == 2) dp = dst + (((size_t)(n0 >> 8) * (K >> 6) + kb) * 256 + (n0 & 255)) * 64;
    else dp = dst + (size_t)(mode ? ((n0 >> 7) * 256 + (n0 & 127)) : n0) * ldd + k0;
    const int rp = (mode == 2) ? 64 : ldd;
    const float* wp = W + (size_t)(k0 + 16 * kq) * N + n0 + 4 * nq; const float* gp = gain ? gain + k0 + 16 * kq : nullptr;
    f32x4 v[16];
#pragma unroll
    for (int j = 0; j < 16; ++j) { const float gk = gp ? gp[j] : 1.0f; v[j] = *(const GAS f32x4*)(wp + (size_t)j * N) * gk; }
    char* sp = stg + (4 * nq) * CV_PITCH + (16 * kq) * 2;
#pragma unroll
    for (int e = 0; e < 4; ++e)
#pragma unroll
        for (int h = 0; h < 2; ++h) { v4u o; o.x = pg8::cvt_pk_bf16(v[8 * h + 0][e], v[8 * h + 1][e]); o.y = pg8::cvt_pk_bf16(v[8 * h + 2][e], v[8 * h + 3][e]);
            o.z = pg8::cvt_pk_bf16(v[8 * h + 4][e], v[8 * h + 5][e]); o.w = pg8::cvt_pk_bf16(v[8 * h + 6][e], v[8 * h + 7][e]); *(v4u*)(sp + e * CV_PITCH + h * 16) = o; }
    asm volatile("" ::: "memory");
    const char* rdp = stg + (lane >> 3) * CV_PITCH + (lane & 7) * 16; char* op = (char*)dp + (size_t)(lane >> 3) * rp * 2 + (lane & 7) * 16;
#pragma unroll
    for (int i = 0; i < 8; ++i) { const v4u o = *(const v4u*)(rdp + i * 8 * CV_PITCH); *(GAS v4u*)(op + (size_t)i * 8 * rp * 2) = o; }
    asm volatile("" ::: "memory");
}

struct Args { const float* in[23]; float* out; unsigned char* ws; int ph_lo, ph_hi, pad0, pad1; };
constexpr int NPH_PER = 13, NPHASE = 1 + NCHUNK * NLAYER * NPH_PER;
typedef const __attribute__((address_space(4))) Args* KArgs;
__device__ __forceinline__ KArgs kargs() { unsigned long long p = (unsigned long long)__builtin_amdgcn_kernarg_segment_ptr(); asm volatile("" : "+s"(p)); return (KArgs)p; }

constexpr int CV_FFN = (DM / 64) * (DFF / 64), CV_WIN = (DM / 64) * (DIN / 64), CV_SQ = (DM / 64) * (DM / 64), CV_BR = (1024 / 64) * (DM / 64), CV_LAYER = 6 * CV_FFN + CV_WIN + 3 * CV_SQ + 3 * CV_BR + CV_SQ;
__device__ __forceinline__ void convert_flat(KArgs ap, unsigned char* ws, int g, int lane, char* stg) {
    const int l = g / CV_LAYER; int r = g - l * CV_LAYER;
    unsigned char* wl = ws + WS_W + (size_t)l * LAYER_W_BYTES;
    const float* g1 = ap->in[2] + l * DM; const float* gm = ap->in[6] + l * DM; const float* g2 = ap->in[19] + l * DM;
    if (r < CV_FFN) { convert_item(ap->in[3] + (size_t)l * DM * DFF, DM, DFF, (bf16*)(wl + LW_W13_1), DM, 1, g1, r, lane, stg); return; } r -= CV_FFN;
    if (r < CV_FFN) { convert_item(ap->in[4] + (size_t)l * DM * DFF, DM, DFF, (bf16*)(wl + LW_W13_1) + (size_t)128 * DM, DM, 1, g1, r, lane, stg); return; } r -= CV_FFN;
    if (r < CV_FFN) { convert_item(ap->in[5] + (size_t)l * DFF * DM, DFF, DM, (bf16*)(wl + LW_WD_1), DFF, 2, nullptr, r, lane, stg); return; } r -= CV_FFN;
    if (r < CV_WIN) { convert_item(ap->in[7] + (size_t)l * DM * DIN, DM, DIN, (bf16*)(wl + LW_WIN), DM, 0, gm, r, lane, stg); return; } r -= CV_WIN;
    if (r < 3 * CV_SQ) { const int i = r / CV_SQ; convert_item(ap->in[8] + (size_t)(l * 3 + i) * DM * DM, DM, DM, (bf16*)(wl + LW_WGATE) + (size_t)i * DM * DM, DM, 0, gm, r - CV_SQ * i, lane, stg); return; } r -= 3 * CV_SQ;
    if (r < 3 * CV_BR) { const int i = r / CV_BR; convert_item(ap->in[17] + (size_t)(l * 3 + i) * 1024 * DM, 1024, DM, (bf16*)(wl + LW_WBR) + (size_t)i * DM * 1024, 1024, 0, nullptr, r - CV_BR * i, lane, stg); return; } r -= 3 * CV_BR;
    if (r < CV_SQ) { convert_item(ap->in[18] + (size_t)l * DM * DM, DM, DM, (bf16*)(wl + LW_WOUT3), DM, 0, nullptr, r, lane, stg); return; } r -= CV_SQ;
    if (r < CV_FFN) { convert_item(ap->in[20] + (size_t)l * DM * DFF, DM, DFF, (bf16*)(wl + LW_W13_2), DM, 1, g2, r, lane, stg); return; } r -= CV_FFN;
    if (r < CV_FFN) { convert_item(ap->in[21] + (size_t)l * DM * DFF, DM, DFF, (bf16*)(wl + LW_W13_2) + (size_t)128 * DM, DM, 1, g2, r, lane, stg); return; } r -= CV_FFN;
    convert_item(ap->in[22] + (size_t)l * DFF * DM, DFF, DM, (bf16*)(wl + LW_WD_2), DFF, 2, nullptr, r, lane, stg);
}
#define PH_PRE \
    const int wave = launder_s(wave_s); const int lane = lane_id_local(); const int tid = wave * 64 + lane; (void)lane; (void)wave; \
    const KArgs ap = kargs(); const int bx = launder_s((int)blockIdx.x), G = launder_s((int)gridDim.x); \
    const int vcu = (G % 8 == 0) ? (bx % 8) * (G / 8) + bx / 8 : bx; const int gw = vcu * NWAVES + wave, NGW = G * NWAVES; (void)gw; (void)NGW; \
    unsigned char* const ws = ap->ws; (void)ws;
#define PH_PRE_CL \
    PH_PRE \
    const int c2 = launder_s(cl); const int chunk = c2 >> 1, layer = c2 & 1; (void)chunk; (void)layer; \
    const int S = chunk < 1 ? 8192 : 4096; (void)S; \
    float* const xo = ap->out + (size_t)chunk * MC * DM; (void)xo; \
    unsigned char* const wl = ws + WS_W + (size_t)layer * LAYER_W_BYTES; (void)wl; \
    float* const SSQ = (float*)(ws + WS_SSQ); (void)SSQ; bf16* const Hb = (bf16*)(ws + WS_H); bf16* const QKV = (bf16*)(ws + WS_QKV); bf16* const BB = (bf16*)(ws + WS_BB); bf16* const Ob = (bf16*)(ws + WS_O); (void)Hb; (void)QKV; (void)BB; (void)Ob;
#define XIN_PTR (chunk < 1 ? ap->in[0] : ap->in[1])

__global__ void __launch_bounds__(NWAVES * 64, 2) mk_fwd(Args args) {
    extern __shared__ __attribute__((aligned(16))) unsigned char lds[];
    LAS unsigned char* const ldsL = (LAS unsigned char*)lds;
    volatile LAS unsigned* const MISC = (volatile LAS unsigned*)(ldsL + MISC_OFF);
    const int wave_s = __builtin_amdgcn_readfirstlane((int)threadIdx.x >> 6);
    for (int u = threadIdx.x; u < (LDS_BYTES - LDSCTL_OFF) / 4; u += NWAVES * 64) ((LAS unsigned*)(ldsL + LDSCTL_OFF))[u] = 0u;
    __syncthreads();
    XcdBarrier bar = xcd_barrier_post((unsigned*)((gu32*)(args.ws + WS_CTL) + CW_BAR), MISC + 8);
    const int lo = args.ph_lo, hi = args.ph_hi;
#define IN(k) (lo <= (k) && (k) < hi)
#define SEAM(k) do { if (IN(k) && IN((k) + 1)) xcd_barrier(bar, wave_s); } while (0)

    if (IN(0)) {
        PH_PRE
        { char* const stg = (char*)lds + RING_OFF + wave * CV_STAGE;
          for (int g = gw; g < NLAYER * CV_LAYER; g += NGW) convert_flat(ap, ws, g, lane, stg); }
        { float* rope = (float*)(ws + WS_ROPE); const int gt = bx * (NWAVES * 64) + tid;
          if (gt < 128 * 32) { const int pos = gt >> 5, j = gt & 31;
              double f = 1.0; for (int q = 0; q < j; ++q) f *= 0.74989420933245582730;
              const double x2 = f * f; double c = 1.0, s = f, tc = 1.0, ts = f;
              for (int n = 1; n <= 12; ++n) { tc *= -x2 / (double)((2 * n - 1) * (2 * n)); c += tc; ts *= -x2 / (double)((2 * n) * (2 * n + 1)); s += ts; }
              double cr = 1.0, si = 0.0; for (int q = 0; q < pos; ++q) { const double t = cr * c - si * s; si = cr * s + si * c; cr = t; }
              rope[2 * gt] = (float)cr; rope[2 * gt + 1] = (float)si; } }
    }
    SEAM(0);

    for (int cl = 0; cl < NCHUNK * NLAYER; ++cl) {
        const int pb = 1 + cl * NPH_PER;
        if (hi <= pb || lo >= pb + NPH_PER) continue;

        if (IN(pb + 0) && (cl & 1) == 0) { PH_PRE_CL const float* x0 = XIN_PTR;
            for (int m = gw; m < MC; m += NGW) row_to_xb(x0 + (size_t)m * DM, Hb + (size_t)m * DM, SSQ + (size_t)m * pg8::NSSQ, lane); }
        if ((cl & 1) == 0) SEAM(pb + 0);
        if (IN(pb + 1)) { PH_PRE_CL pg8::Gemm g{Hb, (const bf16*)(wl + LW_W13_1), MC, 2 * DFF, DM, DM, DM, 0, 0, 0, 0}; pg8::RsOrder So; So.init(MC, 2 * DFF, G, bx); So.ssq = SSQ; So.tab = (LAS float*)(ldsL + RTAB_OFF); So.inv_ncol = 1.0f / DM; So.eps = EPS; So.tid = tid;
            pg8::EpiSwiglu E{QKV, DFF, (const LAS float*)(ldsL + RTAB_OFF)}; pg8::gemm_phase<pg8::EpiSwiglu, pg8::RsOrder, true, true>(ldsL + RING_OFF, g, So, E, tid); }
        SEAM(pb + 1);
        if (IN(pb + 2)) { PH_PRE_CL
            pg8::Gemm g{QKV, (const bf16*)(wl + LW_WD_1), MC, DM, DFF, DFF, DFF, 0, 0, 1, 1}; pg8::StaticOrder So; So.init(MC, DM, G, bx);
            pg8::EpiResidX E{Hb, nullptr, SSQ, DM, 0.5f}; pg8::gemm_phase<pg8::EpiResidX, pg8::StaticOrder, true, true>(ldsL + RING_OFF, g, So, E, tid); }
        SEAM(pb + 2);
        if (IN(pb + 4)) { PH_PRE_CL pg8::Gemm g{Hb, (const bf16*)(wl + LW_WIN), MC, DIN, DM, DM, DM, 0, 0, 0, 0}; pg8::RsOrder So; So.init(MC, DIN, G, bx); So.ssq = SSQ; So.tab = (LAS float*)(ldsL + RTAB_OFF); So.inv_ncol = 1.0f / DM; So.eps = EPS; So.tid = tid;
            pg8::EpiBf16 E{QKV, DIN, (const LAS float*)(ldsL + RTAB_OFF)}; pg8::gemm_phase<pg8::EpiBf16, pg8::RsOrder, true, true>(ldsL + RING_OFF, g, So, E, tid); }
        SEAM(pb + 4);
        if (IN(pb + 5)) { PH_PRE_CL
            const float* rope = (const float*)(ws + WS_ROPE);
            const int sub = lane >> 4, t16 = lane & 15;
            for (int task = gw; task < MC / 2; task += NGW) {
                const int m = task * 2 + (sub >> 1), hidx = sub & 1;
                const int cb = 32 + hidx; const float* gp = ap->in[13] + layer * HD + 8 * t16;
                GAS v4u* p = (GAS v4u*)(QKV + (size_t)m * DIN + cb * 128 + 8 * t16);
                const v4u raw = *p;
                float x[8] = {pg8::bf_lo(raw.x), pg8::bf_hi(raw.x), pg8::bf_lo(raw.y), pg8::bf_hi(raw.y), pg8::bf_lo(raw.z), pg8::bf_hi(raw.z), pg8::bf_lo(raw.w), pg8::bf_hi(raw.w)};
                float ss = 0.f;
#pragma unroll
                for (int i = 0; i < 8; ++i) ss += x[i] * x[i];
                ss += shx(ss, 1, lane); ss += shx(ss, 2, lane); ss += shx(ss, 4, lane); ss += shx(ss, 8, lane);
                const float rstd = __builtin_amdgcn_rsqf(ss * (1.f / HD) + EPS);
                const f32x4 g0 = *(const GAS f32x4*)gp, g1 = *(const GAS f32x4*)(gp + 4);
                x[0] *= rstd * g0.x; x[1] *= rstd * g0.y; x[2] *= rstd * g0.z; x[3] *= rstd * g0.w; x[4] *= rstd * g1.x; x[5] *= rstd * g1.y; x[6] *= rstd * g1.z; x[7] *= rstd * g1.w;
                float y[8];
                { const int tpos = m % S, pos = (t16 & 8) ? (tpos & 63) : (tpos >> 6);
                    const bool first = (t16 & 4) == 0; const int j0 = 8 * (t16 & 3);
                    const GAS f32x4* rt = (const GAS f32x4*)(rope + ((size_t)pos * 32 + j0) * 2);
                    const f32x4 cs0 = rt[0], cs1 = rt[1], cs2 = rt[2], cs3 = rt[3];
                    const float cc[8] = {cs0.x, cs0.z, cs1.x, cs1.z, cs2.x, cs2.z, cs3.x, cs3.z}, sn[8] = {cs0.y, cs0.w, cs1.y, cs1.w, cs2.y, cs2.w, cs3.y, cs3.w};
#pragma unroll
                    for (int i = 0; i < 8; ++i) { const float other = shx(x[i], 4, lane); y[i] = x[i] * cc[i] + (first ? -other : other) * sn[i]; }
                }
                v4u w; w.x = pk2(y[0], y[1]); w.y = pk2(y[2], y[3]); w.z = pk2(y[4], y[5]); w.w = pk2(y[6], y[7]);
                *p = w;
            }
        }
        SEAM(pb + 5);
        if (IN(pb + 6)) {
          { PH_PRE_CL
            const int nqb = S / 256, nunit = MC / 256 * 8;
            for (int u = vcu; u < nunit; u += G) {
                const int qb = u % nqb, h = (u / nqb) % 8, sq = u / (nqb * 8); const int kvh = h >> 2;
                const size_t row0 = (size_t)sq * S;
                att::Par P{0, 0, 0, 0, 0, 0.f, 0.f, ap->in[12] + layer * HD, (const float*)(ws + WS_ROPE), qb * 256};
                att::attn_body<0>(QKV + (row0 + (size_t)qb * 256) * DIN + C_QB + h * 128, QKV + row0 * DIN + C_KB + kvh * 128, QKV + row0 * DIN + C_VB + kvh * 128,
                                  Ob + (row0 + (size_t)qb * 256) * 3072 + 1024 + h * 128, S / 64, (char*)lds + RING_OFF, P, launder_s(wave_s) * 64 + lane_id_local());
            } }
          { PH_PRE_CL
            const int rows = S / 64, nqb = S / 256, nunit = MC / 256 * 8;
            for (int u = vcu; u < nunit; u += G) {
                const int qb = u % nqb, h = (u / nqb) % 8, sq = u / (nqb * 8);
                const size_t row0 = (size_t)sq * S;
                int kr0 = qb * 4 - 4; kr0 = kr0 < 0 ? 0 : kr0; kr0 = kr0 > rows - 12 ? rows - 12 : kr0;
                { const float* rb = ap->in[11] + (size_t)(layer * 8 + h) * 465; float* tb = (float*)((char*)lds + RING_OFF + att::TBL_OFF);
                  if (tid < 480) { const int rr = tid >> 5, cc = tid & 31; tb[tid] = (cc < 31) ? rb[rr * 31 + cc] * (1.0f / att::SCALE) : att::NEG; } }
                att::Par P{0, 0, qb * 4, rows, kr0, 0.f, 0.f, ap->in[9] + layer * HD, nullptr, qb * 256, ap->in[10] + layer * HD};
                att::attn_body_simple<2>(QKV + (row0 + (size_t)qb * 256) * DIN + C_QA + h * 128, QKV + (row0 + (size_t)kr0 * 64) * DIN + C_KA + h * 128, QKV + (row0 + (size_t)kr0 * 64) * DIN + C_VA + h * 128,
                                  Ob + (row0 + (size_t)qb * 256) * 3072 + h * 128, 12, (char*)lds + RING_OFF, P, tid);
            } }
          { PH_PRE_CL
            const int nqb = S / 256, nunit = MC / 256 * 8;
            for (int u = vcu; u < nunit; u += G) {
                const int qb = u % nqb, h = (u / nqb) % 8, sq = u / (nqb * 8); const int kvh = h >> 2;
                const size_t row0 = (size_t)sq * S;
                int ks = qb * 256 - 128; ks = ks < 0 ? 0 : ks; ks = ks > S - 512 ? S - 512 : ks;
                const float slope = exp2f(-(float)(h + 1)), sink = ap->in[16][layer * 8 + h];
                att::Par P{qb * 256, ks, 0, 0, 0, slope * (1.0f / att::SCALE), sink * (1.0f / att::SCALE), ap->in[14] + layer * HD, nullptr, qb * 256, ap->in[15] + layer * HD};
                att::attn_body_simple<1>(QKV + (row0 + (size_t)qb * 256) * DIN + C_QC + h * 128, QKV + (row0 + (size_t)ks) * DIN + C_KC + kvh * 128, QKV + (row0 + (size_t)ks) * DIN + C_VC + kvh * 128,
                                  Ob + (row0 + (size_t)qb * 256) * 3072 + 2048 + h * 128, 8, (char*)lds + RING_OFF, P, tid);
            } }
        }
        SEAM(pb + 6);
        if (IN(pb + 7)) { PH_PRE_CL pg8::Gemm g{Ob, (const bf16*)(wl + LW_WBR), MC, DIN, 1024, 3072, 1024, 8, 1024, 0, 0}; pg8::StaticOrder So; So.init(MC, DIN, G, bx);
            pg8::EpiTileImg E{BB, DIN / 256, tid}; pg8::gemm_phase<pg8::EpiTileImg, pg8::StaticOrder, true, true>(ldsL + RING_OFF, g, So, E, tid); }
        SEAM(pb + 7);
        if (IN(pb + 8)) { PH_PRE_CL pg8::Gemm g{Hb, (const bf16*)(wl + LW_WGATE), MC, DIN, DM, DM, DM, 0, 0, 0, 0}; pg8::TriOrder So; So.init3(MC, DM, G, bx); So.ssq = SSQ; So.tab = (LAS float*)(ldsL + RTAB_OFF); So.inv_ncol = 1.0f / DM; So.eps = EPS; So.tid = tid;
            pg8::EpiGateAcc E{BB, DIN / 256, (float*)(ws + WS_SCR) + (size_t)bx * 65536, (bf16*)(ws + WS_MRG), DM, (const LAS float*)(ldsL + RTAB_OFF), tid, DM / 256};
            pg8::gemm_phase<pg8::EpiGateAcc, pg8::TriOrder, true, true>(ldsL + RING_OFF, g, So, E, tid); }
        SEAM(pb + 8);
        if (IN(pb + 9)) { PH_PRE_CL pg8::Gemm g{(const bf16*)(ws + WS_MRG), (const bf16*)(wl + LW_WOUT3), MC, DM, DM, DM, DM, 0, 0, 0, 0}; pg8::StaticOrder So; So.init(MC, DM, G, bx);
            pg8::EpiResidX E{Hb, nullptr, SSQ, DM, 1.0f}; pg8::gemm_phase<pg8::EpiResidX, pg8::StaticOrder, true, true>(ldsL + RING_OFF, g, So, E, tid); }
        SEAM(pb + 9);
        if (IN(pb + 11)) { PH_PRE_CL pg8::Gemm g{Hb, (const bf16*)(wl + LW_W13_2), MC, 2 * DFF, DM, DM, DM, 0, 0, 0, 0}; pg8::RsOrder So; So.init(MC, 2 * DFF, G, bx); So.ssq = SSQ; So.tab = (LAS float*)(ldsL + RTAB_OFF); So.inv_ncol = 1.0f / DM; So.eps = EPS; So.tid = tid;
            pg8::EpiSwiglu E{QKV, DFF, (const LAS float*)(ldsL + RTAB_OFF)}; pg8::gemm_phase<pg8::EpiSwiglu, pg8::RsOrder, true, true>(ldsL + RING_OFF, g, So, E, tid); }
        SEAM(pb + 11);
        if (IN(pb + 12)) { PH_PRE_CL pg8::Gemm g{QKV, (const bf16*)(wl + LW_WD_2), MC, DM, DFF, DFF, DFF, 0, 0, 1, 1}; pg8::StaticOrder So; So.init(MC, DM, G, bx);
            pg8::EpiResidX E{Hb, (layer == NLAYER - 1) ? xo : nullptr, SSQ, DM, 0.5f}; pg8::gemm_phase<pg8::EpiResidX, pg8::StaticOrder, true, true>(ldsL + RING_OFF, g, So, E, tid); }
        SEAM(pb + 12);
    }
#undef IN
#undef SEAM
}

extern "C" void kernel_launch(void* const* d_in, const int* in_sizes, int n_in, void* d_out, int out_size, void* d_ws, size_t ws_size, hipStream_t stream) {
    static int grid = 0;
    if (grid == 0) {
        if (n_in != 23 || out_size != MTOT * DM || ws_size < WS_END) { fprintf(stderr, "kernel_launch: unexpected shapes: n_in %d out %d ws %zu (need %zu)\n", n_in, out_size, ws_size, (size_t)WS_END); grid = -1; return; }
        int dev = 0, cus = 0, per_cu = 0;
        if (hipGetDevice(&dev) != hipSuccess || hipDeviceGetAttribute(&cus, hipDeviceAttributeMultiprocessorCount, dev) != hipSuccess) { grid = -1; return; }
        if (hipFuncSetAttribute((const void*)mk_fwd, hipFuncAttributeMaxDynamicSharedMemorySize, LDS_BYTES) != hipSuccess) { fprintf(stderr, "kernel_launch: hipFuncSetAttribute failed\n"); grid = -1; return; }
        if (hipOccupancyMaxActiveBlocksPerMultiprocessor(&per_cu, (const void*)mk_fwd, NWAVES * 64, LDS_BYTES) != hipSuccess || per_cu < 1)
            fprintf(stderr, "kernel_launch: occupancy query reports %d workgroups per CU\n", per_cu);
        (void)hipGetLastError();
        grid = cus > 304 ? 304 : cus;
    }
    if (grid < 0) return;
    if (hipMemsetAsync((char*)d_ws + WS_CTL, 0, CTL_ZERO_BYTES, stream) != hipSuccess) return;
    Args a{};
    for (int i = 0; i < 23; ++i) a.in[i] = (const float*)d_in[i];
    a.out = (float*)d_out; a.ws = (unsigned char*)d_ws;
#if MK_ONE_LAUNCH
    a.ph_lo = 0; a.ph_hi = NPHASE;
    hipLaunchKernelGGL(mk_fwd, dim3(grid), dim3(NWAVES * 64), LDS_BYTES, stream, a);
#else
    for (int p = 0; p < NPHASE; ++p) { a.ph_lo = p; a.ph_hi = p + 1; hipLaunchKernelGGL(mk_fwd, dim3(grid), dim3(NWAVES * 64), LDS_BYTES, stream, a); }
#endif
    const hipError_t le = hipPeekAtLastError();
    if (le != hipSuccess) fprintf(stderr, "kernel_launch: launch failed: %s\n", hipGetErrorName(le));
}
```
